# Optimizing an MI355X kernel written in HIP

```python
import jax
import jax.numpy as jnp
from jax import lax
import numpy as np

D_MODEL = 1024
BATCH = 2
SEQ = 16384
DEPTH = 2

GRID_W = 64
CTX_LEN = 256
N_SUB = 3
D_FF = 2816
NA_HEADS = 8
NA_HEAD_DIM = 64
NA_KH = 8
NA_KW = 16
ML_HEADS = 4
ML_HEAD_DIM = 128
ML_CHUNK = 128
ROPE_THETA = 10000.0
SG_CHUNK = 128
SG_WIDTH = 2048
SG_GROUPS = 8
NA_WIDTH = NA_HEADS * NA_HEAD_DIM
ML_WIDTH = ML_HEADS * ML_HEAD_DIM
MIX_WIDTH = NA_WIDTH + ML_WIDTH
N_GATES = 4 * ML_HEADS
P_EVEN = 3 * NA_WIDTH + 4 * ML_WIDTH + N_GATES
SPLITS = (NA_WIDTH, 2 * NA_WIDTH, 3 * NA_WIDTH, 3 * NA_WIDTH + ML_WIDTH, 3 * NA_WIDTH + 2 * ML_WIDTH,
          3 * NA_WIDTH + 3 * ML_WIDTH, 3 * NA_WIDTH + 4 * ML_WIDTH)
N_EVEN = (DEPTH + 1) // 2
N_ODD = DEPTH // 2
EPS = 1e-6

kernel_name = 'hybrid_natten_mlstm_sgmlp_dit_block'


def rms_norm(x, g):
    xf = x.astype(jnp.float32)
    y = xf * lax.rsqrt(jnp.mean(jnp.square(xf), axis=-1, keepdims=True) + EPS)
    return (y * g.astype(jnp.float32)).astype(x.dtype)


def layer_norm(x, g, b):
    xf = x.astype(jnp.float32)
    mu = jnp.mean(xf, axis=-1, keepdims=True)
    var = jnp.mean(jnp.square(xf - mu), axis=-1, keepdims=True)
    y = (xf - mu) * lax.rsqrt(var + EPS)
    return (y * g.astype(jnp.float32) + b.astype(jnp.float32)).astype(x.dtype)


def modulate(x, g, shift, scale):
    return rms_norm(x, g) * (1.0 + scale) + shift


def swiglu(h, w_in, w_out):
    a, b = jnp.split(h @ w_in, 2, axis=-1)
    return (jax.nn.silu(a) * b) @ w_out


def macaron_half_ffn(x, g, shift, scale, gate, w_in, w_out):
    return x + 0.5 * gate * swiglu(modulate(x, g, shift, scale), w_in, w_out)


def mod_terms(m, j):
    return m[:, 3 * j], m[:, 3 * j + 1], m[:, 3 * j + 2]


def axial_rope(x):
    n, dh = x.shape[1], x.shape[-1]
    n_pairs = dh // 4
    pos = jnp.arange(n)
    row = (pos // GRID_W).astype(jnp.float32)
    col = (pos % GRID_W).astype(jnp.float32)
    inv_freq = ROPE_THETA ** (-jnp.arange(n_pairs, dtype=jnp.float32) / n_pairs)
    ang = jnp.concatenate([row[:, None] * inv_freq, col[:, None] * inv_freq], axis=-1)
    cos = jnp.cos(ang)[None, :, None, :]
    sin = jnp.sin(ang)[None, :, None, :]
    xp = x.astype(jnp.float32).reshape(*x.shape[:-1], dh // 2, 2)
    x1, x2 = xp[..., 0], xp[..., 1]
    out = jnp.stack([x1 * cos - x2 * sin, x1 * sin + x2 * cos], axis=-1)
    return out.reshape(x.shape).astype(x.dtype)


def dense_attention(q, k, v):
    s = jnp.einsum('bqhd,bkhd->bhqk', q, k) * (q.shape[-1] ** -0.5)
    p = jax.nn.softmax(s.astype(jnp.float32), axis=-1).astype(v.dtype)
    return jnp.einsum('bhqk,bkhd->bqhd', p, v)


def neighbourhood_attention(q, k, v, kx, vx, rpb):
    B, N, H, Dh = q.shape
    rows = N // GRID_W
    kh = min(NA_KH, rows)
    kw = NA_KW
    scale = Dh ** -0.5
    qg = q.reshape(B, rows, GRID_W, H, Dh)
    kg = k.reshape(B, rows, GRID_W, H, Dh)
    vg = v.reshape(B, rows, GRID_W, H, Dh)
    cols = jnp.arange(GRID_W)
    col_idx = jnp.clip(cols - kw // 2, 0, GRID_W - kw)[:, None] + jnp.arange(kw)[None, :]
    col_rel = col_idx - cols[:, None] + (NA_KW - 1)

    def row_block(i):
        r0 = jnp.clip(i - kh // 2, 0, rows - kh)
        q_i = lax.dynamic_index_in_dim(qg, i, axis=1, keepdims=False)
        k_win = lax.dynamic_slice_in_dim(kg, r0, kh, axis=1)[:, :, col_idx]
        v_win = lax.dynamic_slice_in_dim(vg, r0, kh, axis=1)[:, :, col_idx]
        row_rel = r0 + jnp.arange(kh) - i + (NA_KH - 1)
        bias = rpb[:, row_rel[None, :, None], col_rel[:, None, :]]
        s_loc = jnp.einsum('bqhd,baqkhd->bhqak', q_i, k_win) * scale + bias
        s_ctx = jnp.einsum('bqhd,bchd->bhqc', q_i, kx) * scale
        s = jnp.concatenate([s_loc.reshape(B, H, GRID_W, kh * kw), s_ctx], axis=-1).astype(jnp.float32)
        p = jax.nn.softmax(s, axis=-1).astype(v.dtype)
        p_loc = p[..., :kh * kw].reshape(B, H, GRID_W, kh, kw)
        p_ctx = p[..., kh * kw:]
        return (jnp.einsum('bhqak,baqkhd->bqhd', p_loc, v_win)
                + jnp.einsum('bhqc,bchd->bqhd', p_ctx, vx))

    out = lax.map(row_block, jnp.arange(rows))
    return jnp.moveaxis(out, 0, 1).reshape(B, N, H, Dh)


def mlstm_scan(q, k, v, log_i, log_f, state, with_output):
    B, H, N, Dk = q.shape
    nc = N // ML_CHUNK

    def chunks(a):
        return jnp.moveaxis(a.reshape(B, H, nc, ML_CHUNK, *a.shape[3:]), 2, 0)

    tri = jnp.tril(jnp.ones((ML_CHUNK, ML_CHUNK), dtype=bool))

    def step(carry, inp):
        C, n, m = carry
        qc, kc, vc, ic, fc = inp
        b = jnp.cumsum(fc, axis=-1)
        b_end = b[..., -1]
        w_end = b_end[..., None] - b + ic
        m_new = jnp.maximum(b_end + m, jnp.max(w_end, axis=-1))
        a_prev = jnp.exp(b_end + m - m_new)
        a_tok = jnp.exp(w_end - m_new[..., None])
        C_new = a_prev[..., None, None] * C + jnp.einsum('bhs,bhsv,bhsk->bhvk', a_tok, vc, kc)
        n_new = a_prev[..., None] * n + jnp.einsum('bhs,bhsk->bhk', a_tok, kc)
        if not with_output:
            return (C_new, n_new, m_new), None
        log_w = jnp.where(tri, b[..., :, None] - b[..., None, :] + ic[..., None, :], -jnp.inf)
        log_inter = b + m[..., None]
        m_t = jnp.maximum(log_inter, jnp.max(log_w, axis=-1))
        w_intra = jnp.exp(log_w - m_t[..., None])
        w_inter = jnp.exp(log_inter - m_t)
        s = jnp.einsum('bhtk,bhsk->bhts', qc, kc) * w_intra
        num = (w_inter[..., None] * jnp.einsum('bhvk,bhtk->bhtv', C, qc)
               + jnp.einsum('bhts,bhsv->bhtv', s, vc))
        den = w_inter * jnp.einsum('bhk,bhtk->bht', n, qc) + jnp.sum(s, axis=-1)
        h = num / jnp.maximum(jnp.abs(den), jnp.exp(-m_t))[..., None]
        return (C_new, n_new, m_new), h

    state, hs = lax.scan(step, state, (chunks(q), chunks(k), chunks(v), chunks(log_i), chunks(log_f)))
    if not with_output:
        return state, None
    return state, jnp.moveaxis(hs, 0, 2).reshape(B, H, N, Dk)


def _flip(a, rev):
    return jnp.flip(a, axis=2) if rev else a


def mlstm_bidirectional(q, k, v, log_i, log_f, qx, kx, vx, log_ix, log_fx, ctx_out):
    B, _, H, Dk = q.shape
    bh = lambda a: jnp.moveaxis(a.astype(jnp.float32), 1, 2)
    lat = [bh(a) for a in (q, k, v)]
    cx = [bh(a) for a in (qx, kx, vx)]
    h_lat, h_ctx = [], []
    for d in range(2):
        rev = d == 1
        init = (jnp.zeros((B, H, Dk, Dk), jnp.float32), jnp.zeros((B, H, Dk), jnp.float32),
                jnp.zeros((B, H), jnp.float32))
        st, hc = mlstm_scan(*[_flip(a, rev) for a in cx], _flip(bh(log_ix[..., d]), rev),
                            _flip(bh(log_fx[..., d]), rev), init, ctx_out)
        _, hl = mlstm_scan(*[_flip(a, rev) for a in lat], _flip(bh(log_i[..., d]), rev),
                           _flip(bh(log_f[..., d]), rev), st, True)
        h_lat.append(_flip(hl, rev))
        if ctx_out:
            h_ctx.append(_flip(hc, rev))
    y = jnp.moveaxis(h_lat[0] + h_lat[1], 2, 1)
    yx = jnp.moveaxis(h_ctx[0] + h_ctx[1], 2, 1) if ctx_out else None
    return y, yx


def mlstm_readout(h, o, head_g):
    B, L, H, Dk = h.shape
    y = rms_norm(h, head_g) * jax.nn.sigmoid(o.astype(jnp.float32)).reshape(B, L, H, Dk)
    return y.reshape(B, L, H * Dk).astype(o.dtype)


def even_mixer(h, hx, w_in, rpb, gate_b, head_g, w_out, ctx_out):
    def project(t):
        p = t @ w_in
        Bt, L, _ = p.shape
        qa, ka, va, qb, kb, vb, ob, g = jnp.split(p, SPLITS, axis=-1)
        na = [a.reshape(Bt, L, NA_HEADS, NA_HEAD_DIM) for a in (qa, ka, va)]
        ml = [a.reshape(Bt, L, ML_HEADS, ML_HEAD_DIM) for a in (qb, kb, vb)]
        g = g.reshape(Bt, L, ML_HEADS, 2, 2).astype(jnp.float32) + gate_b
        return na, ml, ob, g[..., 0], jax.nn.log_sigmoid(g[..., 1])

    (qa, ka, va), (qb, kb, vb), ob, li, lf = project(h)
    (qax, kax, vax), (qbx, kbx, vbx), obx, lix, lfx = project(hx)
    B, N, _ = h.shape
    y_a = neighbourhood_attention(qa, ka, va, kax, vax, rpb).reshape(B, N, NA_WIDTH)
    k_scale = ML_HEAD_DIM ** -0.5
    h_b, h_bx = mlstm_bidirectional(axial_rope(qb), axial_rope(kb) * k_scale, vb, li, lf,
                                    qbx, kbx * k_scale, vbx, lix, lfx, ctx_out)
    y = jnp.concatenate([y_a, mlstm_readout(h_b, ob, head_g)], axis=-1) @ w_out
    if not ctx_out:
        return y, None
    Bx, Lc, _ = hx.shape
    y_ax = dense_attention(qax, kax, vax).reshape(Bx, Lc, NA_WIDTH)
    yx = jnp.concatenate([y_ax, mlstm_readout(h_bx, obx, head_g)], axis=-1) @ w_out
    return y, yx


def spatial_gating(h, w_in, ln_g, ln_b, w_s, b_s, w_out):
    B, L, _ = h.shape
    u, v = jnp.split(jax.nn.gelu(h @ w_in), 2, axis=-1)
    v = layer_norm(v, ln_g, ln_b)
    nc = L // SG_CHUNK
    vg = v.reshape(B, nc, SG_CHUNK, SG_GROUPS, SG_WIDTH // SG_GROUPS)
    mixed = jnp.einsum('gts,bcsgd->bctgd', w_s, vg) + b_s.T[None, None, :, :, None]
    return (u * mixed.reshape(B, L, SG_WIDTH)) @ w_out


def setup_inputs(seed: int = 0) -> dict:
    key = jax.random.key(seed)
    ks = jax.random.split(key, 24)
    nrm = lambda k, shape, std: jax.random.normal(k, shape, jnp.float32) * std
    D = D_MODEL
    forget_base = jnp.linspace(3.0, 6.0, ML_HEADS, dtype=jnp.float32)[:, None]
    gate_b = jnp.stack([nrm(ks[11], (N_EVEN, ML_HEADS, 2), 0.1),
                        forget_base + nrm(ks[12], (N_EVEN, ML_HEADS, 2), 0.1)], axis=-1)
    return {
        'x': nrm(ks[0], (BATCH, SEQ, D), 1.0),
        'c': nrm(ks[1], (BATCH, D), 1.0),
        'ctx': nrm(ks[2], (BATCH, CTX_LEN, D), 1.0),
        'c_ctx': nrm(ks[3], (D,), 1.0),
        'w_mod': nrm(ks[4], (DEPTH, D, 3 * N_SUB * D), 0.5 * D ** -0.5),
        'b_mod': nrm(ks[5], (DEPTH, 3 * N_SUB * D), 0.02),
        'norm_g': 1.0 + nrm(ks[6], (DEPTH, N_SUB, D), 0.05),
        'ffn_w_in': nrm(ks[7], (DEPTH, 2, D, 2 * D_FF), D ** -0.5),
        'ffn_w_out': nrm(ks[8], (DEPTH, 2, D_FF, D), D_FF ** -0.5),
        'mix_w_in': nrm(ks[9], (N_EVEN, D, P_EVEN), D ** -0.5),
        'na_rpb': nrm(ks[10], (N_EVEN, NA_HEADS, 2 * NA_KH - 1, 2 * NA_KW - 1), 0.1),
        'ml_gate_b': gate_b,
        'ml_head_g': 1.0 + nrm(ks[13], (N_EVEN, ML_HEADS, ML_HEAD_DIM), 0.05),
        'mix_w_out': nrm(ks[14], (N_EVEN, MIX_WIDTH, D), MIX_WIDTH ** -0.5),
        'sg_w_in': nrm(ks[15], (N_ODD, D, 2 * SG_WIDTH), D ** -0.5),
        'sg_ln_g': 1.0 + nrm(ks[16], (N_ODD, SG_WIDTH), 0.05),
        'sg_ln_b': nrm(ks[17], (N_ODD, SG_WIDTH), 0.02),
        'sg_w_s': nrm(ks[18], (N_ODD, SG_GROUPS, SG_CHUNK, SG_CHUNK), 0.5 * SG_CHUNK ** -0.5),
        'sg_b_s': 1.0 + nrm(ks[19], (N_ODD, SG_GROUPS, SG_CHUNK), 0.1),
        'sg_w_out': nrm(ks[20], (N_ODD, SG_WIDTH, D), SG_WIDTH ** -0.5),
        'final_g': 1.0 + nrm(ks[21], (D,), 0.05),
    }


def reference(x, c, ctx, c_ctx, w_mod, b_mod, norm_g, ffn_w_in, ffn_w_out, mix_w_in, na_rpb, ml_gate_b,
              ml_head_g, mix_w_out, sg_w_in, sg_ln_g, sg_ln_b, sg_w_s, sg_b_s, sg_w_out, final_g):
    B, N, D = x.shape
    last_ctx_layer = ((DEPTH - 1) // 2) * 2
    silu_c = jax.nn.silu(c)
    silu_cx = jax.nn.silu(c_ctx)[None]
    xc = ctx
    for l in range(DEPTH):
        ctx_in = l <= last_ctx_layer
        ctx_out = l < last_ctx_layer
        mod = (silu_c @ w_mod[l] + b_mod[l]).reshape(B, 3 * N_SUB, 1, D)
        x = macaron_half_ffn(x, norm_g[l, 0], *mod_terms(mod, 0), ffn_w_in[l, 0], ffn_w_out[l, 0])
        sh, sc, gt = mod_terms(mod, 1)
        h = modulate(x, norm_g[l, 1], sh, sc)
        hx = None
        if ctx_in:
            modx = (silu_cx @ w_mod[l] + b_mod[l]).reshape(1, 3 * N_SUB, 1, D)
            xc = macaron_half_ffn(xc, norm_g[l, 0], *mod_terms(modx, 0), ffn_w_in[l, 0], ffn_w_out[l, 0])
            shx, scx, gtx = mod_terms(modx, 1)
            hx = modulate(xc, norm_g[l, 1], shx, scx)
        if l % 2 == 0:
            e = l // 2
            y, yx = even_mixer(h, hx, mix_w_in[e], na_rpb[e], ml_gate_b[e], ml_head_g[e], mix_w_out[e], ctx_out)
        else:
            o = l // 2
            y = spatial_gating(h, sg_w_in[o], sg_ln_g[o], sg_ln_b[o], sg_w_s[o], sg_b_s[o], sg_w_out[o])
            yx = (spatial_gating(hx, sg_w_in[o], sg_ln_g[o], sg_ln_b[o], sg_w_s[o], sg_b_s[o], sg_w_out[o])
                  if ctx_out else None)
        x = x + gt * y
        x = macaron_half_ffn(x, norm_g[l, 2], *mod_terms(mod, 2), ffn_w_in[l, 1], ffn_w_out[l, 1])
        if ctx_out:
            xc = xc + gtx * yx
            xc = macaron_half_ffn(xc, norm_g[l, 2], *mod_terms(modx, 2), ffn_w_in[l, 1], ffn_w_out[l, 1])
    return rms_norm(x, final_g)
```

```cpp
#include <hip/hip_runtime.h>
#include <hip/hip_cooperative_groups.h>
#include <cstdio>
namespace cg = cooperative_groups;

#ifndef NAIVE_NA
#define NAIVE_NA 0
#endif
#ifndef NAIVE_MLA
#define NAIVE_MLA 0
#endif
#ifndef NAIVE_MLC
#define NAIVE_MLC 0
#endif
#ifndef NAIVE_SG
#define NAIVE_SG 0
#endif
#ifndef DBL_MASK
#define DBL_MASK 0u
#endif
#ifndef REV_PANELS
#define REV_PANELS 1
#endif
#ifndef MULTI_LAUNCH
#define MULTI_LAUNCH 0
#endif

#define LAS __attribute__((address_space(3)))
typedef unsigned short bf16_t;
typedef short bf16x8 __attribute__((ext_vector_type(8)));
typedef float f32x4 __attribute__((ext_vector_type(4)));
typedef float f32x2 __attribute__((ext_vector_type(2)));
typedef unsigned u32x4 __attribute__((ext_vector_type(4)));
typedef unsigned u32x2 __attribute__((ext_vector_type(2)));

constexpr int T = 32768, TC = 512, TP = T + TC, D = 1024, DFF = 2816, NSEQ = 16384;
constexpr int NTHR = 512;
constexpr int LDS_BYTES = 147456;
constexpr int NSLOT = 2 * 4 * 2 * 130;
constexpr int PITCH = 272;

constexpr size_t WS_MOD = 0;
constexpr size_t WS_BAR = 229376;
constexpr size_t WS_ST = 243712;
constexpr size_t WS_ZERO_END = WS_ST + (size_t)T * 8;
constexpr size_t WS_ROPE = WS_ZERO_END + 256;
constexpr size_t WS_W = WS_ROPE + 65536;
constexpr size_t W_FFN_IN = 0, W_FFN_OUT = W_FFN_IN + 4ull * 5632 * 1024, W_MIXIN = W_FFN_OUT + 4ull * 1024 * 2816,
                 W_MIXOUT = W_MIXIN + 3840ull * 1024, W_SGIN = W_MIXOUT + 1024ull * 1024, W_SGOUT = W_SGIN + 4096ull * 1024,
                 W_END = W_SGOUT + 1024ull * 2048;
constexpr size_t WS_R = WS_W + W_END * 2;
constexpr size_t WS_H = WS_R + 268435456ull;
constexpr size_t WS_CL = WS_H + (size_t)TP * 1024 * 2;
constexpr size_t WS_XC = WS_CL + (size_t)NSLOT * 32768;
constexpr size_t WS_VEC = WS_XC + (size_t)TC * 1024 * 4;
constexpr size_t WS_NL = WS_VEC + (size_t)NSLOT * 2048;
constexpr size_t WS_END = WS_NL + (size_t)NSLOT * 512;

struct P {
    const float *x, *c, *ctx, *c_ctx, *w_mod, *b_mod, *norm_g, *ffn_w_in, *ffn_w_out, *mix_w_in, *na_rpb, *ml_gate_b, *ml_head_g,
        *mix_w_out, *sg_w_in, *sg_ln_g, *sg_ln_b, *sg_w_s, *sg_b_s, *sg_w_out, *final_g;
    float* out; unsigned char* ws; int ph_lo, ph_hi;
};

__device__ __forceinline__ int opaque_tid() { int t = threadIdx.x; asm volatile("" : "+v"(t)); return t; }
#define TIDX (opaque_tid())
__device__ __forceinline__ float bf2f(bf16_t v) { return __uint_as_float(((unsigned)v) << 16); }
__device__ __forceinline__ float bflo(unsigned u) { return __uint_as_float(u << 16); }
__device__ __forceinline__ float bfhi(unsigned u) { return __uint_as_float(u & 0xffff0000u); }
typedef __bf16 bf16v2_t __attribute__((ext_vector_type(2)));
__device__ __forceinline__ unsigned cvt_pk_bf16(float lo, float hi) { const f32x2 v = {lo, hi}; return __builtin_bit_cast(unsigned, __builtin_convertvector(v, bf16v2_t)); }
__device__ __forceinline__ bf16_t f2bf(float f) { return (bf16_t)(cvt_pk_bf16(f, 0.f) & 0xffffu); }
__device__ __forceinline__ float fexp(float v) { return __builtin_amdgcn_exp2f(v * 1.4426950408889634f); }
__device__ __forceinline__ float silu_f(float v) { return v * __builtin_amdgcn_rcpf(1.0f + fexp(-v)); }
__device__ __forceinline__ float sigmoid_f(float v) { return __builtin_amdgcn_rcpf(1.0f + fexp(-v)); }
__device__ __forceinline__ float gelu_tanh(float v) { const float u = 0.7978845608028654f * (v + 0.044715f * v * v * v); const float e = fexp(2.0f * u); return v * (1.0f - __builtin_amdgcn_rcpf(e + 1.0f)); }
__device__ __forceinline__ float log_sigmoid_f(float v) { return fminf(v, 0.f) - log1pf(__expf(-fabsf(v))); }

namespace pg8 {
constexpr int BM = 256, BK = 64, HALF = 128, HTB = HALF * BK * 2, STAGE_BYTES = 8 * HTB, NXCD = 8, WGM = 8;
__device__ __forceinline__ int lds_byte(int r, int c) { const int st = (r >> 4) * 2 + (c >> 5), rr = r & 15, cc = c & 31, ob = rr * 64 + cc * 2; return st * 1024 + (ob ^ (((ob >> 9) & 1) << 5)); }
__device__ __forceinline__ void stage_rc(int b, int& R, int& C) { const int st = b / 1024, sb = b % 1024, swz = sb ^ (((sb >> 9) & 1) << 5); R = (st >> 1) * 16 + swz / 64; C = (st & 1) * 32 + (swz % 64) / 2; }
struct Unit { int pm, pn; };
struct Gemm { const bf16_t* A; const bf16_t* Bt; int M, N, K; int tiledA, tiledB; };
struct StaticOrder {
    int nM, nN, nwg, G, c, fpm, fpn, rev;
    __device__ void init(int M, int N, int G_, int c_) { nM = M / BM; nN = N / BM; nwg = nM * nN; G = G_; c = c_; fpm = -1; fpn = 0; rev = 0; }
    __device__ bool next(int i, Unit& u) const {
        if (fpm >= 0) { if (i > 0) return false; u.pm = fpm; u.pn = fpn; return true; }
        const long L = (long)i * G + c; if (L >= nwg) return false;
        int wgid = (int)L; { const int q = nwg / NXCD, r = nwg % NXCD, xcd = wgid % NXCD, off = wgid / NXCD; wgid = (xcd < r ? xcd * (q + 1) : r * (q + 1) + (xcd - r) * q) + off; }
        const int nig = WGM * nN, gid = wgid / nig, fm = gid * WGM, gsz = (nM - fm) < WGM ? (nM - fm) : WGM;
        u.pm = fm + ((wgid % nig) % gsz); u.pn = (wgid % nig) / gsz; if (rev) u.pm = nM - 1 - u.pm; return true;
    }
};

#ifndef PG8_SP2
#define PG8_SP2 true
#endif
#ifndef PG8_ALIGN
#define PG8_ALIGN true
#endif
template <class Epi, bool ALIGN_EPI = PG8_ALIGN, bool SP2 = PG8_SP2>
__device__ __forceinline__ void gemm_phase(LAS unsigned char* lds, const Gemm g, const StaticOrder& S, const Epi& E) {
    const int tid = TIDX, wid = __builtin_amdgcn_readfirstlane(tid >> 6), lane = tid & 63, wr = wid >> 2, wc = wid & 3, fr = lane & 15, fq = lane >> 4;
    const int K = g.K, nt = K / BK;
    unsigned voffA[2], voffB[2];
#pragma unroll
    for (int i = 0; i < 2; ++i) { int R, C; stage_rc(tid * 16 + i * 8192, R, C); voffA[i] = (unsigned)(R * (g.tiledA ? BK : K) + C) * 2u; voffB[i] = (unsigned)(R * (g.tiledB ? BK : K) + C) * 2u; }
    const size_t kstepA = g.tiledA ? (size_t)(2 * HTB) : (size_t)(BK * 2), kstepB = g.tiledB ? (size_t)(2 * HTB) : (size_t)(BK * 2);
    const size_t hstepA = g.tiledA ? (size_t)HTB : (size_t)HALF * K * 2, hstepB = g.tiledB ? (size_t)HTB : (size_t)HALF * K * 2;
    const size_t tstepA = (size_t)BM * K * 2, tstepB = (size_t)BM * K * 2;
    const unsigned ldsw = (unsigned)wid * 1024u;
    const int aoff = lds_byte(wr * 64 + fr, fq * 8), boff = lds_byte(wc * 32 + fr, fq * 8);
#define PG8_SA(b, h) (((b) * 2 + (h)) * HTB)
#define PG8_SB(b, h) ((4 + (b) * 2 + (h)) * HTB)
#define PG8_STAGE(bufoff, gbase, voff) do { _Pragma("unroll") for (int _i = 0; _i < 2; ++_i) \
        __builtin_amdgcn_global_load_lds((const unsigned*)((const char*)(gbase) + (voff)[_i]), (LAS unsigned*)(lds + (bufoff) + ldsw + _i * 8192), 16, 0, 0); } while (0)
#define PG8_LDA(dst, b, h) do { _Pragma("unroll") for (int m = 0; m < 4; ++m) _Pragma("unroll") for (int k = 0; k < 2; ++k) dst[m][k] = *(const LAS bf16x8*)(lds + PG8_SA(b, h) + aoff + m * 2048 + k * 1024); } while (0)
#define PG8_LDB(dst, b, h) do { _Pragma("unroll") for (int n = 0; n < 2; ++n) _Pragma("unroll") for (int k = 0; k < 2; ++k) dst[n][k] = *(const LAS bf16x8*)(lds + PG8_SB(b, h) + boff + n * 2048 + k * 1024); } while (0)
#define PG8_MMA(ai, bj, At, Bt) do { __builtin_amdgcn_s_setprio(1); _Pragma("unroll") for (int m = 0; m < 4; ++m) _Pragma("unroll") for (int n = 0; n < 2; ++n) _Pragma("unroll") for (int k = 0; k < 2; ++k) \
        acc[ai][bj][m][n] = __builtin_amdgcn_mfma_f32_16x16x32_bf16(Bt[n][k], At[m][k], acc[ai][bj][m][n], 0, 0, 0); __builtin_amdgcn_s_setprio(0); } while (0)
#define PG8_WAIT_V(n) asm volatile("s_waitcnt vmcnt(" #n ")" ::: "memory")
#define PG8_WAIT_L(n) asm volatile("s_waitcnt lgkmcnt(" #n ")" ::: "memory")
#define PG8_BAR __builtin_amdgcn_s_barrier()
#define PG8_SCHED __builtin_amdgcn_sched_barrier(0)
    Unit cur, nxt; int ui = 0;
    if (!S.next(0, cur)) return;
    f32x4 acc[2][2][4][2];
#pragma unroll
    for (int a = 0; a < 2; ++a)
#pragma unroll
        for (int b = 0; b < 2; ++b)
#pragma unroll
            for (int m = 0; m < 4; ++m)
#pragma unroll
                for (int n = 0; n < 2; ++n) acc[a][b][m][n] = (f32x4){0.f, 0.f, 0.f, 0.f};
    bf16x8 At[4][2], B0[2][2], B1[2][2];
    const char* cA = (const char*)g.A + (size_t)cur.pm * tstepA; const char* cB = (const char*)g.Bt + (size_t)cur.pn * tstepB;
    if constexpr (SP2) {
        PG8_STAGE(PG8_SB(0, 0), cB, voffB); PG8_STAGE(PG8_SB(0, 1), cB + hstepB, voffB); PG8_STAGE(PG8_SA(0, 0), cA, voffA); PG8_STAGE(PG8_SA(0, 1), cA + hstepA, voffA);
        if (wr == 1) PG8_BAR;
        PG8_WAIT_V(2); PG8_BAR;
        PG8_STAGE(PG8_SB(1, 0), cB + kstepB, voffB); PG8_STAGE(PG8_SA(1, 0), cA + kstepA, voffA); PG8_STAGE(PG8_SB(1, 1), cB + hstepB + kstepB, voffB);
        PG8_WAIT_V(6); PG8_BAR;
    } else {
        PG8_STAGE(PG8_SB(0, 0), cB, voffB); PG8_STAGE(PG8_SA(0, 0), cA, voffA); PG8_STAGE(PG8_SB(0, 1), cB + hstepB, voffB); PG8_STAGE(PG8_SA(0, 1), cA + hstepA, voffA);
        if (wr == 1) PG8_BAR;
        PG8_WAIT_V(4); PG8_BAR;
        PG8_STAGE(PG8_SB(1, 0), cB + kstepB, voffB); PG8_STAGE(PG8_SA(1, 0), cA + kstepA, voffA); PG8_STAGE(PG8_SB(1, 1), cB + hstepB + kstepB, voffB);
        PG8_WAIT_V(6); PG8_BAR;
    }
    for (;;) {
        const bool has_next = S.next(ui + 1, nxt);
        const char* nA = has_next ? (const char*)g.A + (size_t)nxt.pm * tstepA : cA; const char* nB = has_next ? (const char*)g.Bt + (size_t)nxt.pn * tstepB : cB;
        for (int t = 0; t < nt; t += 2) {
            const bool last = (t == nt - 2);
            const char* a1 = cA + (size_t)(t + 1) * kstepA;
            const char* a2 = last ? nA : cA + (size_t)(t + 2) * kstepA; const char* b2 = last ? nB : cB + (size_t)(t + 2) * kstepB;
            const char* a3 = a2 + kstepA; const char* b3 = b2 + kstepB;
            if constexpr (SP2) {
            PG8_LDB(B0, 0, 0); PG8_LDB(B1, 0, 1); PG8_SCHED; PG8_LDA(At, 0, 0); PG8_STAGE(PG8_SA(1, 1), a1 + hstepA, voffA);
            PG8_WAIT_V(8); PG8_WAIT_L(0); PG8_BAR; PG8_MMA(0, 0, At, B0); PG8_MMA(0, 1, At, B1); PG8_BAR; PG8_SCHED;
            PG8_LDA(At, 0, 1); PG8_STAGE(PG8_SB(0, 0), b2, voffB); PG8_STAGE(PG8_SB(0, 1), b2 + hstepB, voffB); PG8_STAGE(PG8_SA(0, 0), a2, voffA);
            PG8_WAIT_V(8); PG8_WAIT_L(0); PG8_BAR; PG8_MMA(1, 0, At, B0); PG8_MMA(1, 1, At, B1); PG8_BAR; PG8_SCHED;
            PG8_LDB(B0, 1, 0); PG8_LDB(B1, 1, 1); PG8_SCHED; PG8_LDA(At, 1, 0); PG8_STAGE(PG8_SA(0, 1), a2 + hstepA, voffA);
            PG8_WAIT_V(8); PG8_WAIT_L(0); PG8_BAR; PG8_MMA(0, 0, At, B0); PG8_MMA(0, 1, At, B1); PG8_BAR; PG8_SCHED;
            PG8_LDA(At, 1, 1); PG8_STAGE(PG8_SB(1, 0), b3, voffB); PG8_STAGE(PG8_SB(1, 1), b3 + hstepB, voffB); PG8_STAGE(PG8_SA(1, 0), a3, voffA);
            PG8_WAIT_V(8); PG8_WAIT_L(0); PG8_BAR; PG8_MMA(1, 0, At, B0); PG8_MMA(1, 1, At, B1); PG8_BAR; PG8_SCHED;
            } else {
            PG8_LDB(B0, 0, 0); PG8_SCHED; PG8_LDA(At, 0, 0); PG8_STAGE(PG8_SA(1, 1), a1 + hstepA, voffA);
            PG8_WAIT_L(8); PG8_BAR; PG8_WAIT_L(0); PG8_MMA(0, 0, At, B0); PG8_BAR; PG8_SCHED;
            PG8_LDB(B1, 0, 1); PG8_STAGE(PG8_SB(0, 0), b2, voffB);
            PG8_BAR; PG8_WAIT_L(0); PG8_MMA(0, 1, At, B1); PG8_BAR;
            PG8_LDA(At, 0, 1); PG8_STAGE(PG8_SA(0, 0), a2, voffA);
            PG8_BAR; PG8_WAIT_L(0); PG8_MMA(1, 0, At, B0); PG8_BAR; PG8_SCHED;
            PG8_STAGE(PG8_SB(0, 1), b2 + hstepB, voffB);
            PG8_WAIT_V(6); PG8_BAR; PG8_MMA(1, 1, At, B1); PG8_BAR;
            PG8_LDB(B0, 1, 0); PG8_SCHED; PG8_LDA(At, 1, 0); PG8_STAGE(PG8_SA(0, 1), a2 + hstepA, voffA);
            PG8_WAIT_L(8); PG8_BAR; PG8_WAIT_L(0); PG8_MMA(0, 0, At, B0); PG8_BAR; PG8_SCHED;
            PG8_LDB(B1, 1, 1); PG8_STAGE(PG8_SB(1, 0), b3, voffB);
            PG8_BAR; PG8_WAIT_L(0); PG8_MMA(0, 1, At, B1); PG8_BAR;
            PG8_LDA(At, 1, 1); PG8_STAGE(PG8_SA(1, 0), a3, voffA);
            PG8_BAR; PG8_WAIT_L(0); PG8_MMA(1, 0, At, B0); PG8_BAR; PG8_SCHED;
            PG8_STAGE(PG8_SB(1, 1), b3 + hstepB, voffB);
            PG8_WAIT_V(6); PG8_BAR; PG8_MMA(1, 1, At, B1); PG8_BAR;
            }
        }
        if constexpr (ALIGN_EPI) { if (wr == 0) PG8_BAR; }
        E(acc, cur, wr, wc, fr, fq);
        if (!has_next) break;
#pragma unroll
        for (int a = 0; a < 2; ++a)
#pragma unroll
            for (int b = 0; b < 2; ++b)
#pragma unroll
                for (int m = 0; m < 4; ++m)
#pragma unroll
                    for (int n = 0; n < 2; ++n) acc[a][b][m][n] = (f32x4){0.f, 0.f, 0.f, 0.f};
        cur = nxt; cA = nA; cB = nB; ++ui;
        if constexpr (ALIGN_EPI) { if (wr == 1) PG8_BAR; }
    }
    PG8_WAIT_V(0);
    if constexpr (!ALIGN_EPI) { if (wr == 0) PG8_BAR; }
    PG8_BAR;
#undef PG8_SA
#undef PG8_SB
#undef PG8_STAGE
#undef PG8_LDA
#undef PG8_LDB
#undef PG8_MMA
#undef PG8_WAIT_V
#undef PG8_WAIT_L
#undef PG8_BAR
#undef PG8_SCHED
}
}

struct EpiSwiglu {
    bf16_t* hid;
    __device__ __forceinline__ void operator()(const f32x4 (&acc)[2][2][4][2], const pg8::Unit& u, int wr, int wc, int fr, int fq) const {
        const int row0 = u.pm * 256 + wr * 64 + fr, hc0 = u.pn * 128 + wc * 32 + 8 * fq;
#pragma unroll
        for (int ai = 0; ai < 2; ++ai)
#pragma unroll
            for (int m = 0; m < 4; ++m) { u32x4 w;
#pragma unroll
                for (int n = 0; n < 2; ++n) { const f32x4 a = acc[ai][0][m][n], b = acc[ai][1][m][n];
                    w[2 * n] = cvt_pk_bf16(silu_f(a[0]) * b[0], silu_f(a[1]) * b[1]); w[2 * n + 1] = cvt_pk_bf16(silu_f(a[2]) * b[2], silu_f(a[3]) * b[3]); }
                const int row = row0 + ai * 128 + m * 16;
                *(u32x4*)(hid + ((size_t)((row >> 8) * (DFF / 64) + (hc0 >> 6)) * 2 + ((row >> 7) & 1)) * 8192 + (row & 127) * 64 + (hc0 & 63)) = w; }
    }
};
struct EpiResid {
    const float* xin_lat; const float* xin_ctx; float* xout_lat; float* xout_ctx; const float* gate; float coef;
    __device__ __forceinline__ void operator()(const f32x4 (&acc)[2][2][4][2], const pg8::Unit& u, int wr, int wc, int fr, int fq) const {
        const int row0 = u.pm * 256 + wr * 64 + fr, col0 = u.pn * 256 + wc * 32 + 8 * fq;
        const bool isctx = u.pm >= T / 256; const int mb = isctx ? 2 : (u.pm >> 6);
        const float* xi = isctx ? xin_ctx - (size_t)T * D : xin_lat; float* xo = isctx ? xout_ctx - (size_t)T * D : xout_lat;
        const float* gp = gate + mb * 9216 + col0;
        f32x4 gv[2][2];
#pragma unroll
        for (int bj = 0; bj < 2; ++bj)
#pragma unroll
            for (int n = 0; n < 2; ++n) gv[bj][n] = *(const f32x4*)(gp + bj * 128 + n * 4) * coef;
#pragma unroll
        for (int ai = 0; ai < 2; ++ai) {
            f32x4 xv[4][2][2];
#pragma unroll
            for (int m = 0; m < 4; ++m)
#pragma unroll
                for (int bj = 0; bj < 2; ++bj)
#pragma unroll
                    for (int n = 0; n < 2; ++n) xv[m][bj][n] = *(const f32x4*)(xi + (size_t)(row0 + ai * 128 + m * 16) * D + col0 + bj * 128 + n * 4);
#pragma unroll
            for (int m = 0; m < 4; ++m)
#pragma unroll
                for (int bj = 0; bj < 2; ++bj)
#pragma unroll
                    for (int n = 0; n < 2; ++n) *(f32x4*)(xo + (size_t)(row0 + ai * 128 + m * 16) * D + col0 + bj * 128 + n * 4) = xv[m][bj][n] + gv[bj][n] * acc[ai][bj][m][n];
        }
    }
};
struct EpiProj {
    bf16_t* base; float* G; const float2* rope; const float* gate_b;
    __device__ __forceinline__ void operator()(const f32x4 (&acc)[2][2][4][2], const pg8::Unit& u, int wr, int wc, int fr, int fq) const {
        const int row0 = u.pm * 256 + wr * 64 + fr;
        if (u.pn == 14) {
            if (wc == 0 && fq < 2) {
#pragma unroll
                for (int nn = 0; nn < 2; ++nn) { const int head = 2 * fq + nn; const f32x4 gb = *(const f32x4*)(gate_b + 4 * head);
#pragma unroll
                    for (int ai = 0; ai < 2; ++ai)
#pragma unroll
                        for (int m = 0; m < 4; ++m) { const int row = row0 + ai * 128 + m * 16; f32x4 v = acc[ai][0][m][nn] + gb;
                            v[1] = log_sigmoid_f(v[1]); v[3] = log_sigmoid_f(v[3]);
                            *(f32x4*)(G + (size_t)row * 16 + 4 * head) = v; } }
            }
            return;
        }
        const int kind = u.pn >> 1; bf16_t* dst = base + (size_t)kind * TP * 512;
        const int cc0 = (u.pn & 1) * 256 + wc * 32 + 8 * fq;
        const bool rope_k = (kind == 3 || kind == 4) && (u.pm < T / 256);
        const float sc = (kind == 4) ? 0.08838834764831845f : 1.0f;
#pragma unroll
        for (int ai = 0; ai < 2; ++ai)
#pragma unroll
            for (int m = 0; m < 4; ++m) { const int row = row0 + ai * 128 + m * 16; const int n = row & (NSEQ - 1), gi = n >> 6, gj = n & 63;
#pragma unroll
                for (int bj = 0; bj < 2; ++bj) { u32x4 w;
#pragma unroll
                    for (int nn = 0; nn < 2; ++nn) { const int cc = cc0 + bj * 128 + nn * 4; f32x4 v = acc[ai][bj][m][nn];
                        if (rope_k) { const int pr = (cc & 127) >> 1; const int pos = (pr < 32) ? gi : gj; const int fi = pr & 31;
                            const float2 cs0 = rope[pos * 32 + fi], cs1 = rope[pos * 32 + fi + 1];
                            const float a0 = v[0] * cs0.x - v[1] * cs0.y, a1 = v[0] * cs0.y + v[1] * cs0.x, a2 = v[2] * cs1.x - v[3] * cs1.y, a3 = v[2] * cs1.y + v[3] * cs1.x;
                            v = (f32x4){a0, a1, a2, a3}; }
                        v = v * sc;
                        w[2 * nn] = cvt_pk_bf16(v[0], v[1]); w[2 * nn + 1] = cvt_pk_bf16(v[2], v[3]); }
                    *(u32x4*)(dst + (size_t)row * 512 + cc0 + bj * 128) = w; } }
    }
};
struct EpiGeluUV {
    bf16_t* base; float* st;
    __device__ __forceinline__ void operator()(const f32x4 (&acc)[2][2][4][2], const pg8::Unit& u, int wr, int wc, int fr, int fq) const {
        const int row0 = u.pm * 256 + wr * 64 + fr; bf16_t* dst = base + (size_t)(u.pn >> 3) * T * 2048; const int cc0 = (u.pn & 7) * 256 + wc * 32 + 8 * fq;
        const bool isv = u.pn >= 8;
#define GU_ROW(ai, m) { bf16_t* rowp = dst + (size_t)(row0 + (ai) * 128 + (m) * 16) * 2048 + cc0; float s1 = 0.f, s2 = 0.f; \
            _Pragma("unroll") for (int bj = 0; bj < 2; ++bj) { u32x4 w; \
                _Pragma("unroll") for (int n = 0; n < 2; ++n) { const f32x4 v = acc[ai][bj][m][n]; const float g0 = gelu_tanh(v[0]), g1 = gelu_tanh(v[1]), g2 = gelu_tanh(v[2]), g3 = gelu_tanh(v[3]); \
                    s1 += (g0 + g1) + (g2 + g3); s2 += (g0 * g0 + g1 * g1) + (g2 * g2 + g3 * g3); \
                    w[2 * n] = cvt_pk_bf16(g0, g1); w[2 * n + 1] = cvt_pk_bf16(g2, g3); } \
                *(u32x4*)(rowp + bj * 128) = w; } \
            if (isv) { s1 += __shfl_xor(s1, 16); s1 += __shfl_xor(s1, 32); s2 += __shfl_xor(s2, 16); s2 += __shfl_xor(s2, 32); \
                if (fq == 0) { atomicAdd(st + 2 * (row0 + (ai) * 128 + (m) * 16), s1); atomicAdd(st + 2 * (row0 + (ai) * 128 + (m) * 16) + 1, s2); } } }
        GU_ROW(0, 0) GU_ROW(0, 1) GU_ROW(0, 2) GU_ROW(0, 3) GU_ROW(1, 0) GU_ROW(1, 1) GU_ROW(1, 2) GU_ROW(1, 3)
#undef GU_ROW
    }
};

__device__ void ph_prep(const P& p, LAS unsigned char* lds) {
    const int tid = TIDX, G = gridDim.x, bid = blockIdx.x;
    float* mod = (float*)(p.ws + WS_MOD);
    for (int idx = bid * NTHR + tid; idx < 256 * 32; idx += G * NTHR) {
        const int pos = idx >> 5, fi = idx & 31;
        const float inv = exp2f(-(float)fi * (13.287712379549449f / 32.0f));
        const float ang = (float)pos * inv;
        const double a = (double)ang; const double kq = rint(a * 0.6366197723675814); const double r = a - kq * 1.5707963267948966;
        const float rf = (float)r, r2 = rf * rf; const int q = ((int)kq) & 3;
        const float s = rf + rf * r2 * (-1.6666654611e-1f + r2 * (8.3321608736e-3f + r2 * (-1.9515295891e-4f)));
        const float c = 1.0f - 0.5f * r2 + r2 * r2 * (4.166664568298827e-2f + r2 * (-1.388731625493765e-3f + r2 * 2.443315711809948e-5f));
        float co, si;
        if (q == 0) { co = c; si = s; } else if (q == 1) { co = -s; si = c; } else if (q == 2) { co = -c; si = -s; } else { co = s; si = -c; }
        ((float2*)(p.ws + WS_ROPE))[idx] = make_float2(co, si);
    }
    LAS float* sv = (LAS float*)lds;
    for (int item = bid; item < 288; item += G) {
        const int l = item / 144, rem = item % 144, ks = rem / 9, cgp = rem % 9;
        __syncthreads();
        if (tid < 192) { const int mb = tid >> 6, kk = tid & 63, k = ks * 64 + kk; const float cv = (mb < 2) ? p.c[mb * 1024 + k] : p.c_ctx[k]; sv[mb * 64 + kk] = silu_f(cv); }
        __syncthreads();
        const int half = tid >> 8, cq = tid & 255, col = cgp * 1024 + cq * 4;
        f32x4 a0 = {0, 0, 0, 0}, a1 = a0, a2 = a0;
        const float* wp = p.w_mod + ((size_t)(l * 1024 + ks * 64 + half * 32)) * 9216 + col;
#pragma unroll 16
        for (int kk = 0; kk < 32; ++kk) { const f32x4 w = *(const f32x4*)(wp + (size_t)kk * 9216); const int si = half * 32 + kk;
            a0 += w * sv[si]; a1 += w * sv[64 + si]; a2 += w * sv[128 + si]; }
        if (ks == 0 && half == 0) { const f32x4 bb = *(const f32x4*)(p.b_mod + l * 9216 + col); a0 += bb; a1 += bb; a2 += bb; }
        float* m0 = mod + (size_t)(l * 3) * 9216 + col;
#pragma unroll
        for (int j = 0; j < 4; ++j) { atomicAdd(m0 + j, a0[j]); atomicAdd(m0 + 9216 + j, a1[j]); atomicAdd(m0 + 2 * 9216 + j, a2[j]); }
    }
}

__device__ void ph_convert(const P& p, LAS unsigned char* lds, int layer, int wid, int nwg, int v_lo, int v_hi) {
    const int tid = TIDX;
    __syncthreads();
    LAS bf16_t* tl = (LAS bf16_t*)(lds + 1024);
    bf16_t* Wb = (bf16_t*)(p.ws + WS_W);
    float vv[16]; bf16_t* cdst = nullptr; int cK = 0, ck0 = 0, cr0 = 0;
#define CONV_DECODE(t, src, dst, K, Ns, kind, k0, r0) { int nrt, lt; \
        if (t < 2816) { const int j = t / 704; lt = t % 704; src = p.ffn_w_in + (size_t)j * 1024 * 5632; dst = Wb + W_FFN_IN + (size_t)j * 5632 * 1024; K = 1024; Ns = 5632; nrt = 88; kind = 1; } \
        else if (t < 4224) { const int j = (t - 2816) / 352; lt = (t - 2816) % 352; src = p.ffn_w_out + (size_t)j * 2816 * 1024; dst = Wb + W_FFN_OUT + (size_t)j * 1024 * 2816; K = 2816; Ns = 1024; nrt = 16; kind = 0; } \
        else if (t < 4704) { lt = t - 4224; src = p.mix_w_in; dst = Wb + W_MIXIN; K = 1024; Ns = 3600; nrt = 60; kind = 2; } \
        else if (t < 4832) { lt = t - 4704; src = p.mix_w_out; dst = Wb + W_MIXOUT; K = 1024; Ns = 1024; nrt = 16; kind = 0; } \
        else if (t < 5344) { lt = t - 4832; src = p.sg_w_in; dst = Wb + W_SGIN; K = 1024; Ns = 4096; nrt = 64; kind = 0; } \
        else { lt = t - 5344; src = p.sg_w_out; dst = Wb + W_SGOUT; K = 2048; Ns = 1024; nrt = 16; kind = 0; } \
        k0 = (lt / nrt) * 128; r0 = (lt % nrt) * 64; }
#define CONV_LOAD(t) { const float* src; bf16_t* dst; int K, Ns, kind, k0, r0; CONV_DECODE(t, src, dst, K, Ns, kind, k0, r0) \
        const int rr = r0 + (tid & 63); int sc = rr; \
        if (kind == 1) { const int pn = rr >> 8, cl = rr & 255; sc = 128 * pn + 32 * ((cl >> 5) & 3) + 8 * ((cl >> 2) & 3) + 4 * ((cl >> 4) & 1) + (cl & 3) + (cl >> 7) * DFF; } \
        else { const int rho = rr & 31; sc = (rr & ~31) + 8 * ((rho & 15) >> 2) + 4 * (rho >> 4) + (rho & 3); if (kind == 2 && sc >= 3600) sc = -1; } \
        _Pragma("unroll") for (int it = 0; it < 16; ++it) { const int kk = it * 8 + (tid >> 6); vv[it] = (sc >= 0) ? src[(size_t)(k0 + kk) * Ns + sc] : 0.f; } \
        cdst = dst; cK = K; ck0 = k0; cr0 = r0; }
    const int nv = min(v_hi, layer ? 2880 : 2720);
#define CONV_REMAP(v) (layer ? (((v) < 1408) ? (v) + 1408 : ((v) < 2112) ? (v) - 1408 + 3520 : (v) - 2112 + 4832) : (((v) < 1408) ? (v) : ((v) < 2112) ? (v) - 1408 + 2816 : (v) - 2112 + 4224))
    int v = v_lo + wid;
    if (v < nv) { const int t = CONV_REMAP(v); CONV_LOAD(t) }
    while (v < nv) {
        __syncthreads();
        { const int rl = tid & 63;
#pragma unroll
          for (int it = 0; it < 16; ++it) { const int kk = it * 8 + (tid >> 6); tl[rl * 136 + kk] = f2bf(vv[it]); } }
        bf16_t* odst = cdst; const int oK = cK, ok0 = ck0, or0 = cr0; const bool otile = (oK == 2816);
        __syncthreads();
        v += nwg;
        if (v < nv) { const int t = CONV_REMAP(v); CONV_LOAD(t) }
#pragma unroll
        for (int h2 = 0; h2 < 2; ++h2) { const int idx = tid + h2 * 512, rl = idx >> 4, kc = (idx & 15) * 8; const u32x4 v = *(const LAS u32x4*)(tl + rl * 136 + kc); const int rr = or0 + rl, kk = ok0 + kc;
            const size_t off = otile ? (((size_t)((rr >> 8) * (2816 / 64) + (kk >> 6)) * 2 + ((rr >> 7) & 1)) * 8192 + (rr & 127) * 64 + (kk & 63)) : ((size_t)rr * oK + kk);
            *(u32x4*)(odst + off) = v; }
    }
#undef CONV_LOAD
#undef CONV_REMAP
#undef CONV_DECODE
}

__device__ void ph_norm(const P& p, const float* xlat, const float* xctx, int row_lo, int nrows, int wg0, int nwg, const float* g, const float* modl, int sub, bf16_t* H) {
    const int lane = TIDX & 63, wv = TIDX >> 6;
    if ((int)blockIdx.x < wg0) return;
    const int stride = nwg * 16;
    int row = row_lo + (((int)blockIdx.x - wg0) * 8 + wv) * 2;
    f32x4 v[2][4], nx[2][4], gg[4], s0[4]; int cur_mb = -1;
#define NORM_LOAD(dst, r_) { const bool ic_ = (r_) >= T; const float* xr_ = ic_ ? xctx + (size_t)((r_) - T) * D : xlat + (size_t)(r_) * D; \
        _Pragma("unroll") for (int rr = 0; rr < 2; ++rr) _Pragma("unroll") for (int i = 0; i < 4; ++i) dst[rr][i] = *(const f32x4*)(xr_ + rr * D + 8 * (lane + 64 * (i >> 1)) + 4 * (i & 1)); }
    if (row < nrows) NORM_LOAD(nx, row)
    while (row < nrows) {
#pragma unroll
        for (int rr = 0; rr < 2; ++rr)
#pragma unroll
            for (int i = 0; i < 4; ++i) v[rr][i] = nx[rr][i];
        const int nrow = row + stride;
        if (nrow < nrows) NORM_LOAD(nx, nrow)
        const int mb = (row >= T) ? 2 : (row >> 14);
        if (mb != cur_mb) { const float* sh = modl + mb * 9216 + (sub * 3) * 1024; const float* scp = sh + 1024;
#pragma unroll
            for (int i = 0; i < 4; ++i) { const int k = 8 * (lane + 64 * (i >> 1)) + 4 * (i & 1); gg[i] = *(const f32x4*)(g + k) * (*(const f32x4*)(scp + k) + 1.0f); s0[i] = *(const f32x4*)(sh + k); }
            cur_mb = mb; }
        float ss0 = 0.f, ss1 = 0.f;
#pragma unroll
        for (int i = 0; i < 4; ++i) { ss0 += v[0][i][0] * v[0][i][0] + v[0][i][1] * v[0][i][1] + v[0][i][2] * v[0][i][2] + v[0][i][3] * v[0][i][3];
            ss1 += v[1][i][0] * v[1][i][0] + v[1][i][1] * v[1][i][1] + v[1][i][2] * v[1][i][2] + v[1][i][3] * v[1][i][3]; }
#pragma unroll
        for (int o = 32; o >= 1; o >>= 1) { ss0 += __shfl_xor(ss0, o); ss1 += __shfl_xor(ss1, o); }
        const float rstd0 = rsqrtf(ss0 * (1.0f / D) + 1e-6f), rstd1 = rsqrtf(ss1 * (1.0f / D) + 1e-6f);
#pragma unroll
        for (int h2 = 0; h2 < 2; ++h2) { const int k = 8 * (lane + 64 * h2);
#pragma unroll
            for (int rr = 0; rr < 2; ++rr) { const float rs = rr ? rstd1 : rstd0;
                const f32x4 ya = v[rr][2 * h2] * rs * gg[2 * h2] + s0[2 * h2], yb = v[rr][2 * h2 + 1] * rs * gg[2 * h2 + 1] + s0[2 * h2 + 1];
                u32x4 w; w[0] = cvt_pk_bf16(ya[0], ya[1]); w[1] = cvt_pk_bf16(ya[2], ya[3]); w[2] = cvt_pk_bf16(yb[0], yb[1]); w[3] = cvt_pk_bf16(yb[2], yb[3]);
                *(u32x4*)(H + (size_t)(row + rr) * D + k) = w; } }
        row = nrow;
    }
#undef NORM_LOAD
}
__device__ void ph_final_norm(const P& p) {
    const int lane = TIDX & 63, wv = TIDX >> 6;
    const int stride = gridDim.x * 16;
    int row = (blockIdx.x * 8 + wv) * 2;
    f32x4 v[2][4], nx[2][4], gg[4];
#pragma unroll
    for (int i = 0; i < 4; ++i) gg[i] = *(const f32x4*)(p.final_g + 4 * (lane + 64 * i));
#define FN_LOAD(dst, r_) { const float* xr_ = p.out + (size_t)(r_) * D; \
        _Pragma("unroll") for (int rr = 0; rr < 2; ++rr) _Pragma("unroll") for (int i = 0; i < 4; ++i) dst[rr][i] = *(const f32x4*)(xr_ + rr * D + 4 * (lane + 64 * i)); }
    if (row < T) FN_LOAD(nx, row)
    while (row < T) {
#pragma unroll
        for (int rr = 0; rr < 2; ++rr)
#pragma unroll
            for (int i = 0; i < 4; ++i) v[rr][i] = nx[rr][i];
        const int nrow = row + stride;
        if (nrow < T) FN_LOAD(nx, nrow)
        float ss0 = 0.f, ss1 = 0.f;
#pragma unroll
        for (int i = 0; i < 4; ++i) { ss0 += v[0][i][0] * v[0][i][0] + v[0][i][1] * v[0][i][1] + v[0][i][2] * v[0][i][2] + v[0][i][3] * v[0][i][3];
            ss1 += v[1][i][0] * v[1][i][0] + v[1][i][1] * v[1][i][1] + v[1][i][2] * v[1][i][2] + v[1][i][3] * v[1][i][3]; }
#pragma unroll
        for (int o = 32; o >= 1; o >>= 1) { ss0 += __shfl_xor(ss0, o); ss1 += __shfl_xor(ss1, o); }
        const float rstd0 = rsqrtf(ss0 * (1.0f / D) + 1e-6f), rstd1 = rsqrtf(ss1 * (1.0f / D) + 1e-6f);
        float* xr = p.out + (size_t)row * D;
#pragma unroll
        for (int i = 0; i < 4; ++i) { const int k = 4 * (lane + 64 * i); *(f32x4*)(xr + k) = v[0][i] * rstd0 * gg[i]; *(f32x4*)(xr + D + k) = v[1][i] * rstd1 * gg[i]; }
        row = nrow;
    }
#undef FN_LOAD
}

__device__ void ph_na_naive(const P& p) {
    const bf16_t* R = (const bf16_t*)(p.ws + WS_R);
    const bf16_t* QA = R; const bf16_t* KA = R + (size_t)TP * 512; const bf16_t* VA = R + (size_t)2 * TP * 512;
    bf16_t* Y = (bf16_t*)(p.ws + WS_H);
    for (int u = blockIdx.x; u < 512; u += gridDim.x) {
        const int head = u & 7, token = (u >> 3) * 512 + TIDX, b = token >> 14, n = token & (NSEQ - 1), gi = n >> 6, gj = n & 63;
        const int r0 = min(max(gi - 4, 0), 248), c0 = min(max(gj - 8, 0), 48);
        float q[64], acc[64];
        { const u32x4* qp = (const u32x4*)(QA + (size_t)token * 512 + head * 64);
#pragma unroll
          for (int i = 0; i < 8; ++i) { const u32x4 w = qp[i];
#pragma unroll
              for (int e = 0; e < 4; ++e) { q[i * 8 + 2 * e] = bflo(w[e]) * 0.125f; q[i * 8 + 2 * e + 1] = bfhi(w[e]) * 0.125f; } } }
#pragma unroll
        for (int d = 0; d < 64; ++d) acc[d] = 0.f;
        float m = -1e30f, l = 0.f;
        const float* rp = p.na_rpb + head * 465;
#pragma unroll 1
        for (int kidx = 0; kidx < 384; ++kidx) {
            int krow; float bias = 0.f;
            if (kidx < 128) { const int a = kidx >> 4, kk = kidx & 15; krow = (b << 14) + (r0 + a) * 64 + c0 + kk; bias = rp[(r0 + a - gi + 7) * 31 + (c0 + kk - gj + 15)]; }
            else krow = T + b * 256 + (kidx - 128);
            const u32x4* kp = (const u32x4*)(KA + (size_t)krow * 512 + head * 64);
            float s = 0.f;
#pragma unroll
            for (int i = 0; i < 8; ++i) { const u32x4 w = kp[i];
#pragma unroll
                for (int e = 0; e < 4; ++e) { s += q[i * 8 + 2 * e] * bflo(w[e]); s += q[i * 8 + 2 * e + 1] * bfhi(w[e]); } }
            s += bias;
            const float mn = fmaxf(m, s), sc = __expf(m - mn), pw = __expf(s - mn);
            l = l * sc + pw; m = mn;
            const u32x4* vp = (const u32x4*)(VA + (size_t)krow * 512 + head * 64);
#pragma unroll
            for (int i = 0; i < 8; ++i) { const u32x4 w = vp[i];
#pragma unroll
                for (int e = 0; e < 4; ++e) { acc[i * 8 + 2 * e] = acc[i * 8 + 2 * e] * sc + pw * bflo(w[e]); acc[i * 8 + 2 * e + 1] = acc[i * 8 + 2 * e + 1] * sc + pw * bfhi(w[e]); } }
        }
        const float il = 1.0f / l;
        u32x4* yp = (u32x4*)(Y + (size_t)token * 1024 + head * 64);
#pragma unroll
        for (int i = 0; i < 8; ++i) { u32x4 w;
#pragma unroll
            for (int e = 0; e < 4; ++e) w[e] = cvt_pk_bf16(acc[i * 8 + 2 * e] * il, acc[i * 8 + 2 * e + 1] * il);
            yp[i] = w; }
    }
}

__device__ __forceinline__ int ml_chunk_row0(int b, int d, int j) {
    if (j < 2) { const int oc = d ? 1 - j : j; return T + b * 256 + oc * 128; }
    const int oc = d ? 129 - j : j - 2; return (b << 14) + oc * 128;
}
__device__ __forceinline__ void ml_load_tile(LAS unsigned char* dst, const bf16_t* src, const LAS float* rowscale) {
    for (int i = TIDX; i < 128 * 16; i += NTHR) { const int r = i >> 4, ch = i & 15;
        u32x4 w = *(const u32x4*)(src + (size_t)r * 512 + ch * 8);
        if (rowscale) { const float a = rowscale[r];
#pragma unroll
            for (int e = 0; e < 4; ++e) w[e] = cvt_pk_bf16(bflo(w[e]) * a, bfhi(w[e]) * a); }
        *(LAS u32x4*)(dst + r * PITCH + ch * 16) = w; }
}

__device__ void ph_mlA_naive(const P& p, LAS unsigned char* lds) {
    const bf16_t* R = (const bf16_t*)(p.ws + WS_R);
    const bf16_t* KB = R + (size_t)4 * TP * 512; const bf16_t* VB = R + (size_t)5 * TP * 512; const float* Gt = (const float*)(R + (size_t)7 * TP * 512);
    bf16_t* CL = (bf16_t*)(p.ws + WS_CL); float* VEC = (float*)(p.ws + WS_VEC); float* NL = (float*)(p.ws + WS_NL);
    LAS unsigned char* Kt = lds; LAS unsigned char* Vt = lds + 128 * PITCH; LAS float* av = (LAS float*)(lds + 2 * 128 * PITCH);
    const int tid = TIDX, lane = tid & 63;
    for (int slot = blockIdx.x; slot < NSLOT; slot += gridDim.x) {
        const int j = slot % 130, bhd = slot / 130, d = bhd & 1, h = (bhd >> 1) & 3, b = bhd >> 3;
        const int row0 = ml_chunk_row0(b, d, j);
        __syncthreads();
        if (tid < 64) {
            const int p0 = 2 * lane, p1 = 2 * lane + 1, t0 = d ? 127 - p0 : p0, t1 = d ? 127 - p1 : p1;
            const int gofs = (h * 2 + d) * 2;
            const float i0 = Gt[(size_t)(row0 + t0) * 16 + gofs], f0 = Gt[(size_t)(row0 + t0) * 16 + gofs + 1];
            const float i1 = Gt[(size_t)(row0 + t1) * 16 + gofs], f1 = Gt[(size_t)(row0 + t1) * 16 + gofs + 1];
            float s = f0 + f1;
#pragma unroll
            for (int o = 1; o < 64; o <<= 1) { const float t = __shfl_up(s, o); if (lane >= o) s += t; }
            const float b1 = s, b0 = s - f1, z0 = i0 - b0, z1 = i1 - b1;
            float cmx = fmaxf(z0, z1);
#pragma unroll
            for (int o = 1; o < 64; o <<= 1) { const float t = __shfl_up(cmx, o); if (lane >= o) cmx = fmaxf(cmx, t); }
            float prev = __shfl_up(cmx, 1); if (lane == 0) prev = -1e30f;
            const float cm0 = fmaxf(prev, z0), cm1 = cmx;
            const float btot = __shfl(b1, 63), cml = __shfl(cm1, 63);
            float* vz = VEC + (size_t)slot * 512;
            vz[t0] = z0; vz[t1] = z1; vz[128 + t0] = b0; vz[128 + t1] = b1; vz[256 + t0] = cm0; vz[256 + t1] = cm1;
            if (lane == 0) { vz[384] = btot; vz[385] = btot + cml; }
            av[t0] = __expf(z0 - cml); av[t1] = __expf(z1 - cml);
        }
        __syncthreads();
        ml_load_tile(Kt, KB + (size_t)row0 * 512 + h * 128, nullptr);
        ml_load_tile(Vt, VB + (size_t)row0 * 512 + h * 128, av);
        __syncthreads();
        {
            const int v = tid >> 2, kq = tid & 3;
            float acc[32];
#pragma unroll
            for (int i = 0; i < 32; ++i) acc[i] = 0.f;
#pragma unroll 1
            for (int s = 0; s < 128; ++s) {
                const float avv = bf2f(*(const LAS bf16_t*)(Vt + s * PITCH + v * 2));
#pragma unroll
                for (int c = 0; c < 4; ++c) { const u32x4 w = *(const LAS u32x4*)(Kt + s * PITCH + kq * 64 + c * 16);
#pragma unroll
                    for (int e = 0; e < 4; ++e) { acc[c * 8 + 2 * e] += avv * bflo(w[e]); acc[c * 8 + 2 * e + 1] += avv * bfhi(w[e]); } }
            }
            bf16_t* cp = CL + (size_t)slot * 16384 + v * 128 + kq * 32;
#pragma unroll
            for (int c = 0; c < 4; ++c) { u32x4 w;
#pragma unroll
                for (int e = 0; e < 4; ++e) w[e] = cvt_pk_bf16(acc[c * 8 + 2 * e], acc[c * 8 + 2 * e + 1]);
                *(u32x4*)(cp + c * 8) = w; }
            if (tid < 128) { float sacc = 0.f; for (int s = 0; s < 128; ++s) sacc += av[s] * bf2f(*(const LAS bf16_t*)(Kt + s * PITCH + tid * 2)); NL[(size_t)slot * 128 + tid] = sacc; }
        }
    }
}

__device__ void ph_mlB(const P& p, LAS unsigned char* lds) {
    unsigned* CL = (unsigned*)(p.ws + WS_CL); float* VEC = (float*)(p.ws + WS_VEC); float* NL = (float*)(p.ws + WS_NL);
    LAS float* sb = (LAS float*)lds;
    const int tid = TIDX;
    for (int w = blockIdx.x; w < 16 * 16; w += gridDim.x) {
        const int stream = w >> 4, e2 = (w & 15) * 512 + tid;
        __syncthreads();
        if (tid < 130) { const float* vz = VEC + (size_t)(stream * 130 + tid) * 512 + 384; sb[2 * tid] = vz[0]; sb[2 * tid + 1] = vz[1]; }
        __syncthreads();
        float m = 0.f, c0 = 0.f, c1 = 0.f, n0 = 0.f, n1 = 0.f;
        const bool do_n = (w & 15) == 0 && tid < 64;
        unsigned* cp = CL + (size_t)stream * 130 * 8192 + e2;
        float* np = NL + (size_t)stream * 130 * 128 + 2 * tid;
        unsigned cl[13], cn[13]; f32x2 nlv[13], nnv[13];
#pragma unroll
        for (int jj = 0; jj < 13; ++jj) cn[jj] = cp[(size_t)jj * 8192];
        if (do_n) {
#pragma unroll
            for (int jj = 0; jj < 13; ++jj) nnv[jj] = *(const f32x2*)(np + (size_t)jj * 128);
        }
        for (int j0 = 0; j0 < 130; j0 += 13) {
#pragma unroll
            for (int jj = 0; jj < 13; ++jj) { cl[jj] = cn[jj]; nlv[jj] = nnv[jj]; }
            if (j0 + 13 < 130) {
#pragma unroll
                for (int jj = 0; jj < 13; ++jj) cn[jj] = cp[(size_t)(j0 + 13 + jj) * 8192];
                if (do_n) {
#pragma unroll
                    for (int jj = 0; jj < 13; ++jj) nnv[jj] = *(const f32x2*)(np + (size_t)(j0 + 13 + jj) * 128);
                }
            }
#pragma unroll
            for (int jj = 0; jj < 13; ++jj) {
                const int j = j0 + jj;
                const float btot = sb[2 * j], mloc = sb[2 * j + 1];
                cp[(size_t)j * 8192] = cvt_pk_bf16(c0, c1);
                const float mn = fmaxf(btot + m, mloc), ap = __expf(btot + m - mn), al = __expf(mloc - mn);
                if (do_n) { *(f32x2*)(np + (size_t)j * 128) = (f32x2){n0, n1}; n0 = ap * n0 + al * nlv[jj][0]; n1 = ap * n1 + al * nlv[jj][1]; }
                if ((w & 15) == 0 && tid == 0) VEC[(size_t)(stream * 130 + j) * 512 + 386] = m;
                c0 = ap * c0 + al * bflo(cl[jj]); c1 = ap * c1 + al * bfhi(cl[jj]); m = mn;
            }
        }
    }
}

__device__ void ph_mlC_naive(const P& p, LAS unsigned char* lds) {
    const bf16_t* R = (const bf16_t*)(p.ws + WS_R);
    const bf16_t* QB = R + (size_t)3 * TP * 512; const bf16_t* KB = R + (size_t)4 * TP * 512; const bf16_t* VB = R + (size_t)5 * TP * 512; const bf16_t* OB = R + (size_t)6 * TP * 512;
    const bf16_t* CL = (const bf16_t*)(p.ws + WS_CL); const float* VEC = (const float*)(p.ws + WS_VEC); const float* NL = (const float*)(p.ws + WS_NL);
    bf16_t* Y = (bf16_t*)(p.ws + WS_H);
    LAS unsigned char* Qt = lds; LAS unsigned char* Kt = lds + 128 * PITCH; LAS unsigned char* Vt = lds + 2 * 128 * PITCH; LAS unsigned char* Ct = lds + 3 * 128 * PITCH;
    LAS float* vz = (LAS float*)(lds + 4 * 128 * PITCH); LAS float* vb = vz + 128; LAS float* vcm = vb + 128; LAS float* vn = vcm + 128;
    const int tid = TIDX, t = tid >> 2, vq = tid & 3;
    for (int u = blockIdx.x; u < 1024; u += gridDim.x) {
        const int oc = u & 127, h = (u >> 7) & 3, b = u >> 9;
        const int row0 = (b << 14) + oc * 128;
        float hsum[32];
#pragma unroll
        for (int i = 0; i < 32; ++i) hsum[i] = 0.f;
        for (int d = 0; d < 2; ++d) {
            const int j = d ? 129 - oc : oc + 2, slot = ((b * 4 + h) * 2 + d) * 130 + j;
            __syncthreads();
            ml_load_tile(Qt, QB + (size_t)row0 * 512 + h * 128, nullptr);
            ml_load_tile(Kt, KB + (size_t)row0 * 512 + h * 128, nullptr);
            ml_load_tile(Vt, VB + (size_t)row0 * 512 + h * 128, nullptr);
            for (int i = tid; i < 128 * 16; i += NTHR) { const int r = i >> 4, ch = i & 15; *(LAS u32x4*)(Ct + r * PITCH + ch * 16) = *(const u32x4*)(CL + (size_t)slot * 16384 + r * 128 + ch * 8); }
            if (tid < 128) { const float* vp = VEC + (size_t)slot * 512; vz[tid] = vp[tid]; vb[tid] = vp[128 + tid]; vcm[tid] = vp[256 + tid]; vn[tid] = NL[(size_t)slot * 128 + tid]; }
            const float mprev = VEC[(size_t)slot * 512 + 386];
            __syncthreads();
            const float ut = -fmaxf(mprev, vcm[t]), winter = __expf(mprev + ut), flo = __expf(ut - vb[t]);
            float sc[32];
#pragma unroll
            for (int i = 0; i < 32; ++i) sc[i] = 0.f;
            float nq = 0.f;
#pragma unroll 1
            for (int kc = 0; kc < 16; ++kc) {
                const u32x4 qw = *(const LAS u32x4*)(Qt + t * PITCH + kc * 16);
                float qf[8];
#pragma unroll
                for (int e = 0; e < 4; ++e) { qf[2 * e] = bflo(qw[e]); qf[2 * e + 1] = bfhi(qw[e]); }
                if ((kc >> 2) == vq) {
#pragma unroll
                    for (int e = 0; e < 8; ++e) nq += qf[e] * vn[kc * 8 + e]; }
#pragma unroll
                for (int si = 0; si < 32; ++si) { const u32x4 kw = *(const LAS u32x4*)(Kt + (32 * vq + si) * PITCH + kc * 16);
#pragma unroll
                    for (int e = 0; e < 4; ++e) { sc[si] += qf[2 * e] * bflo(kw[e]); sc[si] += qf[2 * e + 1] * bfhi(kw[e]); }
                    asm volatile("" ::: "memory"); }
            }
            float rs = 0.f;
            int tt = t, s_base = 32 * vq; asm volatile("" : "+v"(tt), "+v"(s_base));
#pragma unroll
            for (int si = 0; si < 32; ++si) { const int s = s_base + si; const bool ok = d ? (s >= tt) : (s <= tt);
                const float w = ok ? __expf(ut + vz[s]) : 0.f; sc[si] *= w; rs += sc[si]; }
            rs += __shfl_xor(rs, 1); rs += __shfl_xor(rs, 2);
            nq += __shfl_xor(nq, 1); nq += __shfl_xor(nq, 2);
            __syncthreads();
#pragma unroll
            for (int c = 0; c < 4; ++c) { u32x4 w;
#pragma unroll
                for (int e = 0; e < 4; ++e) w[e] = cvt_pk_bf16(sc[c * 8 + 2 * e], sc[c * 8 + 2 * e + 1]);
                *(LAS u32x4*)(Kt + t * PITCH + vq * 64 + c * 16) = w; }
            __syncthreads();
            const float den = winter * nq + rs, dd = 1.0f / fmaxf(fabsf(den), flo);
#pragma unroll
            for (int hv = 0; hv < 2; ++hv) {
                float num[16];
#pragma unroll
                for (int i = 0; i < 16; ++i) num[i] = 0.f;
#pragma unroll 1
                for (int kc = 0; kc < 16; ++kc) {
                    const u32x4 qw = *(const LAS u32x4*)(Qt + t * PITCH + kc * 16);
                    float qf[8];
#pragma unroll
                    for (int e = 0; e < 4; ++e) { qf[2 * e] = bflo(qw[e]); qf[2 * e + 1] = bfhi(qw[e]); }
#pragma unroll
                    for (int vi = 0; vi < 16; ++vi) { const u32x4 cw = *(const LAS u32x4*)(Ct + (32 * vq + 16 * hv + vi) * PITCH + kc * 16);
#pragma unroll
                        for (int e = 0; e < 4; ++e) { num[vi] += qf[2 * e] * bflo(cw[e]); num[vi] += qf[2 * e + 1] * bfhi(cw[e]); }
                        asm volatile("" ::: "memory"); }
                }
#pragma unroll
                for (int i = 0; i < 16; ++i) num[i] *= winter;
#pragma unroll 1
                for (int s8 = 0; s8 < 16; ++s8) {
                    const u32x4 pw = *(const LAS u32x4*)(Kt + t * PITCH + s8 * 16);
                    float pf[8];
#pragma unroll
                    for (int e = 0; e < 4; ++e) { pf[2 * e] = bflo(pw[e]); pf[2 * e + 1] = bfhi(pw[e]); }
#pragma unroll
                    for (int ss = 0; ss < 8; ++ss) {
#pragma unroll
                        for (int c = 0; c < 2; ++c) { const u32x4 vw = *(const LAS u32x4*)(Vt + (s8 * 8 + ss) * PITCH + vq * 64 + hv * 32 + c * 16);
#pragma unroll
                            for (int e = 0; e < 4; ++e) { num[c * 8 + 2 * e] += pf[ss] * bflo(vw[e]); num[c * 8 + 2 * e + 1] += pf[ss] * bfhi(vw[e]); } }
                        asm volatile("" ::: "memory"); }
                }
#pragma unroll
                for (int i = 0; i < 16; ++i) hsum[hv * 16 + i] += num[i] * dd;
            }
        }
        float ss = 0.f;
#pragma unroll
        for (int i = 0; i < 32; ++i) ss += hsum[i] * hsum[i];
        ss += __shfl_xor(ss, 1); ss += __shfl_xor(ss, 2);
        const float rstd = rsqrtf(ss * (1.0f / 128.0f) + 1e-6f);
        const int row = row0 + t;
        const bf16_t* op = OB + (size_t)row * 512 + h * 128 + vq * 32; const float* hg = p.ml_head_g + h * 128 + vq * 32;
        bf16_t* yp = Y + (size_t)row * 1024 + 512 + h * 128 + vq * 32;
#pragma unroll
        for (int c = 0; c < 4; ++c) { const u32x4 ow = *(const u32x4*)(op + c * 8); u32x4 w;
#pragma unroll
            for (int e = 0; e < 4; ++e) { const int i0 = c * 8 + 2 * e;
                const float y0 = hsum[i0] * rstd * hg[i0] * sigmoid_f(bflo(ow[e])), y1 = hsum[i0 + 1] * rstd * hg[i0 + 1] * sigmoid_f(bfhi(ow[e]));
                w[e] = cvt_pk_bf16(y0, y1); }
            *(u32x4*)(yp + c * 8) = w; }
    }
}

__device__ void ph_sg_stats(const P& p) {
    const bf16_t* V = (const bf16_t*)(p.ws + WS_R) + (size_t)T * 2048; float* ST = (float*)(p.ws + WS_ST);
    const int lane = TIDX & 63, wv = TIDX >> 6;
    for (int row = blockIdx.x * 8 + wv; row < T; row += gridDim.x * 8) {
        float vals[32]; float s = 0.f;
#pragma unroll
        for (int i = 0; i < 4; ++i) { const u32x4 w = *(const u32x4*)(V + (size_t)row * 2048 + 8 * (lane + 64 * i));
#pragma unroll
            for (int e = 0; e < 4; ++e) { vals[i * 8 + 2 * e] = bflo(w[e]); vals[i * 8 + 2 * e + 1] = bfhi(w[e]); s += vals[i * 8 + 2 * e] + vals[i * 8 + 2 * e + 1]; } }
#pragma unroll
        for (int o = 32; o >= 1; o >>= 1) s += __shfl_xor(s, o);
        const float mu = s * (1.0f / 2048.0f); float q = 0.f;
#pragma unroll
        for (int i = 0; i < 32; ++i) { const float dlt = vals[i] - mu; q += dlt * dlt; }
#pragma unroll
        for (int o = 32; o >= 1; o >>= 1) q += __shfl_xor(q, o);
        if (lane == 0) { ST[2 * row] = mu; ST[2 * row + 1] = rsqrtf(q * (1.0f / 2048.0f) + 1e-6f); }
    }
}
__device__ void ph_sg_naive(const P& p, LAS unsigned char* lds) {
    bf16_t* U = (bf16_t*)(p.ws + WS_R); const bf16_t* V = U + (size_t)T * 2048; const float* ST = (const float*)(p.ws + WS_ST);
    constexpr int VP = 528;
    LAS unsigned char* Vn = lds; LAS unsigned char* Wt = lds + 128 * VP;
    const int tid = TIDX, t = tid >> 2, dq = tid & 3;
    for (int u = blockIdx.x; u < 2048; u += gridDim.x) {
        const int g = u & 7, ch = u >> 3, row0 = ch * 128;
        __syncthreads();
        for (int i = tid; i < 128 * 32; i += NTHR) { const int r = i >> 5, c8 = i & 31; const int cbase = g * 256 + c8 * 8;
            const u32x4 w = *(const u32x4*)(V + (size_t)(row0 + r) * 2048 + cbase); const float mu = ST[2 * (row0 + r)], rs = ST[2 * (row0 + r) + 1];
            const f32x4 g0 = *(const f32x4*)(p.sg_ln_g + cbase), g1 = *(const f32x4*)(p.sg_ln_g + cbase + 4), b0 = *(const f32x4*)(p.sg_ln_b + cbase), b1 = *(const f32x4*)(p.sg_ln_b + cbase + 4);
            u32x4 o;
            o[0] = cvt_pk_bf16((bflo(w[0]) - mu) * rs * g0[0] + b0[0], (bfhi(w[0]) - mu) * rs * g0[1] + b0[1]);
            o[1] = cvt_pk_bf16((bflo(w[1]) - mu) * rs * g0[2] + b0[2], (bfhi(w[1]) - mu) * rs * g0[3] + b0[3]);
            o[2] = cvt_pk_bf16((bflo(w[2]) - mu) * rs * g1[0] + b1[0], (bfhi(w[2]) - mu) * rs * g1[1] + b1[1]);
            o[3] = cvt_pk_bf16((bflo(w[3]) - mu) * rs * g1[2] + b1[2], (bfhi(w[3]) - mu) * rs * g1[3] + b1[3]);
            *(LAS u32x4*)(Vn + r * VP + c8 * 16) = o; }
        for (int i = tid; i < 128 * 32; i += NTHR) { const int r = i >> 5, c4 = i & 31; const f32x4 w = *(const f32x4*)(p.sg_w_s + (size_t)g * 16384 + r * 128 + c4 * 4);
            u32x2 o; o.x = cvt_pk_bf16(w[0], w[1]); o.y = cvt_pk_bf16(w[2], w[3]); *(LAS u32x2*)(Wt + r * PITCH + c4 * 8) = o; }
        __syncthreads();
        float acc[64];
#pragma unroll
        for (int i = 0; i < 64; ++i) acc[i] = 0.f;
#pragma unroll 1
        for (int s8 = 0; s8 < 16; ++s8) {
            const u32x4 ww = *(const LAS u32x4*)(Wt + t * PITCH + s8 * 16);
            float wf[8];
#pragma unroll
            for (int e = 0; e < 4; ++e) { wf[2 * e] = bflo(ww[e]); wf[2 * e + 1] = bfhi(ww[e]); }
#pragma unroll
            for (int ss = 0; ss < 8; ++ss) {
#pragma unroll
                for (int c = 0; c < 8; ++c) { const u32x4 vw = *(const LAS u32x4*)(Vn + (s8 * 8 + ss) * VP + dq * 128 + c * 16);
#pragma unroll
                    for (int e = 0; e < 4; ++e) { acc[c * 8 + 2 * e] += wf[ss] * bflo(vw[e]); acc[c * 8 + 2 * e + 1] += wf[ss] * bfhi(vw[e]); }
                    if ((c & 3) == 3) asm volatile("" ::: "memory"); } }
        }
        const float bs = p.sg_b_s[g * 128 + t];
        bf16_t* up = U + (size_t)(row0 + t) * 2048 + g * 256 + dq * 64;
#pragma unroll
        for (int c = 0; c < 8; ++c) { const u32x4 uw = *(const u32x4*)(up + c * 8); u32x4 o;
#pragma unroll
            for (int e = 0; e < 4; ++e) o[e] = cvt_pk_bf16(bflo(uw[e]) * (acc[c * 8 + 2 * e] + bs), bfhi(uw[e]) * (acc[c * 8 + 2 * e + 1] + bs));
            *(u32x4*)(up + c * 8) = o; }
    }
}

typedef short s16x4 __attribute__((ext_vector_type(4)));
__device__ __forceinline__ s16x4 ds_tr(LAS unsigned char* a) { return __builtin_amdgcn_ds_read_tr16_b64_v4i16((LAS s16x4*)a); }
__device__ __forceinline__ bf16x8 cat8(s16x4 lo, s16x4 hi) { return __builtin_shufflevector(lo, hi, 0, 1, 2, 3, 4, 5, 6, 7); }
__device__ __forceinline__ f32x4 mfma16(bf16x8 a, bf16x8 b, f32x4 c) { return __builtin_amdgcn_mfma_f32_16x16x32_bf16(a, b, c, 0, 0, 0); }
__device__ __forceinline__ bf16x8 pk8(f32x4 a, f32x4 b) { u32x4 w; w[0] = cvt_pk_bf16(a[0], a[1]); w[1] = cvt_pk_bf16(a[2], a[3]); w[2] = cvt_pk_bf16(b[0], b[1]); w[3] = cvt_pk_bf16(b[2], b[3]); return __builtin_bit_cast(bf16x8, w); }
constexpr int TPI = 304;
__device__ __forceinline__ void ml_load_tile2(LAS unsigned char* dst, const bf16_t* src, int srcstride, const LAS float* rowscale, int tid) {
    for (int i = tid; i < 128 * 16; i += NTHR) { const int r = i >> 4, ch = i & 15;
        u32x4 w = *(const u32x4*)(src + (size_t)r * srcstride + ch * 8);
        if (rowscale) { const float a = rowscale[r];
#pragma unroll
            for (int e = 0; e < 4; ++e) w[e] = cvt_pk_bf16(bflo(w[e]) * a, bfhi(w[e]) * a); }
        *(LAS u32x4*)(dst + r * TPI + ch * 16) = w; }
}

__device__ void ph_na(const P& p, LAS unsigned char* lds) {
    const bf16_t* R = (const bf16_t*)(p.ws + WS_R);
    const bf16_t* QA = R; const bf16_t* KA = R + (size_t)TP * 512; const bf16_t* VA = R + (size_t)2 * TP * 512;
    bf16_t* Y = (bf16_t*)(p.ws + WS_H);
    constexpr int VP = 144;
    LAS unsigned char* Vl = lds; LAS unsigned char* Vc = lds + 512 * VP;
    LAS float* comb = (LAS float*)(lds + 768 * VP); LAS float* rpbs = comb + 4 * 18 * 64;
    const int tid = TIDX, lane = tid & 63, w = __builtin_amdgcn_readfirstlane(tid >> 6), c = lane & 15, g = lane >> 4, qb = w & 3, half = w >> 2;
    const int qq = (lane & 15) >> 2, pp = lane & 3;
    const int per = (4096 + gridDim.x - 1) / gridDim.x;
    const int u_lo = blockIdx.x * per, u_hi = min(u_lo + per, 4096);
    int last_bh = -1;
    const int cstart = (qb == 0) ? 0 : (qb == 1) ? 8 : (qb == 2) ? 24 : 32;
    u32x4 vnew = {0u, 0u, 0u, 0u}; int pf_row = -1; bf16x8 qn[2] = {};
    int crm[2][4];
    { const int qcol = 16 * qb + c, c0 = min(max(qcol - 8, 0), 48);
#pragma unroll
      for (int chh = 0; chh < 2; ++chh)
#pragma unroll
          for (int j = 0; j < 4; ++j) { const int col = cstart + 16 * chh + 4 * g + j; crm[chh][j] = ((col >= c0) && (col < c0 + 16)) ? (col - qcol + 15) : 31; } }
    for (int u = u_lo; u < u_hi; ++u) {
        const int gi = u & 255, bh = u >> 8, head = bh & 7, b = bh >> 3;
        const int r0 = min(max(gi - 4, 0), 248);
        const int token = (b << 14) + gi * 64 + 16 * qb + c;
        bf16x8 qf[2];
        if (bh != last_bh) {
            for (int i = tid; i < 256 * 8; i += NTHR) { const int key = i >> 3, ch = i & 7;
                *(LAS u32x4*)(Vc + key * VP + ch * 16) = *(const u32x4*)(VA + (size_t)(T + b * 256 + key) * 512 + head * 64 + ch * 8); }
            if (tid < 480) { const int rr = tid >> 5, cc = tid & 31; rpbs[tid] = (cc < 31) ? p.na_rpb[head * 465 + rr * 31 + cc] * 1.4426950408889634f : -1e30f; }
            for (int i = tid; i < 512 * 8; i += NTHR) { const int key = i >> 3, ch = i & 7, row = r0 + (key >> 6);
                *(LAS u32x4*)(Vl + ((row & 7) * 64 + (key & 63)) * VP + ch * 16) = *(const u32x4*)(VA + (size_t)((b << 14) + row * 64 + (key & 63)) * 512 + head * 64 + ch * 8); }
            qf[0] = *(const bf16x8*)(QA + (size_t)token * 512 + head * 64 + 8 * g); qf[1] = *(const bf16x8*)(QA + (size_t)token * 512 + head * 64 + 32 + 8 * g);
            last_bh = bh;
        } else {
            if (pf_row >= 0) *(LAS u32x4*)(Vl + ((pf_row & 7) * 64 + (tid >> 3)) * VP + (tid & 7) * 16) = vnew;
            qf[0] = qn[0]; qf[1] = qn[1];
        }
        __syncthreads();
        pf_row = -1;
        if (u + 1 < u_hi && ((u + 1) >> 8) == bh) {
            const int gin = gi + 1, r0n = min(max(gin - 4, 0), 248);
            if (r0n != r0) { pf_row = r0n + 7; vnew = *(const u32x4*)(VA + (size_t)((b << 14) + pf_row * 64 + (tid >> 3)) * 512 + head * 64 + (tid & 7) * 8); }
            const size_t tn = (size_t)((b << 14) + gin * 64 + 16 * qb + c) * 512 + head * 64 + 8 * g;
            qn[0] = *(const bf16x8*)(QA + tn); qn[1] = *(const bf16x8*)(QA + tn + 32);
        }
        f32x4 sc[16];
        const LAS float* rrow = rpbs + (r0 - gi + 7) * 32;
#pragma unroll
        for (int kt = 0; kt < 16; ++kt) {
            const int a = kt >> 1, chh = kt & 1;
            const int krow = half ? (T + b * 256 + 16 * kt + c) : ((b << 14) + (r0 + a) * 64 + cstart + 16 * chh + c);
            const bf16_t* kp = KA + (size_t)krow * 512 + head * 64 + 8 * g;
            const bf16x8 A0 = *(const bf16x8*)kp, A1 = *(const bf16x8*)(kp + 32);
            f32x4 acc = {0.f, 0.f, 0.f, 0.f};
            acc = mfma16(A0, qf[0], acc); acc = mfma16(A1, qf[1], acc);
            if (half == 0) {
#pragma unroll
                for (int j = 0; j < 4; ++j) acc[j] = acc[j] * 0.18033688011112042f + rrow[a * 32 + crm[chh][j]];
            } else acc = acc * 0.18033688011112042f;
            sc[kt] = acc;
        }
        float m = -1e30f;
#pragma unroll
        for (int kt = 0; kt < 16; ++kt) m = fmaxf(m, fmaxf(fmaxf(sc[kt][0], sc[kt][1]), fmaxf(sc[kt][2], sc[kt][3])));
        m = fmaxf(m, __shfl_xor(m, 16)); m = fmaxf(m, __shfl_xor(m, 32));
        float l = 0.f;
#pragma unroll
        for (int kt = 0; kt < 16; ++kt) {
#pragma unroll
            for (int j = 0; j < 4; ++j) { const float e = __builtin_amdgcn_exp2f(sc[kt][j] - m); sc[kt][j] = e; l += e; } }
        l += __shfl_xor(l, 16); l += __shfl_xor(l, 32);
        f32x4 o[4];
#pragma unroll
        for (int dt = 0; dt < 4; ++dt) o[dt] = (f32x4){0.f, 0.f, 0.f, 0.f};
#pragma unroll
        for (int kp = 0; kp < 8; ++kp) {
            const bf16x8 pf = pk8(sc[2 * kp], sc[2 * kp + 1]);
            LAS unsigned char* vb = half ? (Vc + (32 * kp + 4 * g + qq) * VP + 8 * pp) : (Vl + ((((r0 + kp) & 7) * 64) + cstart + 4 * g + qq) * VP + 8 * pp);
#pragma unroll
            for (int dt = 0; dt < 4; ++dt) { const s16x4 lo = ds_tr(vb + dt * 32), hi = ds_tr(vb + 16 * VP + dt * 32); o[dt] = mfma16(cat8(lo, hi), pf, o[dt]); }
        }
        if (half == 1) { LAS float* cb = comb + qb * 18 * 64 + lane; cb[0] = m; cb[64] = l;
#pragma unroll
            for (int dt = 0; dt < 4; ++dt)
#pragma unroll
                for (int j = 0; j < 4; ++j) cb[(2 + 4 * dt + j) * 64] = o[dt][j]; }
        __syncthreads();
        if (half == 0) { const LAS float* cb = comb + qb * 18 * 64 + lane; const float m1 = cb[0], l1 = cb[64];
            const float M = fmaxf(m, m1), e0 = __builtin_amdgcn_exp2f(m - M), e1 = __builtin_amdgcn_exp2f(m1 - M), il = 1.0f / (l * e0 + l1 * e1);
            bf16_t* yp = Y + (size_t)token * 1024 + head * 64 + 4 * g;
#pragma unroll
            for (int dt = 0; dt < 4; ++dt) { f32x4 r;
#pragma unroll
                for (int j = 0; j < 4; ++j) r[j] = (o[dt][j] * e0 + cb[(2 + 4 * dt + j) * 64] * e1) * il;
                u32x2 wv; wv.x = cvt_pk_bf16(r[0], r[1]); wv.y = cvt_pk_bf16(r[2], r[3]); *(u32x2*)(yp + 16 * dt) = wv; } }
    }
}

__device__ void ph_na2(const P& p, LAS unsigned char* lds) {
    const bf16_t* R = (const bf16_t*)(p.ws + WS_R);
    const bf16_t* QA = R; const bf16_t* KA = R + (size_t)TP * 512; const bf16_t* VA = R + (size_t)2 * TP * 512;
    bf16_t* Y = (bf16_t*)(p.ws + WS_H);
    constexpr int VP = 144, RING = 11;
    LAS unsigned char* Vl = lds; LAS unsigned char* Vc = lds + RING * 64 * VP; LAS float* rpbs = (LAS float*)(lds + (RING * 64 + 256) * VP);
    const int tid = TIDX, lane = tid & 63, w = __builtin_amdgcn_readfirstlane(tid >> 6), c = lane & 15, g = lane >> 4, qb = w & 3, ur = w >> 2;
    const int qq = (lane & 15) >> 2, pp = lane & 3;
    const int per = (4096 + gridDim.x - 1) / gridDim.x;
    const int u_lo = blockIdx.x * per, u_hi = min(u_lo + per, 4096);
    int last_bh = -1, have_hi = -1;
    const int cstart = (qb == 0) ? 0 : (qb == 1) ? 8 : (qb == 2) ? 24 : 32;
    u32x4 vnew0 = {0u, 0u, 0u, 0u}, vnew1 = vnew0; int pf_n = 0; bf16x8 qn[2] = {};
    int crm[2][4];
    { const int qcol = 16 * qb + c, c0 = min(max(qcol - 8, 0), 48);
#pragma unroll
      for (int chh = 0; chh < 2; ++chh)
#pragma unroll
          for (int j = 0; j < 4; ++j) { const int col = cstart + 16 * chh + 4 * g + j; crm[chh][j] = ((col >= c0) && (col < c0 + 16)) ? (col - qcol + 15) : 31; } }
    for (int u0 = u_lo; u0 < u_hi; u0 += 2) {
        const int bh = u0 >> 8, head = bh & 7, b = bh >> 3, gi0 = u0 & 255;
        const int r0a = min(max(gi0 - 4, 0), 248), r0b = min(max(gi0 - 3, 0), 248);
        const int gi = gi0 + ur, r0 = ur ? r0b : r0a;
        const bool valid = (u0 + ur) < u_hi;
        const int token = (b << 14) + gi * 64 + 16 * qb + c;
        bf16x8 qf[2];
        if (bh != last_bh) {
            __syncthreads();
            for (int i = tid; i < 256 * 8; i += NTHR) { const int key = i >> 3, ch = i & 7;
                *(LAS u32x4*)(Vc + key * VP + ch * 16) = *(const u32x4*)(VA + (size_t)(T + b * 256 + key) * 512 + head * 64 + ch * 8); }
            if (tid < 480) { const int rr = tid >> 5, cc = tid & 31; rpbs[tid] = (cc < 31) ? p.na_rpb[head * 465 + rr * 31 + cc] * 1.4426950408889634f : -1e30f; }
            for (int i = tid; i < 9 * 64 * 8; i += NTHR) { const int key = i >> 3, ch = i & 7, row = r0a + (key >> 6);
                if (row <= r0b + 7) *(LAS u32x4*)(Vl + ((row % RING) * 64 + (key & 63)) * VP + ch * 16) = *(const u32x4*)(VA + (size_t)((b << 14) + row * 64 + (key & 63)) * 512 + head * 64 + ch * 8); }
            qf[0] = *(const bf16x8*)(QA + (size_t)token * 512 + head * 64 + 8 * g); qf[1] = *(const bf16x8*)(QA + (size_t)token * 512 + head * 64 + 32 + 8 * g);
            last_bh = bh; have_hi = r0b + 7;
        } else {
            if (pf_n > 0) *(LAS u32x4*)(Vl + (((have_hi + 1) % RING) * 64 + (tid >> 3)) * VP + (tid & 7) * 16) = vnew0;
            if (pf_n > 1) *(LAS u32x4*)(Vl + (((have_hi + 2) % RING) * 64 + (tid >> 3)) * VP + (tid & 7) * 16) = vnew1;
            have_hi += pf_n;
            qf[0] = qn[0]; qf[1] = qn[1];
        }
        __syncthreads();
        pf_n = 0;
        if (u0 + 2 < u_hi && ((u0 + 2) >> 8) == bh) {
            const int need_hi = min(max(gi0 - 1, 0), 248) + 7;
            pf_n = need_hi - have_hi;
            if (pf_n > 0) vnew0 = *(const u32x4*)(VA + (size_t)((b << 14) + (have_hi + 1) * 64 + (tid >> 3)) * 512 + head * 64 + (tid & 7) * 8);
            if (pf_n > 1) vnew1 = *(const u32x4*)(VA + (size_t)((b << 14) + (have_hi + 2) * 64 + (tid >> 3)) * 512 + head * 64 + (tid & 7) * 8);
            const size_t tn = (size_t)((b << 14) + (gi + 2) * 64 + 16 * qb + c) * 512 + head * 64 + 8 * g;
            qn[0] = *(const bf16x8*)(QA + tn); qn[1] = *(const bf16x8*)(QA + tn + 32);
        }
        if (valid) {
            const LAS float* rrow = rpbs + (r0 - gi + 7) * 32;
            const bf16_t* kl = KA + (size_t)((b << 14) + r0 * 64 + cstart + c) * 512 + head * 64 + 8 * g;
            const bf16_t* kc = KA + (size_t)(T + b * 256 + c) * 512 + head * 64 + 8 * g;
            float M = -1e30f, L = 0.f;
            f32x4 o[4];
#pragma unroll
            for (int dt = 0; dt < 4; ++dt) o[dt] = (f32x4){0.f, 0.f, 0.f, 0.f};
#pragma unroll 1
            for (int hf = 0; hf < 2; ++hf) {
                f32x4 sc[16];
#pragma unroll
                for (int kt = 0; kt < 16; ++kt) {
                    const int a = kt >> 1, chh = kt & 1;
                    const bf16_t* kp = hf ? kc : kl;
                    if (hf) kc += 16 * 512; else kl += (chh ? 48 : 16) * 512;
                    const bf16x8 A0 = *(const bf16x8*)kp, A1 = *(const bf16x8*)(kp + 32);
                    f32x4 acc = {0.f, 0.f, 0.f, 0.f};
                    acc = mfma16(A0, qf[0], acc); acc = mfma16(A1, qf[1], acc);
                    if (hf == 0) {
#pragma unroll
                        for (int j = 0; j < 4; ++j) acc[j] = acc[j] * 0.18033688011112042f + rrow[a * 32 + crm[chh][j]];
                    } else acc = acc * 0.18033688011112042f;
                    sc[kt] = acc;
                    if ((kt & 7) == 7) asm volatile("" : "+v"(kl), "+v"(kc) :: "memory");
                }
                float m = -1e30f;
#pragma unroll
                for (int kt = 0; kt < 16; ++kt) m = fmaxf(m, fmaxf(fmaxf(sc[kt][0], sc[kt][1]), fmaxf(sc[kt][2], sc[kt][3])));
                m = fmaxf(m, __shfl_xor(m, 16)); m = fmaxf(m, __shfl_xor(m, 32));
                const float mn = fmaxf(M, m), es = __builtin_amdgcn_exp2f(M - mn);
                float l = 0.f;
#pragma unroll
                for (int kt = 0; kt < 16; ++kt) {
#pragma unroll
                    for (int j = 0; j < 4; ++j) { const float e = __builtin_amdgcn_exp2f(sc[kt][j] - mn); sc[kt][j] = e; l += e; } }
                l += __shfl_xor(l, 16); l += __shfl_xor(l, 32);
                L = L * es + l; M = mn;
#pragma unroll
                for (int dt = 0; dt < 4; ++dt) o[dt] = o[dt] * es;
#pragma unroll
                for (int kp = 0; kp < 8; ++kp) {
                    const bf16x8 pf = pk8(sc[2 * kp], sc[2 * kp + 1]);
                    LAS unsigned char* vb = hf ? (Vc + (32 * kp + 4 * g + qq) * VP + 8 * pp) : (Vl + ((((r0 + kp) % RING) * 64) + cstart + 4 * g + qq) * VP + 8 * pp);
#pragma unroll
                    for (int dt = 0; dt < 4; ++dt) { const s16x4 lo = ds_tr(vb + dt * 32), hi = ds_tr(vb + 16 * VP + dt * 32); o[dt] = mfma16(cat8(lo, hi), pf, o[dt]); }
                    if (kp & 1) asm volatile("" ::: "memory");
                }
            }
            const float il = 1.0f / L;
            bf16_t* yp = Y + (size_t)token * 1024 + head * 64 + 4 * g;
#pragma unroll
            for (int dt = 0; dt < 4; ++dt) { u32x2 wv; wv.x = cvt_pk_bf16(o[dt][0] * il, o[dt][1] * il); wv.y = cvt_pk_bf16(o[dt][2] * il, o[dt][3] * il); *(u32x2*)(yp + 16 * dt) = wv; }
        }
    }
}

__device__ void ph_mlA(const P& p, LAS unsigned char* lds) {
    const bf16_t* R = (const bf16_t*)(p.ws + WS_R);
    const bf16_t* KB = R + (size_t)4 * TP * 512; const bf16_t* VB = R + (size_t)5 * TP * 512; const float* Gt = (const float*)(R + (size_t)7 * TP * 512);
    bf16_t* CL = (bf16_t*)(p.ws + WS_CL); float* VEC = (float*)(p.ws + WS_VEC); float* NL = (float*)(p.ws + WS_NL);
    LAS unsigned char* Kt = lds; LAS unsigned char* Vt = lds + 128 * TPI; LAS float* av = (LAS float*)(lds + 2 * 128 * TPI);
    const int tid = TIDX, lane = tid & 63, w = __builtin_amdgcn_readfirstlane(tid >> 6), c = lane & 15, g = lane >> 4, qq = (lane & 15) >> 2, pp = lane & 3;
    const int ch = tid & 15, rb = tid >> 4;
    u32x4 kr[4], vr[4]; float gi0 = 0.f, gf0 = 0.f, gi1 = 0.f, gf1 = 0.f;
#define MLA_PREFETCH(sl) { const int j_ = (sl) % 130, bhd_ = (sl) / 130, d_ = bhd_ & 1, h_ = (bhd_ >> 1) & 3, b_ = bhd_ >> 3; const int row0_ = ml_chunk_row0(b_, d_, j_); \
        _Pragma("unroll") for (int k = 0; k < 4; ++k) { const size_t o_ = (size_t)(row0_ + rb + 32 * k) * 512 + h_ * 128 + ch * 8; kr[k] = *(const u32x4*)(KB + o_); vr[k] = *(const u32x4*)(VB + o_); } \
        if (w == 0) { const int p0 = 2 * lane, t0 = d_ ? 127 - p0 : p0, t1 = d_ ? 126 - p0 : p0 + 1; const int gofs = (h_ * 2 + d_) * 2; \
            gi0 = Gt[(size_t)(row0_ + t0) * 16 + gofs]; gf0 = Gt[(size_t)(row0_ + t0) * 16 + gofs + 1]; gi1 = Gt[(size_t)(row0_ + t1) * 16 + gofs]; gf1 = Gt[(size_t)(row0_ + t1) * 16 + gofs + 1]; } }
    int slot = blockIdx.x;
    if (slot < NSLOT) MLA_PREFETCH(slot)
    while (slot < NSLOT) {
        const int d = (slot / 130) & 1;
        __syncthreads();
        if (w == 0) {
            const int p0 = 2 * lane, p1 = 2 * lane + 1, t0 = d ? 127 - p0 : p0, t1 = d ? 127 - p1 : p1;
            const float i0 = gi0, f0 = gf0, i1 = gi1, f1 = gf1;
            float s = f0 + f1;
#pragma unroll
            for (int o = 1; o < 64; o <<= 1) { const float t = __shfl_up(s, o); if (lane >= o) s += t; }
            const float b1 = s, b0 = s - f1, z0 = i0 - b0, z1 = i1 - b1;
            float cmx = fmaxf(z0, z1);
#pragma unroll
            for (int o = 1; o < 64; o <<= 1) { const float t = __shfl_up(cmx, o); if (lane >= o) cmx = fmaxf(cmx, t); }
            float prev = __shfl_up(cmx, 1); if (lane == 0) prev = -1e30f;
            const float cm0 = fmaxf(prev, z0), cm1 = cmx;
            const float btot = __shfl(b1, 63), cml = __shfl(cm1, 63);
            float* vz = VEC + (size_t)slot * 512;
            vz[t0] = z0; vz[t1] = z1; vz[128 + t0] = b0; vz[128 + t1] = b1; vz[256 + t0] = cm0; vz[256 + t1] = cm1;
            if (lane == 0) { vz[384] = btot; vz[385] = btot + cml; }
            av[t0] = __expf(z0 - cml); av[t1] = __expf(z1 - cml);
        }
#pragma unroll
        for (int k = 0; k < 4; ++k) *(LAS u32x4*)(Kt + (rb + 32 * k) * TPI + ch * 16) = kr[k];
        __syncthreads();
#pragma unroll
        for (int k = 0; k < 4; ++k) { const float a = av[rb + 32 * k]; u32x4 wv = vr[k];
#pragma unroll
            for (int e = 0; e < 4; ++e) wv[e] = cvt_pk_bf16(bflo(wv[e]) * a, bfhi(wv[e]) * a);
            *(LAS u32x4*)(Vt + (rb + 32 * k) * TPI + ch * 16) = wv; }
        const int nslot = slot + gridDim.x;
        if (nslot < NSLOT) MLA_PREFETCH(nslot)
        __syncthreads();
        bf16x8 bv[4], af[4];
#pragma unroll
        for (int ks = 0; ks < 4; ++ks) { LAS unsigned char* a = Vt + (32 * ks + 8 * g + qq) * TPI + (16 * w + 4 * pp) * 2; bv[ks] = cat8(ds_tr(a), ds_tr(a + 4 * TPI));
            const f32x4 a0 = *(const LAS f32x4*)(av + 32 * ks + 8 * g), a1 = *(const LAS f32x4*)(av + 32 * ks + 8 * g + 4); af[ks] = pk8(a0, a1); }
        bf16_t* cp = CL + (size_t)slot * 16384 + (16 * w + c) * 128 + 4 * g;
#pragma unroll
        for (int kt = 0; kt < 8; ++kt) { f32x4 acc = {0.f, 0.f, 0.f, 0.f}, nacc = {0.f, 0.f, 0.f, 0.f};
#pragma unroll
            for (int ks = 0; ks < 4; ++ks) { LAS unsigned char* a = Kt + (32 * ks + 8 * g + qq) * TPI + (16 * kt + 4 * pp) * 2; const bf16x8 kf = cat8(ds_tr(a), ds_tr(a + 4 * TPI));
                acc = mfma16(kf, bv[ks], acc);
                if (kt == w) nacc = mfma16(kf, af[ks], nacc); }
            u32x2 wv; wv.x = cvt_pk_bf16(acc[0], acc[1]); wv.y = cvt_pk_bf16(acc[2], acc[3]); *(u32x2*)(cp + 16 * kt) = wv;
            if (kt == w && c == 0) *(f32x4*)(NL + (size_t)slot * 128 + 16 * kt + 4 * g) = nacc; }
        slot = nslot;
    }
#undef MLA_PREFETCH
}

__device__ void ph_mlC(const P& p, LAS unsigned char* lds) {
    const bf16_t* R = (const bf16_t*)(p.ws + WS_R);
    const bf16_t* QB = R + (size_t)3 * TP * 512; const bf16_t* KB = R + (size_t)4 * TP * 512; const bf16_t* VB = R + (size_t)5 * TP * 512; const bf16_t* OB = R + (size_t)6 * TP * 512;
    const bf16_t* CL = (const bf16_t*)(p.ws + WS_CL); const float* VEC = (const float*)(p.ws + WS_VEC); const float* NL = (const float*)(p.ws + WS_NL);
    bf16_t* Y = (bf16_t*)(p.ws + WS_H);
    LAS unsigned char* Kt = lds; LAS unsigned char* Vt = lds + 128 * TPI; LAS unsigned char* Ct = lds + 2 * 128 * TPI;
    LAS float* vz = (LAS float*)(lds + 3 * 128 * TPI); LAS float* vb = vz + 128; LAS float* vcm = vb + 128; LAS float* vn = vcm + 128;
    const int tid = TIDX, lane = tid & 63, w = __builtin_amdgcn_readfirstlane(tid >> 6), c = lane & 15, g = lane >> 4, qq = (lane & 15) >> 2, pp = lane & 3;
    const int t = 16 * w + c;
    for (int u = blockIdx.x; u < 1024; u += gridDim.x) {
        const int oc = u & 127, h = (u >> 7) & 3, b = u >> 9;
        const int row0 = (b << 14) + oc * 128;
        __syncthreads();
        {
            const int ch = tid & 15, rb = tid >> 4; u32x4 kr[4], vr[4];
#pragma unroll
            for (int k = 0; k < 4; ++k) { const size_t o = (size_t)(row0 + rb + 32 * k) * 512 + h * 128 + ch * 8; kr[k] = *(const u32x4*)(KB + o); vr[k] = *(const u32x4*)(VB + o); }
#pragma unroll
            for (int k = 0; k < 4; ++k) { *(LAS u32x4*)(Kt + (rb + 32 * k) * TPI + ch * 16) = kr[k]; *(LAS u32x4*)(Vt + (rb + 32 * k) * TPI + ch * 16) = vr[k]; }
        }
        bf16x8 qf[4];
#pragma unroll
        for (int ks = 0; ks < 4; ++ks) qf[ks] = *(const bf16x8*)(QB + (size_t)(row0 + t) * 512 + h * 128 + 32 * ks + 8 * g);
        f32x4 hsum[8];
#pragma unroll
        for (int vt = 0; vt < 8; ++vt) hsum[vt] = (f32x4){0.f, 0.f, 0.f, 0.f};
#pragma unroll 1
        for (int d = 0; d < 2; ++d) {
            const int j = d ? 129 - oc : oc + 2, slot = ((b * 4 + h) * 2 + d) * 130 + j;
            if (d == 1) __syncthreads();
            ml_load_tile2(Ct, CL + (size_t)slot * 16384, 128, nullptr, tid);
            if (tid < 128) { const float* vp = VEC + (size_t)slot * 512; vz[tid] = vp[tid]; vb[tid] = vp[128 + tid]; vcm[tid] = vp[256 + tid]; vn[tid] = NL[(size_t)slot * 128 + tid]; }
            const float mprev = VEC[(size_t)slot * 512 + 386];
            __syncthreads();
            const float ut = -fmaxf(mprev, vcm[t]), winter = __expf(mprev + ut), flo = __expf(ut - vb[t]);
            float nq = 0.f;
#pragma unroll
            for (int ks = 0; ks < 4; ++ks) { const u32x4 qw = __builtin_bit_cast(u32x4, qf[ks]); const f32x4 n0 = *(const LAS f32x4*)(vn + 32 * ks + 8 * g), n1 = *(const LAS f32x4*)(vn + 32 * ks + 8 * g + 4);
                nq += bflo(qw[0]) * n0[0] + bfhi(qw[0]) * n0[1] + bflo(qw[1]) * n0[2] + bfhi(qw[1]) * n0[3] + bflo(qw[2]) * n1[0] + bfhi(qw[2]) * n1[1] + bflo(qw[3]) * n1[2] + bfhi(qw[3]) * n1[3]; }
            nq += __shfl_xor(nq, 16); nq += __shfl_xor(nq, 32);
            f32x4 hacc[8];
#pragma unroll
            for (int vt = 0; vt < 8; ++vt) { f32x4 acc = {0.f, 0.f, 0.f, 0.f};
#pragma unroll
                for (int ks = 0; ks < 4; ++ks) acc = mfma16(*(const LAS bf16x8*)(Ct + (16 * vt + c) * TPI + (32 * ks + 8 * g) * 2), qf[ks], acc);
                hacc[vt] = acc * winter; }
            float rs = 0.f;
            bf16x8 pf[4];
#pragma unroll
            for (int kp = 0; kp < 4; ++kp) {
                f32x4 sa[2];
#pragma unroll
                for (int hh = 0; hh < 2; ++hh) { const int st = 2 * kp + hh; const bool active = d ? (st >= w) : (st <= w);
                    f32x4 acc = {0.f, 0.f, 0.f, 0.f};
                    if (active) {
#pragma unroll
                        for (int ks = 0; ks < 4; ++ks) acc = mfma16(*(const LAS bf16x8*)(Kt + (16 * st + c) * TPI + (32 * ks + 8 * g) * 2), qf[ks], acc);
                        const f32x4 zz = *(const LAS f32x4*)(vz + 16 * st + 4 * g);
#pragma unroll
                        for (int jj = 0; jj < 4; ++jj) { const int s = 16 * st + 4 * g + jj; const bool ok = d ? (s >= t) : (s <= t);
                            const float wgt = ok ? __expf(ut + zz[jj]) : 0.f; acc[jj] *= wgt; rs += acc[jj]; }
                    }
                    sa[hh] = acc; }
                pf[kp] = pk8(sa[0], sa[1]);
            }
            rs += __shfl_xor(rs, 16); rs += __shfl_xor(rs, 32);
#pragma unroll
            for (int kp = 0; kp < 4; ++kp) { const bool active = d ? (2 * kp + 1 >= w) : (2 * kp <= w);
                if (active) { LAS unsigned char* vbp = Vt + (32 * kp + 4 * g + qq) * TPI + 8 * pp;
#pragma unroll
                    for (int vt = 0; vt < 8; ++vt) { const s16x4 lo = ds_tr(vbp + vt * 32), hi = ds_tr(vbp + 16 * TPI + vt * 32); hacc[vt] = mfma16(cat8(lo, hi), pf[kp], hacc[vt]); } } }
            const float den = winter * nq + rs, dd = 1.0f / fmaxf(fabsf(den), flo);
#pragma unroll
            for (int vt = 0; vt < 8; ++vt) hsum[vt] += hacc[vt] * dd;
        }
        float ss = 0.f;
#pragma unroll
        for (int vt = 0; vt < 8; ++vt) ss += hsum[vt][0] * hsum[vt][0] + hsum[vt][1] * hsum[vt][1] + hsum[vt][2] * hsum[vt][2] + hsum[vt][3] * hsum[vt][3];
        ss += __shfl_xor(ss, 16); ss += __shfl_xor(ss, 32);
        const float rstd = rsqrtf(ss * (1.0f / 128.0f) + 1e-6f);
        const int row = row0 + t;
        u32x2 owv[8]; f32x4 hgv[8];
#pragma unroll
        for (int vt = 0; vt < 8; ++vt) { const int v0 = 16 * vt + 4 * g; owv[vt] = *(const u32x2*)(OB + (size_t)row * 512 + h * 128 + v0); hgv[vt] = *(const f32x4*)(p.ml_head_g + h * 128 + v0); }
#pragma unroll
        for (int vt = 0; vt < 8; ++vt) { const int v0 = 16 * vt + 4 * g;
            const u32x2 ow = owv[vt]; const f32x4 hg = hgv[vt];
            const float y0 = hsum[vt][0] * rstd * hg[0] * sigmoid_f(bflo(ow.x)), y1 = hsum[vt][1] * rstd * hg[1] * sigmoid_f(bfhi(ow.x));
            const float y2 = hsum[vt][2] * rstd * hg[2] * sigmoid_f(bflo(ow.y)), y3 = hsum[vt][3] * rstd * hg[3] * sigmoid_f(bfhi(ow.y));
            u32x2 wv; wv.x = cvt_pk_bf16(y0, y1); wv.y = cvt_pk_bf16(y2, y3); *(u32x2*)(Y + (size_t)row * 1024 + 512 + h * 128 + v0) = wv; }
    }
}

__device__ void ph_sg(const P& p, LAS unsigned char* lds) {
    bf16_t* U = (bf16_t*)(p.ws + WS_R); const bf16_t* V = U + (size_t)T * 2048; const float* ST = (const float*)(p.ws + WS_ST);
    constexpr int VP = 560;
    LAS unsigned char* Vn = lds; LAS unsigned char* Wt = lds + 128 * VP;
    const int tid = TIDX, lane = tid & 63, w = __builtin_amdgcn_readfirstlane(tid >> 6), c = lane & 15, g = lane >> 4, qq = (lane & 15) >> 2, pp = lane & 3;
    const int c8 = tid & 31, rb = tid >> 5;
    int last_gg = -1;
    f32x4 g0, g1, b0, b1; bf16x8 bw[4]; float bs = 0.f;
    u32x4 vr[8]; f32x2 st[8];
#define SG_PREFETCH(uu) { const int gg_ = (uu) & 7, row0_ = ((uu) >> 3) * 128; \
        _Pragma("unroll") for (int k = 0; k < 8; ++k) { const int r = rb + 16 * k; vr[k] = *(const u32x4*)(V + (size_t)(row0_ + r) * 2048 + gg_ * 256 + c8 * 8); st[k] = *(const f32x2*)(ST + 2 * (row0_ + r)); } }
    int u = blockIdx.x;
    if (u < 2048) SG_PREFETCH(u)
    while (u < 2048) {
        const int gg = u & 7, ch = u >> 3, row0 = ch * 128;
        if (gg != last_gg) { const int cbase = gg * 256 + c8 * 8;
            g0 = *(const f32x4*)(p.sg_ln_g + cbase); g1 = *(const f32x4*)(p.sg_ln_g + cbase + 4); b0 = *(const f32x4*)(p.sg_ln_b + cbase); b1 = *(const f32x4*)(p.sg_ln_b + cbase + 4); }
        __syncthreads();
#pragma unroll
        for (int k = 0; k < 8; ++k) { const int r = rb + 16 * k; const u32x4 wv = vr[k]; const float mu = st[k][0] * (1.0f / 2048.0f), rs = rsqrtf(fmaxf(st[k][1] * (1.0f / 2048.0f) - mu * mu, 0.f) + 1e-6f);
            u32x4 o;
            o[0] = cvt_pk_bf16((bflo(wv[0]) - mu) * rs * g0[0] + b0[0], (bfhi(wv[0]) - mu) * rs * g0[1] + b0[1]);
            o[1] = cvt_pk_bf16((bflo(wv[1]) - mu) * rs * g0[2] + b0[2], (bfhi(wv[1]) - mu) * rs * g0[3] + b0[3]);
            o[2] = cvt_pk_bf16((bflo(wv[2]) - mu) * rs * g1[0] + b1[0], (bfhi(wv[2]) - mu) * rs * g1[1] + b1[1]);
            o[3] = cvt_pk_bf16((bflo(wv[3]) - mu) * rs * g1[2] + b1[2], (bfhi(wv[3]) - mu) * rs * g1[3] + b1[3]);
            *(LAS u32x4*)(Vn + r * VP + c8 * 16) = o; }
        if (gg != last_gg) {
            for (int i = tid; i < 128 * 32; i += NTHR) { const int r = i >> 5, c4 = i & 31; const f32x4 wv = *(const f32x4*)(p.sg_w_s + (size_t)gg * 16384 + r * 128 + c4 * 4);
                u32x2 o; o.x = cvt_pk_bf16(wv[0], wv[1]); o.y = cvt_pk_bf16(wv[2], wv[3]); *(LAS u32x2*)(Wt + r * TPI + c4 * 8) = o; } }
        __syncthreads();
        const int tt = 16 * w + c;
        if (gg != last_gg) {
#pragma unroll
            for (int ks = 0; ks < 4; ++ks) bw[ks] = *(const LAS bf16x8*)(Wt + (16 * w + c) * TPI + (32 * ks + 8 * g) * 2);
            bs = p.sg_b_s[gg * 128 + tt]; last_gg = gg; }
        bf16_t* up = U + (size_t)(row0 + tt) * 2048 + gg * 256 + 8 * g;
        u32x4 uw[8];
#pragma unroll
        for (int q = 0; q < 8; ++q) uw[q] = *(const u32x4*)(up + 32 * q);
        const int un = u + gridDim.x;
        if (un < 2048) SG_PREFETCH(un)
#pragma unroll
        for (int q = 0; q < 8; ++q) { u32x4 o;
#pragma unroll
            for (int hd = 0; hd < 2; ++hd) { f32x4 acc = {0.f, 0.f, 0.f, 0.f};
#pragma unroll
                for (int ks = 0; ks < 4; ++ks) { LAS unsigned char* a = Vn + (32 * ks + 8 * g + qq) * VP + (32 * q + 8 * pp + 4 * hd) * 2; acc = mfma16(cat8(ds_tr(a), ds_tr(a + 4 * VP)), bw[ks], acc); }
                o[2 * hd] = cvt_pk_bf16(bflo(uw[q][2 * hd]) * (acc[0] + bs), bfhi(uw[q][2 * hd]) * (acc[1] + bs));
                o[2 * hd + 1] = cvt_pk_bf16(bflo(uw[q][2 * hd + 1]) * (acc[2] + bs), bfhi(uw[q][2 * hd + 1]) * (acc[3] + bs)); }
            *(u32x4*)(up + 32 * q) = o; }
        u = un;
    }
#undef SG_PREFETCH
}

#define XB_TMO      128
#define XB_XCNT(j)  (256  + 64 * (j))
#define XB_XSUB(j)  (1280 + 64 * (j))
#define XB_XGEN(j)  (2304 + 64 * (j))
#define XB_TOP      3328
#define XB_TOPGEN   3392
#define XCD_BAR_WORDS 3456
#define XB_SPIN_CAP (1u << 18)

__device__ __forceinline__ unsigned xb_ld(unsigned* p)              { return __hip_atomic_load(p, __ATOMIC_RELAXED, __HIP_MEMORY_SCOPE_AGENT); }
__device__ __forceinline__ unsigned xb_add(unsigned* p, unsigned v) { return __hip_atomic_fetch_add(p, v, __ATOMIC_RELAXED, __HIP_MEMORY_SCOPE_AGENT); }
__device__ __forceinline__ unsigned xb_xcc_id() { return (unsigned)__builtin_amdgcn_s_getreg((3 << 11) | 20) & 0xFu; }
#define XB_SPIN(cond, bar) do { unsigned _sp = 0; while (cond) { __builtin_amdgcn_s_sleep(1); \
    if ((++_sp & 255u) == 0u) { if (xb_ld(&(bar)[XB_TMO])) break; if (_sp > XB_SPIN_CAP) { atomicAdd(&(bar)[XB_TMO], 1u); break; } } } } while (0)

struct XcdBarrier {
    unsigned* bar; unsigned x;
    volatile LAS unsigned* st;
};

__device__ __forceinline__ XcdBarrier xcd_barrier_post(unsigned* bar, volatile LAS unsigned* st) {
    XcdBarrier b; b.bar = bar; b.x = xb_xcc_id(); b.st = st;
    if (threadIdx.x == 0) (void)xb_add(&bar[XB_XCNT(b.x)], 1u);
    return b;
}
__device__ __forceinline__ void xcd_barrier_complete(unsigned* bar, unsigned x, unsigned& nloc, unsigned& nx) {
    const unsigned G = gridDim.x * gridDim.y * gridDim.z;
    unsigned sum, cnt, mine, sp = 0u;
    for (;;) {
        sum = 0u; cnt = 0u; mine = 0u;
#pragma unroll
        for (unsigned j = 0; j < 16; ++j) { const unsigned c = xb_ld(&bar[XB_XCNT(j)]); sum += c; cnt += (c > 0u) ? 1u : 0u; mine = (j == x) ? c : mine; }
        if (sum == G) break;
        __builtin_amdgcn_s_sleep(1);
        if ((++sp & 255u) == 0u) { if (xb_ld(&bar[XB_TMO])) break; if (sp > XB_SPIN_CAP) { atomicAdd(&bar[XB_TMO], 1u); break; } }
    }
    nloc = mine > 0u ? mine : 1u; nx = cnt > 0u ? cnt : 1u;
}

__device__ __forceinline__ void xcd_barrier(const XcdBarrier& b) {
    asm volatile("s_waitcnt vmcnt(0)" ::: "memory");
    __syncthreads();
    if (threadIdx.x == 0) {
        unsigned* bar = b.bar;
        __builtin_amdgcn_s_waitcnt(0);
        unsigned nloc = b.st[0], nx = b.st[1];
        if (nloc == 0u) { xcd_barrier_complete(bar, b.x, nloc, nx); b.st[0] = nloc; b.st[1] = nx; }
        const unsigned old = xb_add(&bar[XB_XSUB(b.x)], 1u);
        const unsigned gen = old / nloc;
        if (old + 1u == (gen + 1u) * nloc) {
            __builtin_amdgcn_fence(__ATOMIC_RELEASE, "agent");
            asm volatile("s_waitcnt vmcnt(0)" ::: "memory");
            const unsigned og = xb_add(&bar[XB_TOP], 1u);
            const unsigned tg = og / nx;
            if (og + 1u == (tg + 1u) * nx) xb_add(&bar[XB_TOPGEN], 1u);
            else XB_SPIN(xb_ld(&bar[XB_TOPGEN]) == tg, bar);
            __builtin_amdgcn_fence(__ATOMIC_ACQUIRE, "agent");
            xb_add(&bar[XB_XGEN(b.x)], 1u);
            asm volatile("s_waitcnt vmcnt(0)" ::: "memory");
        } else {
            XB_SPIN(xb_ld(&bar[XB_XGEN(b.x)]) == gen, bar);
            __builtin_amdgcn_fence(__ATOMIC_ACQUIRE, "agent");
            asm volatile("s_waitcnt vmcnt(0)" ::: "memory");
        }
    }
    __syncthreads();
}


constexpr int NPHASE = 25;
constexpr int CONV_L1_EARLY = 1144;
#ifndef PH_EN
#define PH_EN 0xFFFFFFFFu
#endif
#define EN(k) (((PH_EN) >> (k)) & 1u)
__device__ __forceinline__ void run_phase(const P& p, int ph_in, bool second, LAS unsigned char* lds) {
    const int G = gridDim.x, c = blockIdx.x;
    const bool ctx_units = (ph_in == 4) && !second && (c < 8);
    const int ph = ctx_units ? 3 : ph_in;
    unsigned char* ws = p.ws;
    const float* mod = (const float*)(ws + WS_MOD);
    bf16_t* Wb = (bf16_t*)(ws + WS_W); bf16_t* R = (bf16_t*)(ws + WS_R); bf16_t* H = (bf16_t*)(ws + WS_H); float* XC = (float*)(ws + WS_XC);
    pg8::StaticOrder S;
    if (!((PH_EN >> ph_in) & 1u)) return;
    switch (ph) {
    case 0: if (EN(0)) { ph_prep(p, lds); ph_convert(p, lds, 0, c, G, 0, 2720); ph_convert(p, lds, 1, c, G, 0, CONV_L1_EARLY); } break;
    case 1: case 4: case 10: case 13: case 16: case 21: if (EN(1)) {
        const int l = ph >= 13, sub = (ph == 1 || ph == 13) ? 0 : ((ph == 4 || ph == 16) ? 1 : 2);
        const float* xl = (ph == 1) ? p.x : p.out; const float* xc = (ph == 1) ? p.ctx : XC;
        if (ph == 1) ph_norm(p, xl, xc, 0, TP, 0, G, p.norm_g + (l * 3 + sub) * 1024, mod + (size_t)l * 3 * 9216, sub, H);
        else if (ph == 4 && !second) { ph_norm(p, xl, xc, 0, T, 8, G - 8, p.norm_g + (l * 3 + sub) * 1024, mod + (size_t)l * 3 * 9216, sub, H);
            ph_convert(p, lds, 1, c - 8, G - 8, CONV_L1_EARLY, 2880); }
        else if (ph == 4) ph_norm(p, xl, xc, T, TP, 0, G, p.norm_g + (l * 3 + sub) * 1024, mod + (size_t)l * 3 * 9216, sub, H);
        else ph_norm(p, xl, xc, 0, T, 0, G, p.norm_g + (l * 3 + sub) * 1024, mod + (size_t)l * 3 * 9216, sub, H); } break;
    case 2: case 11: case 14: case 22: if (EN(2)) {
        const int l = ph >= 13, s = (ph == 11 || ph == 22), M = (ph == 2) ? TP : T;
        pg8::Gemm g{H, Wb + W_FFN_IN + (size_t)(l * 2 + s) * 5632 * 1024, M, 5632, 1024, 0, 0}; S.init(M, 5632, G, c); EpiSwiglu E{R}; pg8::gemm_phase(lds, g, S, E); } break;
    case 3: case 12: case 15: case 23: case 9: case 20: if (EN(3)) {
        const int l = ph >= 13; pg8::Gemm g; float coef; int sub;
        if (ph == 9) { g = pg8::Gemm{H, Wb + W_MIXOUT, T, 1024, 1024, 0, 0}; coef = 1.0f; sub = 1; }
        else if (ph == 20) { g = pg8::Gemm{R, Wb + W_SGOUT, T, 1024, 2048, 0, 0}; coef = 1.0f; sub = 1; }
        else { const int s = (ph == 12 || ph == 23); g = pg8::Gemm{R, Wb + W_FFN_OUT + (size_t)(l * 2 + s) * 1024 * 2816, ctx_units ? TP : T, 1024, 2816, 1, 1}; coef = 0.5f; sub = s ? 2 : 0; }
        S.init(g.M, 1024, G, c);
        if (ctx_units) { S.fpm = T / 256 + (c >> 2); S.fpn = c & 3; }
        S.rev = REV_PANELS;
        EpiResid E{(ph == 3) ? p.x : p.out, (ph == 3) ? p.ctx : XC, p.out, XC, mod + (size_t)l * 3 * 9216 + (sub * 3 + 2) * 1024, coef}; pg8::gemm_phase(lds, g, S, E); } break;
    case 5: if (EN(5)) { pg8::Gemm g{H, Wb + W_MIXIN, TP, 3840, 1024, 0, 0}; S.init(TP, 3840, G, c);
        EpiProj E{R, (float*)(R + (size_t)7 * TP * 512), (const float2*)(ws + WS_ROPE), p.ml_gate_b}; pg8::gemm_phase(lds, g, S, E); } break;
    case 6:
#if NAIVE_NA
        if (EN(6)) ph_na_naive(p);
#else
        if (EN(6)) ph_na2(p, lds);
#endif
        __syncthreads();
#if NAIVE_MLA
        if (EN(26)) ph_mlA_naive(p, lds);
#else
        if (EN(26)) ph_mlA(p, lds);
#endif
        break;
    case 7: if (EN(7)) ph_mlB(p, lds); break;
    case 8:
#if NAIVE_MLC
        if (EN(8)) ph_mlC_naive(p, lds);
#else
        if (EN(8)) ph_mlC(p, lds);
#endif
        break;
    case 17: if (EN(17)) { pg8::Gemm g{H, Wb + W_SGIN, T, 4096, 1024, 0, 0}; S.init(T, 4096, G, c); EpiGeluUV E{R, (float*)(ws + WS_ST)}; pg8::gemm_phase(lds, g, S, E); } break;
    case 18: if (EN(18)) ph_sg_stats(p); break;
    case 19:
#if NAIVE_SG
        if (EN(19)) ph_sg_naive(p, lds);
#else
        if (EN(19)) ph_sg(p, lds);
#endif
        break;
    case 24: if (EN(24)) ph_final_norm(p); break;
    }
}

__global__ void __launch_bounds__(NTHR, 2) fwd_kernel(P p) {
    extern __shared__ __attribute__((aligned(16))) unsigned char lds_raw[];
    LAS unsigned char* lds = (LAS unsigned char*)lds_raw;
#if MULTI_LAUNCH
    run_phase(p, p.ph_lo, false, lds);
#else
    cg::grid_group grid = cg::this_grid();
    volatile LAS unsigned* bar_st = (volatile LAS unsigned*)(lds + (LDS_BYTES - 16));
    if (threadIdx.x < 4) bar_st[threadIdx.x] = 0u;
    __syncthreads();
    (void)xcd_barrier_post((unsigned*)(p.ws + WS_BAR), bar_st);
    for (int it = 2 * p.ph_lo; it < 2 * p.ph_hi; ++it) {
        const int ph = it >> 1;
        if (ph == 18) continue;
        if ((it & 1) && ph != 4 && !((DBL_MASK >> ph) & 1u)) continue;
        if (it > 2 * p.ph_lo) {
            if (it == 2 * p.ph_lo + 2) grid.sync();
            else { XcdBarrier xb; xb.bar = (unsigned*)(p.ws + WS_BAR); xb.x = xb_xcc_id(); xb.st = bar_st; xcd_barrier(xb); }
        }
        run_phase(p, ph, (it & 1) != 0, lds);
    }
#endif
}

extern "C" void kernel_launch(void* const* d_in, const int* in_sizes, int n_in, void* d_out, int out_size, void* d_ws, size_t ws_size, hipStream_t stream) {
    static int grid = 0;
    if (grid == 0) {
        if (ws_size < WS_END) { fprintf(stderr, "kernel_launch: workspace too small: %zu < %zu\n", ws_size, (size_t)WS_END); grid = -1; return; }
        int dev = 0, cus = 0, per_cu = 0;
        (void)hipGetDevice(&dev); (void)hipDeviceGetAttribute(&cus, hipDeviceAttributeMultiprocessorCount, dev);
        if (hipFuncSetAttribute((const void*)fwd_kernel, hipFuncAttributeMaxDynamicSharedMemorySize, LDS_BYTES) != hipSuccess) { fprintf(stderr, "kernel_launch: hipFuncSetAttribute failed\n"); grid = -1; return; }
        if (hipOccupancyMaxActiveBlocksPerMultiprocessor(&per_cu, (const void*)fwd_kernel, NTHR, LDS_BYTES) != hipSuccess || per_cu < 1) { fprintf(stderr, "kernel_launch: occupancy query gave %d\n", per_cu); per_cu = 1; }
        (void)hipGetLastError();
        grid = cus * 1;
    }
    if (grid < 0) return;
    (void)hipMemsetAsync((char*)d_ws + WS_MOD, 0, WS_ZERO_END, stream);
    P p{};
    const float** pp = (const float**)&p;
    for (int i = 0; i < 21; ++i) pp[i] = (const float*)d_in[i];
    p.out = (float*)d_out; p.ws = (unsigned char*)d_ws;
#if MULTI_LAUNCH
    for (int ph = 0; ph < NPHASE; ++ph) { p.ph_lo = ph; p.ph_hi = ph + 1; hipLaunchKernelGGL(fwd_kernel, dim3(grid), dim3(NTHR), LDS_BYTES, stream, p); }
#else
    p.ph_lo = 0; p.ph_hi = NPHASE;
    void* args[] = {&p};
    hipError_t e = hipLaunchCooperativeKernel((const void*)fwd_kernel, dim3(grid), dim3(NTHR), args, LDS_BYTES, stream);
    if (e != hipSuccess) fprintf(stderr, "cooperative launch failed: %s (grid %d)\n", hipGetErrorString(e), grid);
#endif
}
```

```cpp
#include <hip/hip_runtime.h>
#include <hip/hip_cooperative_groups.h>
#include <cstdio>
namespace cg = cooperative_groups;

#ifndef NAIVE_NA
#define NAIVE_NA 0
#endif
#ifndef NAIVE_MLA
#define NAIVE_MLA 0
#endif
#ifndef NAIVE_MLC
#define NAIVE_MLC 0
#endif
#ifndef NAIVE_SG
#define NAIVE_SG 0
#endif
#ifndef DBL_MASK
#define DBL_MASK 0u
#endif
#ifndef REV_PANELS
#define REV_PANELS 1
#endif
#ifndef MULTI_LAUNCH
#define MULTI_LAUNCH 0
#endif

#define LAS __attribute__((address_space(3)))
typedef unsigned short bf16_t;
typedef short bf16x8 __attribute__((ext_vector_type(8)));
typedef float f32x4 __attribute__((ext_vector_type(4)));
typedef float f32x2 __attribute__((ext_vector_type(2)));
typedef unsigned u32x4 __attribute__((ext_vector_type(4)));
typedef unsigned u32x2 __attribute__((ext_vector_type(2)));

constexpr int T = 32768, TC = 512, TP = T + TC, D = 1024, DFF = 2816, NSEQ = 16384;
constexpr int NTHR = 512;
constexpr int LDS_BYTES = 147456;
constexpr int NSLOT = 2 * 4 * 2 * 130;
constexpr int PITCH = 272;

constexpr size_t WS_MOD = 0;
constexpr size_t WS_BAR = 229376;
constexpr size_t WS_ST = 243712;
constexpr size_t WS_ZERO_END = WS_ST + (size_t)T * 8;
constexpr size_t WS_ROPE = WS_ZERO_END + 256;
constexpr size_t WS_W = WS_ROPE + 65536;
constexpr size_t W_FFN_IN = 0, W_FFN_OUT = W_FFN_IN + 4ull * 5632 * 1024, W_MIXIN = W_FFN_OUT + 4ull * 1024 * 2816,
                 W_MIXOUT = W_MIXIN + 3840ull * 1024, W_SGIN = W_MIXOUT + 1024ull * 1024, W_SGOUT = W_SGIN + 4096ull * 1024,
                 W_END = W_SGOUT + 1024ull * 2048;
constexpr size_t WS_R = WS_W + W_END * 2;
constexpr size_t WS_H = WS_R + 268435456ull;
constexpr size_t WS_CL = WS_H + (size_t)TP * 1024 * 2;
constexpr size_t WS_XC = WS_CL + (size_t)NSLOT * 32768;
constexpr size_t WS_VEC = WS_XC + (size_t)TC * 1024 * 4;
constexpr size_t WS_NL = WS_VEC + (size_t)NSLOT * 2048;
constexpr size_t WS_END = WS_NL + (size_t)NSLOT * 512;

struct P {
    const float *x, *c, *ctx, *c_ctx, *w_mod, *b_mod, *norm_g, *ffn_w_in, *ffn_w_out, *mix_w_in, *na_rpb, *ml_gate_b, *ml_head_g,
        *mix_w_out, *sg_w_in, *sg_ln_g, *sg_ln_b, *sg_w_s, *sg_b_s, *sg_w_out, *final_g;
    float* out; unsigned char* ws; int ph_lo, ph_hi;
};

__device__ __forceinline__ int opaque_tid() { int t = threadIdx.x; asm volatile("" : "+v"(t)); return t; }
#define TIDX (opaque_tid())
__device__ __forceinline__ float bf2f(bf16_t v) { return __uint_as_float(((unsigned)v) << 16); }
__device__ __forceinline__ float bflo(unsigned u) { return __uint_as_float(u << 16); }
__device__ __forceinline__ float bfhi(unsigned u) { return __uint_as_float(u & 0xffff0000u); }
typedef __bf16 bf16v2_t __attribute__((ext_vector_type(2)));
__device__ __forceinline__ unsigned cvt_pk_bf16(float lo, float hi) { const f32x2 v = {lo, hi}; return __builtin_bit_cast(unsigned, __builtin_convertvector(v, bf16v2_t)); }
__device__ __forceinline__ bf16_t f2bf(float f) { return (bf16_t)(cvt_pk_bf16(f, 0.f) & 0xffffu); }
__device__ __forceinline__ float fexp(float v) { return __builtin_amdgcn_exp2f(v * 1.4426950408889634f); }
__device__ __forceinline__ float silu_f(float v) { return v * __builtin_amdgcn_rcpf(1.0f + fexp(-v)); }
__device__ __forceinline__ float sigmoid_f(float v) { return __builtin_amdgcn_rcpf(1.0f + fexp(-v)); }
__device__ __forceinline__ float gelu_tanh(float v) { const float u = 0.7978845608028654f * (v + 0.044715f * v * v * v); const float e = fexp(2.0f * u); return v * (1.0f - __builtin_amdgcn_rcpf(e + 1.0f)); }
__device__ __forceinline__ float log_sigmoid_f(float v) { return fminf(v, 0.f) - log1pf(__expf(-fabsf(v))); }

namespace pg8 {
constexpr int BM = 256, BK = 64, HALF = 128, HTB = HALF * BK * 2, STAGE_BYTES = 8 * HTB, NXCD = 8, WGM = 8;
__device__ __forceinline__ int lds_byte(int r, int c) { const int st = (r >> 4) * 2 + (c >> 5), rr = r & 15, cc = c & 31, ob = rr * 64 + cc * 2; return st * 1024 + (ob ^ (((ob >> 9) & 1) << 5)); }
__device__ __forceinline__ void stage_rc(int b, int& R, int& C) { const int st = b / 1024, sb = b % 1024, swz = sb ^ (((sb >> 9) & 1) << 5); R = (st >> 1) * 16 + swz / 64; C = (st & 1) * 32 + (swz % 64) / 2; }
struct Unit { int pm, pn; };
struct Gemm { const bf16_t* A; const bf16_t* Bt; int M, N, K; int tiledA, tiledB; };
struct StaticOrder {
    int nM, nN, nwg, G, c, fpm, fpn, rev;
    __device__ void init(int M, int N, int G_, int c_) { nM = M / BM; nN = N / BM; nwg = nM * nN; G = G_; c = c_; fpm = -1; fpn = 0; rev = 0; }
    __device__ bool next(int i, Unit& u) const {
        if (fpm >= 0) { if (i > 0) return false; u.pm = fpm; u.pn = fpn; return true; }
        const long L = (long)i * G + c; if (L >= nwg) return false;
        int wgid = (int)L; { const int q = nwg / NXCD, r = nwg % NXCD, xcd = wgid % NXCD, off = wgid / NXCD; wgid = (xcd < r ? xcd * (q + 1) : r * (q + 1) + (xcd - r) * q) + off; }
        const int nig = WGM * nN, gid = wgid / nig, fm = gid * WGM, gsz = (nM - fm) < WGM ? (nM - fm) : WGM;
        u.pm = fm + ((wgid % nig) % gsz); u.pn = (wgid % nig) / gsz; if (rev) u.pm = nM - 1 - u.pm; return true;
    }
};

#ifndef PG8_SP2
#define PG8_SP2 true
#endif
#ifndef PG8_ALIGN
#define PG8_ALIGN true
#endif
template <class Epi, bool ALIGN_EPI = PG8_ALIGN, bool SP2 = PG8_SP2>
__device__ __forceinline__ void gemm_phase(LAS unsigned char* lds, const Gemm g, const StaticOrder& S, const Epi& E) {
    const int tid = TIDX, wid = __builtin_amdgcn_readfirstlane(tid >> 6), lane = tid & 63, wr = wid >> 2, wc = wid & 3, fr = lane & 15, fq = lane >> 4;
    const int K = g.K, nt = K / BK;
    unsigned voffA[2], voffB[2];
#pragma unroll
    for (int i = 0; i < 2; ++i) { int R, C; stage_rc(tid * 16 + i * 8192, R, C); voffA[i] = (unsigned)(R * (g.tiledA ? BK : K) + C) * 2u; voffB[i] = (unsigned)(R * (g.tiledB ? BK : K) + C) * 2u; }
    const size_t kstepA = g.tiledA ? (size_t)(2 * HTB) : (size_t)(BK * 2), kstepB = g.tiledB ? (size_t)(2 * HTB) : (size_t)(BK * 2);
    const size_t hstepA = g.tiledA ? (size_t)HTB : (size_t)HALF * K * 2, hstepB = g.tiledB ? (size_t)HTB : (size_t)HALF * K * 2;
    const size_t tstepA = (size_t)BM * K * 2, tstepB = (size_t)BM * K * 2;
    const unsigned ldsw = (unsigned)wid * 1024u;
    const int aoff = lds_byte(wr * 64 + fr, fq * 8), boff = lds_byte(wc * 32 + fr, fq * 8);
#define PG8_SA(b, h) (((b) * 2 + (h)) * HTB)
#define PG8_SB(b, h) ((4 + (b) * 2 + (h)) * HTB)
#define PG8_STAGE(bufoff, gbase, voff) do { _Pragma("unroll") for (int _i = 0; _i < 2; ++_i) \
        __builtin_amdgcn_global_load_lds((const unsigned*)((const char*)(gbase) + (voff)[_i]), (LAS unsigned*)(lds + (bufoff) + ldsw + _i * 8192), 16, 0, 0); } while (0)
#define PG8_LDA(dst, b, h) do { _Pragma("unroll") for (int m = 0; m < 4; ++m) _Pragma("unroll") for (int k = 0; k < 2; ++k) dst[m][k] = *(const LAS bf16x8*)(lds + PG8_SA(b, h) + aoff + m * 2048 + k * 1024); } while (0)
#define PG8_LDB(dst, b, h) do { _Pragma("unroll") for (int n = 0; n < 2; ++n) _Pragma("unroll") for (int k = 0; k < 2; ++k) dst[n][k] = *(const LAS bf16x8*)(lds + PG8_SB(b, h) + boff + n * 2048 + k * 1024); } while (0)
#define PG8_MMA(ai, bj, At, Bt) do { __builtin_amdgcn_s_setprio(1); _Pragma("unroll") for (int m = 0; m < 4; ++m) _Pragma("unroll") for (int n = 0; n < 2; ++n) _Pragma("unroll") for (int k = 0; k < 2; ++k) \
        acc[ai][bj][m][n] = __builtin_amdgcn_mfma_f32_16x16x32_bf16(Bt[n][k], At[m][k], acc[ai][bj][m][n], 0, 0, 0); __builtin_amdgcn_s_setprio(0); } while (0)
#define PG8_WAIT_V(n) asm volatile("s_waitcnt vmcnt(" #n ")" ::: "memory")
#define PG8_WAIT_L(n) asm volatile("s_waitcnt lgkmcnt(" #n ")" ::: "memory")
#define PG8_BAR __builtin_amdgcn_s_barrier()
#define PG8_SCHED __builtin_amdgcn_sched_barrier(0)
    Unit cur, nxt; int ui = 0;
    if (!S.next(0, cur)) return;
    f32x4 acc[2][2][4][2];
#pragma unroll
    for (int a = 0; a < 2; ++a)
#pragma unroll
        for (int b = 0; b < 2; ++b)
#pragma unroll
            for (int m = 0; m < 4; ++m)
#pragma unroll
                for (int n = 0; n < 2; ++n) acc[a][b][m][n] = (f32x4){0.f, 0.f, 0.f, 0.f};
    bf16x8 At[4][2], B0[2][2], B1[2][2];
    const char* cA = (const char*)g.A + (size_t)cur.pm * tstepA; const char* cB = (const char*)g.Bt + (size_t)cur.pn * tstepB;
    if constexpr (SP2) {
        PG8_STAGE(PG8_SB(0, 0), cB, voffB); PG8_STAGE(PG8_SB(0, 1), cB + hstepB, voffB); PG8_STAGE(PG8_SA(0, 0), cA, voffA); PG8_STAGE(PG8_SA(0, 1), cA + hstepA, voffA);
        if (wr == 1) PG8_BAR;
        PG8_WAIT_V(2); PG8_BAR;
        PG8_STAGE(PG8_SB(1, 0), cB + kstepB, voffB); PG8_STAGE(PG8_SA(1, 0), cA + kstepA, voffA); PG8_STAGE(PG8_SB(1, 1), cB + hstepB + kstepB, voffB);
        PG8_WAIT_V(6); PG8_BAR;
    } else {
        PG8_STAGE(PG8_SB(0, 0), cB, voffB); PG8_STAGE(PG8_SA(0, 0), cA, voffA); PG8_STAGE(PG8_SB(0, 1), cB + hstepB, voffB); PG8_STAGE(PG8_SA(0, 1), cA + hstepA, voffA);
        if (wr == 1) PG8_BAR;
        PG8_WAIT_V(4); PG8_BAR;
        PG8_STAGE(PG8_SB(1, 0), cB + kstepB, voffB); PG8_STAGE(PG8_SA(1, 0), cA + kstepA, voffA); PG8_STAGE(PG8_SB(1, 1), cB + hstepB + kstepB, voffB);
        PG8_WAIT_V(6); PG8_BAR;
    }
    for (;;) {
        const bool has_next = S.next(ui + 1, nxt);
        const char* nA = has_next ? (const char*)g.A + (size_t)nxt.pm * tstepA : cA; const char* nB = has_next ? (const char*)g.Bt + (size_t)nxt.pn * tstepB : cB;
        for (int t = 0; t < nt; t += 2) {
            const bool last = (t == nt - 2);
            const char* a1 = cA + (size_t)(t + 1) * kstepA;
            const char* a2 = last ? nA : cA + (size_t)(t + 2) * kstepA; const char* b2 = last ? nB : cB + (size_t)(t + 2) * kstepB;
            const char* a3 = a2 + kstepA; const char* b3 = b2 + kstepB;
            if constexpr (SP2) {
            PG8_LDB(B0, 0, 0); PG8_LDB(B1, 0, 1); PG8_SCHED; PG8_LDA(At, 0, 0); PG8_STAGE(PG8_SA(1, 1), a1 + hstepA, voffA);
            PG8_WAIT_V(8); PG8_WAIT_L(0); PG8_BAR; PG8_MMA(0, 0, At, B0); PG8_MMA(0, 1, At, B1); PG8_BAR; PG8_SCHED;
            PG8_LDA(At, 0, 1); PG8_STAGE(PG8_SB(0, 0), b2, voffB); PG8_STAGE(PG8_SB(0, 1), b2 + hstepB, voffB); PG8_STAGE(PG8_SA(0, 0), a2, voffA);
            PG8_WAIT_V(8); PG8_WAIT_L(0); PG8_BAR; PG8_MMA(1, 0, At, B0); PG8_MMA(1, 1, At, B1); PG8_BAR; PG8_SCHED;
            PG8_LDB(B0, 1, 0); PG8_LDB(B1, 1, 1); PG8_SCHED; PG8_LDA(At, 1, 0); PG8_STAGE(PG8_SA(0, 1), a2 + hstepA, voffA);
            PG8_WAIT_V(8); PG8_WAIT_L(0); PG8_BAR; PG8_MMA(0, 0, At, B0); PG8_MMA(0, 1, At, B1); PG8_BAR; PG8_SCHED;
            PG8_LDA(At, 1, 1); PG8_STAGE(PG8_SB(1, 0), b3, voffB); PG8_STAGE(PG8_SB(1, 1), b3 + hstepB, voffB); PG8_STAGE(PG8_SA(1, 0), a3, voffA);
            PG8_WAIT_V(8); PG8_WAIT_L(0); PG8_BAR; PG8_MMA(1, 0, At, B0); PG8_MMA(1, 1, At, B1); PG8_BAR; PG8_SCHED;
            } else {
            PG8_LDB(B0, 0, 0); PG8_SCHED; PG8_LDA(At, 0, 0); PG8_STAGE(PG8_SA(1, 1), a1 + hstepA, voffA);
            PG8_WAIT_L(8); PG8_BAR; PG8_WAIT_L(0); PG8_MMA(0, 0, At, B0); PG8_BAR; PG8_SCHED;
            PG8_LDB(B1, 0, 1); PG8_STAGE(PG8_SB(0, 0), b2, voffB);
            PG8_BAR; PG8_WAIT_L(0); PG8_MMA(0, 1, At, B1); PG8_BAR;
            PG8_LDA(At, 0, 1); PG8_STAGE(PG8_SA(0, 0), a2, voffA);
            PG8_BAR; PG8_WAIT_L(0); PG8_MMA(1, 0, At, B0); PG8_BAR; PG8_SCHED;
            PG8_STAGE(PG8_SB(0, 1), b2 + hstepB, voffB);
            PG8_WAIT_V(6); PG8_BAR; PG8_MMA(1, 1, At, B1); PG8_BAR;
            PG8_LDB(B0, 1, 0); PG8_SCHED; PG8_LDA(At, 1, 0); PG8_STAGE(PG8_SA(0, 1), a2 + hstepA, voffA);
            PG8_WAIT_L(8); PG8_BAR; PG8_WAIT_L(0); PG8_MMA(0, 0, At, B0); PG8_BAR; PG8_SCHED;
            PG8_LDB(B1, 1, 1); PG8_STAGE(PG8_SB(1, 0), b3, voffB);
            PG8_BAR; PG8_WAIT_L(0); PG8_MMA(0, 1, At, B1); PG8_BAR;
            PG8_LDA(At, 1, 1); PG8_STAGE(PG8_SA(1, 0), a3, voffA);
            PG8_BAR; PG8_WAIT_L(0); PG8_MMA(1, 0, At, B0); PG8_BAR; PG8_SCHED;
            PG8_STAGE(PG8_SB(1, 1), b3 + hstepB, voffB);
            PG8_WAIT_V(6); PG8_BAR; PG8_MMA(1, 1, At, B1); PG8_BAR;
            }
        }
        if constexpr (ALIGN_EPI) { if (wr == 0) PG8_BAR; }
        E(acc, cur, wr, wc, fr, fq);
        if (!has_next) break;
#pragma unroll
        for (int a = 0; a < 2; ++a)
#pragma unroll
            for (int b = 0; b < 2; ++b)
#pragma unroll
                for (int m = 0; m < 4; ++m)
#pragma unroll
                    for (int n = 0; n < 2; ++n) acc[a][b][m][n] = (f32x4){0.f, 0.f, 0.f, 0.f};
        cur = nxt; cA = nA; cB = nB; ++ui;
        if constexpr (ALIGN_EPI) { if (wr == 1) PG8_BAR; }
    }
    PG8_WAIT_V(0);
    if constexpr (!ALIGN_EPI) { if (wr == 0) PG8_BAR; }
    PG8_BAR;
#undef PG8_SA
#undef PG8_SB
#undef PG8_STAGE
#undef PG8_LDA
#undef PG8_LDB
#undef PG8_MMA
#undef PG8_WAIT_V
#undef PG8_WAIT_L
#undef PG8_BAR
#undef PG8_SCHED
}
}

struct EpiSwiglu {
    bf16_t* hid;
    __device__ __forceinline__ void operator()(const f32x4 (&acc)[2][2][4][2], const pg8::Unit& u, int wr, int wc, int fr, int fq) const {
        const int row0 = u.pm * 256 + wr * 64 + fr, hc0 = u.pn * 128 + wc * 32 + 8 * fq;
#pragma unroll
        for (int ai = 0; ai < 2; ++ai)
#pragma unroll
            for (int m = 0; m < 4; ++m) { u32x4 w;
#pragma unroll
                for (int n = 0; n < 2; ++n) { const f32x4 a = acc[ai][0][m][n], b = acc[ai][1][m][n];
                    w[2 * n] = cvt_pk_bf16(silu_f(a[0]) * b[0], silu_f(a[1]) * b[1]); w[2 * n + 1] = cvt_pk_bf16(silu_f(a[2]) * b[2], silu_f(a[3]) * b[3]); }
                const int row = row0 + ai * 128 + m * 16;
                *(u32x4*)(hid + ((size_t)((row >> 8) * (DFF / 64) + (hc0 >> 6)) * 2 + ((row >> 7) & 1)) * 8192 + (row & 127) * 64 + (hc0 & 63)) = w; }
    }
};
struct EpiResid {
    const float* xin_lat; const float* xin_ctx; float* xout_lat; float* xout_ctx; const float* gate; float coef;
    __device__ __forceinline__ void operator()(const f32x4 (&acc)[2][2][4][2], const pg8::Unit& u, int wr, int wc, int fr, int fq) const {
        const int row0 = u.pm * 256 + wr * 64 + fr, col0 = u.pn * 256 + wc * 32 + 8 * fq;
        const bool isctx = u.pm >= T / 256; const int mb = isctx ? 2 : (u.pm >> 6);
        const float* xi = isctx ? xin_ctx - (size_t)T * D : xin_lat; float* xo = isctx ? xout_ctx - (size_t)T * D : xout_lat;
        const float* gp = gate + mb * 9216 + col0;
        f32x4 gv[2][2];
#pragma unroll
        for (int bj = 0; bj < 2; ++bj)
#pragma unroll
            for (int n = 0; n < 2; ++n) gv[bj][n] = *(const f32x4*)(gp + bj * 128 + n * 4) * coef;
#pragma unroll
        for (int ai = 0; ai < 2; ++ai) {
            f32x4 xv[4][2][2];
#pragma unroll
            for (int m = 0; m < 4; ++m)
#pragma unroll
                for (int bj = 0; bj < 2; ++bj)
#pragma unroll
                    for (int n = 0; n < 2; ++n) xv[m][bj][n] = *(const f32x4*)(xi + (size_t)(row0 + ai * 128 + m * 16) * D + col0 + bj * 128 + n * 4);
#pragma unroll
            for (int m = 0; m < 4; ++m)
#pragma unroll
                for (int bj = 0; bj < 2; ++bj)
#pragma unroll
                    for (int n = 0; n < 2; ++n) *(f32x4*)(xo + (size_t)(row0 + ai * 128 + m * 16) * D + col0 + bj * 128 + n * 4) = xv[m][bj][n] + gv[bj][n] * acc[ai][bj][m][n];
        }
    }
};
struct EpiProj {
    bf16_t* base; float* G; const float2* rope; const float* gate_b;
    __device__ __forceinline__ void operator()(const f32x4 (&acc)[2][2][4][2], const pg8::Unit& u, int wr, int wc, int fr, int fq) const {
        const int row0 = u.pm * 256 + wr * 64 + fr;
        if (u.pn == 14) {
            if (wc == 0 && fq < 2) {
#pragma unroll
                for (int nn = 0; nn < 2; ++nn) { const int head = 2 * fq + nn; const f32x4 gb = *(const f32x4*)(gate_b + 4 * head);
#pragma unroll
                    for (int ai = 0; ai < 2; ++ai)
#pragma unroll
                        for (int m = 0; m < 4; ++m) { const int row = row0 + ai * 128 + m * 16; f32x4 v = acc[ai][0][m][nn] + gb;
                            v[1] = log_sigmoid_f(v[1]); v[3] = log_sigmoid_f(v[3]);
                            *(f32x4*)(G + (size_t)row * 16 + 4 * head) = v; } }
            }
            return;
        }
        const int kind = u.pn >> 1; bf16_t* dst = base + (size_t)kind * TP * 512;
        const int cc0 = (u.pn & 1) * 256 + wc * 32 + 8 * fq;
        const bool rope_k = (kind == 3 || kind == 4) && (u.pm < T / 256);
        const float sc = (kind == 4) ? 0.08838834764831845f : 1.0f;
#pragma unroll
        for (int ai = 0; ai < 2; ++ai) {
            float2 csA[4][2][2], csB[4][2][2];
            if (rope_k) {
#pragma unroll
                for (int m = 0; m < 4; ++m) { const int row = row0 + ai * 128 + m * 16; const int n = row & (NSEQ - 1), gi = n >> 6, gj = n & 63;
#pragma unroll
                    for (int bj = 0; bj < 2; ++bj)
#pragma unroll
                        for (int nn = 0; nn < 2; ++nn) { const int cc = cc0 + bj * 128 + nn * 4; const int pr = (cc & 127) >> 1; const int pos = (pr < 32) ? gi : gj; const int fi = pr & 31;
                            csA[m][bj][nn] = rope[pos * 32 + fi]; csB[m][bj][nn] = rope[pos * 32 + fi + 1]; } }
            }
#pragma unroll
            for (int m = 0; m < 4; ++m) { const int row = row0 + ai * 128 + m * 16;
#pragma unroll
                for (int bj = 0; bj < 2; ++bj) { u32x4 w;
#pragma unroll
                    for (int nn = 0; nn < 2; ++nn) { f32x4 v = acc[ai][bj][m][nn];
                        if (rope_k) { const float2 cs0 = csA[m][bj][nn], cs1 = csB[m][bj][nn];
                            const float a0 = v[0] * cs0.x - v[1] * cs0.y, a1 = v[0] * cs0.y + v[1] * cs0.x, a2 = v[2] * cs1.x - v[3] * cs1.y, a3 = v[2] * cs1.y + v[3] * cs1.x;
                            v = (f32x4){a0, a1, a2, a3}; }
                        v = v * sc;
                        w[2 * nn] = cvt_pk_bf16(v[0], v[1]); w[2 * nn + 1] = cvt_pk_bf16(v[2], v[3]); }
                    *(u32x4*)(dst + (size_t)row * 512 + cc0 + bj * 128) = w; } }
        }
    }
};
struct EpiGeluUV {
    bf16_t* base; float* st;
    __device__ __forceinline__ void operator()(const f32x4 (&acc)[2][2][4][2], const pg8::Unit& u, int wr, int wc, int fr, int fq) const {
        const int row0 = u.pm * 256 + wr * 64 + fr; bf16_t* dst = base + (size_t)(u.pn >> 3) * T * 2048; const int cc0 = (u.pn & 7) * 256 + wc * 32 + 8 * fq;
        const bool isv = u.pn >= 8;
#define GU_ROW(ai, m) { bf16_t* rowp = dst + (size_t)(row0 + (ai) * 128 + (m) * 16) * 2048 + cc0; float s1 = 0.f, s2 = 0.f; \
            _Pragma("unroll") for (int bj = 0; bj < 2; ++bj) { u32x4 w; \
                _Pragma("unroll") for (int n = 0; n < 2; ++n) { const f32x4 v = acc[ai][bj][m][n]; const float g0 = gelu_tanh(v[0]), g1 = gelu_tanh(v[1]), g2 = gelu_tanh(v[2]), g3 = gelu_tanh(v[3]); \
                    s1 += (g0 + g1) + (g2 + g3); s2 += (g0 * g0 + g1 * g1) + (g2 * g2 + g3 * g3); \
                    w[2 * n] = cvt_pk_bf16(g0, g1); w[2 * n + 1] = cvt_pk_bf16(g2, g3); } \
                *(u32x4*)(rowp + bj * 128) = w; } \
            if (isv) { s1 += __shfl_xor(s1, 16); s1 += __shfl_xor(s1, 32); s2 += __shfl_xor(s2, 16); s2 += __shfl_xor(s2, 32); \
                if (fq == 0) { atomicAdd(st + 2 * (row0 + (ai) * 128 + (m) * 16), s1); atomicAdd(st + 2 * (row0 + (ai) * 128 + (m) * 16) + 1, s2); } } }
        GU_ROW(0, 0) GU_ROW(0, 1) GU_ROW(0, 2) GU_ROW(0, 3) GU_ROW(1, 0) GU_ROW(1, 1) GU_ROW(1, 2) GU_ROW(1, 3)
#undef GU_ROW
    }
};

__device__ void ph_prep(const P& p, LAS unsigned char* lds) {
    const int tid = TIDX, G = gridDim.x, bid = blockIdx.x;
    float* mod = (float*)(p.ws + WS_MOD);
    for (int idx = bid * NTHR + tid; idx < 256 * 32; idx += G * NTHR) {
        const int pos = idx >> 5, fi = idx & 31;
        const float inv = exp2f(-(float)fi * (13.287712379549449f / 32.0f));
        const float ang = (float)pos * inv;
        const double a = (double)ang; const double kq = rint(a * 0.6366197723675814); const double r = a - kq * 1.5707963267948966;
        const float rf = (float)r, r2 = rf * rf; const int q = ((int)kq) & 3;
        const float s = rf + rf * r2 * (-1.6666654611e-1f + r2 * (8.3321608736e-3f + r2 * (-1.9515295891e-4f)));
        const float c = 1.0f - 0.5f * r2 + r2 * r2 * (4.166664568298827e-2f + r2 * (-1.388731625493765e-3f + r2 * 2.443315711809948e-5f));
        float co, si;
        if (q == 0) { co = c; si = s; } else if (q == 1) { co = -s; si = c; } else if (q == 2) { co = -c; si = -s; } else { co = s; si = -c; }
        ((float2*)(p.ws + WS_ROPE))[idx] = make_float2(co, si);
    }
    LAS float* sv = (LAS float*)lds;
    for (int item = bid; item < 288; item += G) {
        const int l = item / 144, rem = item % 144, ks = rem / 9, cgp = rem % 9;
        __syncthreads();
        if (tid < 192) { const int mb = tid >> 6, kk = tid & 63, k = ks * 64 + kk; const float cv = (mb < 2) ? p.c[mb * 1024 + k] : p.c_ctx[k]; sv[mb * 64 + kk] = silu_f(cv); }
        __syncthreads();
        const int half = tid >> 8, cq = tid & 255, col = cgp * 1024 + cq * 4;
        f32x4 a0 = {0, 0, 0, 0}, a1 = a0, a2 = a0;
        const float* wp = p.w_mod + ((size_t)(l * 1024 + ks * 64 + half * 32)) * 9216 + col;
#pragma unroll 16
        for (int kk = 0; kk < 32; ++kk) { const f32x4 w = *(const f32x4*)(wp + (size_t)kk * 9216); const int si = half * 32 + kk;
            a0 += w * sv[si]; a1 += w * sv[64 + si]; a2 += w * sv[128 + si]; }
        if (ks == 0 && half == 0) { const f32x4 bb = *(const f32x4*)(p.b_mod + l * 9216 + col); a0 += bb; a1 += bb; a2 += bb; }
        float* m0 = mod + (size_t)(l * 3) * 9216 + col;
#pragma unroll
        for (int j = 0; j < 4; ++j) { atomicAdd(m0 + j, a0[j]); atomicAdd(m0 + 9216 + j, a1[j]); atomicAdd(m0 + 2 * 9216 + j, a2[j]); }
    }
}

__device__ void ph_convert(const P& p, LAS unsigned char* lds, int layer, int wid, int nwg, int v_lo, int v_hi) {
    const int tid = TIDX;
    __syncthreads();
    LAS bf16_t* tl = (LAS bf16_t*)(lds + 1024);
    bf16_t* Wb = (bf16_t*)(p.ws + WS_W);
    float vv[16]; bf16_t* cdst = nullptr; int cK = 0, ck0 = 0, cr0 = 0;
#define CONV_DECODE(t, src, dst, K, Ns, kind, k0, r0) { int nrt, lt; \
        if (t < 2816) { const int j = t / 704; lt = t % 704; src = p.ffn_w_in + (size_t)j * 1024 * 5632; dst = Wb + W_FFN_IN + (size_t)j * 5632 * 1024; K = 1024; Ns = 5632; nrt = 88; kind = 1; } \
        else if (t < 4224) { const int j = (t - 2816) / 352; lt = (t - 2816) % 352; src = p.ffn_w_out + (size_t)j * 2816 * 1024; dst = Wb + W_FFN_OUT + (size_t)j * 1024 * 2816; K = 2816; Ns = 1024; nrt = 16; kind = 0; } \
        else if (t < 4704) { lt = t - 4224; src = p.mix_w_in; dst = Wb + W_MIXIN; K = 1024; Ns = 3600; nrt = 60; kind = 2; } \
        else if (t < 4832) { lt = t - 4704; src = p.mix_w_out; dst = Wb + W_MIXOUT; K = 1024; Ns = 1024; nrt = 16; kind = 0; } \
        else if (t < 5344) { lt = t - 4832; src = p.sg_w_in; dst = Wb + W_SGIN; K = 1024; Ns = 4096; nrt = 64; kind = 0; } \
        else { lt = t - 5344; src = p.sg_w_out; dst = Wb + W_SGOUT; K = 2048; Ns = 1024; nrt = 16; kind = 0; } \
        k0 = (lt / nrt) * 128; r0 = (lt % nrt) * 64; }
#define CONV_LOAD(t) { const float* src; bf16_t* dst; int K, Ns, kind, k0, r0; CONV_DECODE(t, src, dst, K, Ns, kind, k0, r0) \
        const int rr = r0 + (tid & 63); int sc = rr; \
        if (kind == 1) { const int pn = rr >> 8, cl = rr & 255; sc = 128 * pn + 32 * ((cl >> 5) & 3) + 8 * ((cl >> 2) & 3) + 4 * ((cl >> 4) & 1) + (cl & 3) + (cl >> 7) * DFF; } \
        else { const int rho = rr & 31; sc = (rr & ~31) + 8 * ((rho & 15) >> 2) + 4 * (rho >> 4) + (rho & 3); if (kind == 2 && sc >= 3600) sc = -1; } \
        _Pragma("unroll") for (int it = 0; it < 16; ++it) { const int kk = it * 8 + (tid >> 6); vv[it] = (sc >= 0) ? src[(size_t)(k0 + kk) * Ns + sc] : 0.f; } \
        cdst = dst; cK = K; ck0 = k0; cr0 = r0; }
    const int nv = min(v_hi, layer ? 2880 : 2720);
#define CONV_REMAP(v) (layer ? (((v) < 1408) ? (v) + 1408 : ((v) < 2112) ? (v) - 1408 + 3520 : (v) - 2112 + 4832) : (((v) < 1408) ? (v) : ((v) < 2112) ? (v) - 1408 + 2816 : (v) - 2112 + 4224))
    int v = v_lo + wid;
    if (v < nv) { const int t = CONV_REMAP(v); CONV_LOAD(t) }
    while (v < nv) {
        __syncthreads();
        { const int rl = tid & 63;
#pragma unroll
          for (int it = 0; it < 16; ++it) { const int kk = it * 8 + (tid >> 6); tl[rl * 136 + kk] = f2bf(vv[it]); } }
        bf16_t* odst = cdst; const int oK = cK, ok0 = ck0, or0 = cr0; const bool otile = (oK == 2816);
        __syncthreads();
        v += nwg;
        if (v < nv) { const int t = CONV_REMAP(v); CONV_LOAD(t) }
#pragma unroll
        for (int h2 = 0; h2 < 2; ++h2) { const int idx = tid + h2 * 512, rl = idx >> 4, kc = (idx & 15) * 8; const u32x4 v = *(const LAS u32x4*)(tl + rl * 136 + kc); const int rr = or0 + rl, kk = ok0 + kc;
            const size_t off = otile ? (((size_t)((rr >> 8) * (2816 / 64) + (kk >> 6)) * 2 + ((rr >> 7) & 1)) * 8192 + (rr & 127) * 64 + (kk & 63)) : ((size_t)rr * oK + kk);
            *(u32x4*)(odst + off) = v; }
    }
#undef CONV_LOAD
#undef CONV_REMAP
#undef CONV_DECODE
}

__device__ void ph_norm(const P& p, const float* xlat, const float* xctx, int row_lo, int nrows, int wg0, int nwg, const float* g, const float* modl, int sub, bf16_t* H) {
    const int lane = TIDX & 63, wv = TIDX >> 6;
    if ((int)blockIdx.x < wg0) return;
    const int stride = nwg * 16;
    int row = row_lo + (((int)blockIdx.x - wg0) * 8 + wv) * 2;
    f32x4 v[2][4], nx[2][4], gg[4], s0[4]; int cur_mb = -1;
#define NORM_LOAD(dst, r_) { const bool ic_ = (r_) >= T; const float* xr_ = ic_ ? xctx + (size_t)((r_) - T) * D : xlat + (size_t)(r_) * D; \
        _Pragma("unroll") for (int rr = 0; rr < 2; ++rr) _Pragma("unroll") for (int i = 0; i < 4; ++i) dst[rr][i] = *(const f32x4*)(xr_ + rr * D + 8 * (lane + 64 * (i >> 1)) + 4 * (i & 1)); }
    if (row < nrows) NORM_LOAD(nx, row)
    while (row < nrows) {
#pragma unroll
        for (int rr = 0; rr < 2; ++rr)
#pragma unroll
            for (int i = 0; i < 4; ++i) v[rr][i] = nx[rr][i];
        const int nrow = row + stride;
        if (nrow < nrows) NORM_LOAD(nx, nrow)
        const int mb = (row >= T) ? 2 : (row >> 14);
        if (mb != cur_mb) { const float* sh = modl + mb * 9216 + (sub * 3) * 1024; const float* scp = sh + 1024;
#pragma unroll
            for (int i = 0; i < 4; ++i) { const int k = 8 * (lane + 64 * (i >> 1)) + 4 * (i & 1); gg[i] = *(const f32x4*)(g + k) * (*(const f32x4*)(scp + k) + 1.0f); s0[i] = *(const f32x4*)(sh + k); }
            cur_mb = mb; }
        float ss0 = 0.f, ss1 = 0.f;
#pragma unroll
        for (int i = 0; i < 4; ++i) { ss0 += v[0][i][0] * v[0][i][0] + v[0][i][1] * v[0][i][1] + v[0][i][2] * v[0][i][2] + v[0][i][3] * v[0][i][3];
            ss1 += v[1][i][0] * v[1][i][0] + v[1][i][1] * v[1][i][1] + v[1][i][2] * v[1][i][2] + v[1][i][3] * v[1][i][3]; }
#pragma unroll
        for (int o = 32; o >= 1; o >>= 1) { ss0 += __shfl_xor(ss0, o); ss1 += __shfl_xor(ss1, o); }
        const float rstd0 = rsqrtf(ss0 * (1.0f / D) + 1e-6f), rstd1 = rsqrtf(ss1 * (1.0f / D) + 1e-6f);
#pragma unroll
        for (int h2 = 0; h2 < 2; ++h2) { const int k = 8 * (lane + 64 * h2);
#pragma unroll
            for (int rr = 0; rr < 2; ++rr) { const float rs = rr ? rstd1 : rstd0;
                const f32x4 ya = v[rr][2 * h2] * rs * gg[2 * h2] + s0[2 * h2], yb = v[rr][2 * h2 + 1] * rs * gg[2 * h2 + 1] + s0[2 * h2 + 1];
                u32x4 w; w[0] = cvt_pk_bf16(ya[0], ya[1]); w[1] = cvt_pk_bf16(ya[2], ya[3]); w[2] = cvt_pk_bf16(yb[0], yb[1]); w[3] = cvt_pk_bf16(yb[2], yb[3]);
                *(u32x4*)(H + (size_t)(row + rr) * D + k) = w; } }
        row = nrow;
    }
#undef NORM_LOAD
}
__device__ void ph_final_norm(const P& p) {
    const int lane = TIDX & 63, wv = TIDX >> 6;
    const int stride = gridDim.x * 16;
    int row = (blockIdx.x * 8 + wv) * 2;
    f32x4 v[2][4], nx[2][4], gg[4];
#pragma unroll
    for (int i = 0; i < 4; ++i) gg[i] = *(const f32x4*)(p.final_g + 4 * (lane + 64 * i));
#define FN_LOAD(dst, r_) { const float* xr_ = p.out + (size_t)(r_) * D; \
        _Pragma("unroll") for (int rr = 0; rr < 2; ++rr) _Pragma("unroll") for (int i = 0; i < 4; ++i) dst[rr][i] = *(const f32x4*)(xr_ + rr * D + 4 * (lane + 64 * i)); }
    if (row < T) FN_LOAD(nx, row)
    while (row < T) {
#pragma unroll
        for (int rr = 0; rr < 2; ++rr)
#pragma unroll
            for (int i = 0; i < 4; ++i) v[rr][i] = nx[rr][i];
        const int nrow = row + stride;
        if (nrow < T) FN_LOAD(nx, nrow)
        float ss0 = 0.f, ss1 = 0.f;
#pragma unroll
        for (int i = 0; i < 4; ++i) { ss0 += v[0][i][0] * v[0][i][0] + v[0][i][1] * v[0][i][1] + v[0][i][2] * v[0][i][2] + v[0][i][3] * v[0][i][3];
            ss1 += v[1][i][0] * v[1][i][0] + v[1][i][1] * v[1][i][1] + v[1][i][2] * v[1][i][2] + v[1][i][3] * v[1][i][3]; }
#pragma unroll
        for (int o = 32; o >= 1; o >>= 1) { ss0 += __shfl_xor(ss0, o); ss1 += __shfl_xor(ss1, o); }
        const float rstd0 = rsqrtf(ss0 * (1.0f / D) + 1e-6f), rstd1 = rsqrtf(ss1 * (1.0f / D) + 1e-6f);
        float* xr = p.out + (size_t)row * D;
#pragma unroll
        for (int i = 0; i < 4; ++i) { const int k = 4 * (lane + 64 * i); *(f32x4*)(xr + k) = v[0][i] * rstd0 * gg[i]; *(f32x4*)(xr + D + k) = v[1][i] * rstd1 * gg[i]; }
        row = nrow;
    }
#undef FN_LOAD
}

__device__ void ph_na_naive(const P& p) {
    const bf16_t* R = (const bf16_t*)(p.ws + WS_R);
    const bf16_t* QA = R; const bf16_t* KA = R + (size_t)TP * 512; const bf16_t* VA = R + (size_t)2 * TP * 512;
    bf16_t* Y = (bf16_t*)(p.ws + WS_H);
    for (int u = blockIdx.x; u < 512; u += gridDim.x) {
        const int head = u & 7, token = (u >> 3) * 512 + TIDX, b = token >> 14, n = token & (NSEQ - 1), gi = n >> 6, gj = n & 63;
        const int r0 = min(max(gi - 4, 0), 248), c0 = min(max(gj - 8, 0), 48);
        float q[64], acc[64];
        { const u32x4* qp = (const u32x4*)(QA + (size_t)token * 512 + head * 64);
#pragma unroll
          for (int i = 0; i < 8; ++i) { const u32x4 w = qp[i];
#pragma unroll
              for (int e = 0; e < 4; ++e) { q[i * 8 + 2 * e] = bflo(w[e]) * 0.125f; q[i * 8 + 2 * e + 1] = bfhi(w[e]) * 0.125f; } } }
#pragma unroll
        for (int d = 0; d < 64; ++d) acc[d] = 0.f;
        float m = -1e30f, l = 0.f;
        const float* rp = p.na_rpb + head * 465;
#pragma unroll 1
        for (int kidx = 0; kidx < 384; ++kidx) {
            int krow; float bias = 0.f;
            if (kidx < 128) { const int a = kidx >> 4, kk = kidx & 15; krow = (b << 14) + (r0 + a) * 64 + c0 + kk; bias = rp[(r0 + a - gi + 7) * 31 + (c0 + kk - gj + 15)]; }
            else krow = T + b * 256 + (kidx - 128);
            const u32x4* kp = (const u32x4*)(KA + (size_t)krow * 512 + head * 64);
            float s = 0.f;
#pragma unroll
            for (int i = 0; i < 8; ++i) { const u32x4 w = kp[i];
#pragma unroll
                for (int e = 0; e < 4; ++e) { s += q[i * 8 + 2 * e] * bflo(w[e]); s += q[i * 8 + 2 * e + 1] * bfhi(w[e]); } }
            s += bias;
            const float mn = fmaxf(m, s), sc = __expf(m - mn), pw = __expf(s - mn);
            l = l * sc + pw; m = mn;
            const u32x4* vp = (const u32x4*)(VA + (size_t)krow * 512 + head * 64);
#pragma unroll
            for (int i = 0; i < 8; ++i) { const u32x4 w = vp[i];
#pragma unroll
                for (int e = 0; e < 4; ++e) { acc[i * 8 + 2 * e] = acc[i * 8 + 2 * e] * sc + pw * bflo(w[e]); acc[i * 8 + 2 * e + 1] = acc[i * 8 + 2 * e + 1] * sc + pw * bfhi(w[e]); } }
        }
        const float il = 1.0f / l;
        u32x4* yp = (u32x4*)(Y + (size_t)token * 1024 + head * 64);
#pragma unroll
        for (int i = 0; i < 8; ++i) { u32x4 w;
#pragma unroll
            for (int e = 0; e < 4; ++e) w[e] = cvt_pk_bf16(acc[i * 8 + 2 * e] * il, acc[i * 8 + 2 * e + 1] * il);
            yp[i] = w; }
    }
}

__device__ __forceinline__ int ml_chunk_row0(int b, int d, int j) {
    if (j < 2) { const int oc = d ? 1 - j : j; return T + b * 256 + oc * 128; }
    const int oc = d ? 129 - j : j - 2; return (b << 14) + oc * 128;
}
__device__ __forceinline__ void ml_load_tile(LAS unsigned char* dst, const bf16_t* src, const LAS float* rowscale) {
    for (int i = TIDX; i < 128 * 16; i += NTHR) { const int r = i >> 4, ch = i & 15;
        u32x4 w = *(const u32x4*)(src + (size_t)r * 512 + ch * 8);
        if (rowscale) { const float a = rowscale[r];
#pragma unroll
            for (int e = 0; e < 4; ++e) w[e] = cvt_pk_bf16(bflo(w[e]) * a, bfhi(w[e]) * a); }
        *(LAS u32x4*)(dst + r * PITCH + ch * 16) = w; }
}

__device__ void ph_mlA_naive(const P& p, LAS unsigned char* lds) {
    const bf16_t* R = (const bf16_t*)(p.ws + WS_R);
    const bf16_t* KB = R + (size_t)4 * TP * 512; const bf16_t* VB = R + (size_t)5 * TP * 512; const float* Gt = (const float*)(R + (size_t)7 * TP * 512);
    bf16_t* CL = (bf16_t*)(p.ws + WS_CL); float* VEC = (float*)(p.ws + WS_VEC); float* NL = (float*)(p.ws + WS_NL);
    LAS unsigned char* Kt = lds; LAS unsigned char* Vt = lds + 128 * PITCH; LAS float* av = (LAS float*)(lds + 2 * 128 * PITCH);
    const int tid = TIDX, lane = tid & 63;
    for (int slot = blockIdx.x; slot < NSLOT; slot += gridDim.x) {
        const int j = slot % 130, bhd = slot / 130, d = bhd & 1, h = (bhd >> 1) & 3, b = bhd >> 3;
        const int row0 = ml_chunk_row0(b, d, j);
        __syncthreads();
        if (tid < 64) {
            const int p0 = 2 * lane, p1 = 2 * lane + 1, t0 = d ? 127 - p0 : p0, t1 = d ? 127 - p1 : p1;
            const int gofs = (h * 2 + d) * 2;
            const float i0 = Gt[(size_t)(row0 + t0) * 16 + gofs], f0 = Gt[(size_t)(row0 + t0) * 16 + gofs + 1];
            const float i1 = Gt[(size_t)(row0 + t1) * 16 + gofs], f1 = Gt[(size_t)(row0 + t1) * 16 + gofs + 1];
            float s = f0 + f1;
#pragma unroll
            for (int o = 1; o < 64; o <<= 1) { const float t = __shfl_up(s, o); if (lane >= o) s += t; }
            const float b1 = s, b0 = s - f1, z0 = i0 - b0, z1 = i1 - b1;
            float cmx = fmaxf(z0, z1);
#pragma unroll
            for (int o = 1; o < 64; o <<= 1) { const float t = __shfl_up(cmx, o); if (lane >= o) cmx = fmaxf(cmx, t); }
            float prev = __shfl_up(cmx, 1); if (lane == 0) prev = -1e30f;
            const float cm0 = fmaxf(prev, z0), cm1 = cmx;
            const float btot = __shfl(b1, 63), cml = __shfl(cm1, 63);
            float* vz = VEC + (size_t)slot * 512;
            vz[t0] = z0; vz[t1] = z1; vz[128 + t0] = b0; vz[128 + t1] = b1; vz[256 + t0] = cm0; vz[256 + t1] = cm1;
            if (lane == 0) { vz[384] = btot; vz[385] = btot + cml; }
            av[t0] = __expf(z0 - cml); av[t1] = __expf(z1 - cml);
        }
        __syncthreads();
        ml_load_tile(Kt, KB + (size_t)row0 * 512 + h * 128, nullptr);
        ml_load_tile(Vt, VB + (size_t)row0 * 512 + h * 128, av);
        __syncthreads();
        {
            const int v = tid >> 2, kq = tid & 3;
            float acc[32];
#pragma unroll
            for (int i = 0; i < 32; ++i) acc[i] = 0.f;
#pragma unroll 1
            for (int s = 0; s < 128; ++s) {
                const float avv = bf2f(*(const LAS bf16_t*)(Vt + s * PITCH + v * 2));
#pragma unroll
                for (int c = 0; c < 4; ++c) { const u32x4 w = *(const LAS u32x4*)(Kt + s * PITCH + kq * 64 + c * 16);
#pragma unroll
                    for (int e = 0; e < 4; ++e) { acc[c * 8 + 2 * e] += avv * bflo(w[e]); acc[c * 8 + 2 * e + 1] += avv * bfhi(w[e]); } }
            }
            bf16_t* cp = CL + (size_t)slot * 16384 + v * 128 + kq * 32;
#pragma unroll
            for (int c = 0; c < 4; ++c) { u32x4 w;
#pragma unroll
                for (int e = 0; e < 4; ++e) w[e] = cvt_pk_bf16(acc[c * 8 + 2 * e], acc[c * 8 + 2 * e + 1]);
                *(u32x4*)(cp + c * 8) = w; }
            if (tid < 128) { float sacc = 0.f; for (int s = 0; s < 128; ++s) sacc += av[s] * bf2f(*(const LAS bf16_t*)(Kt + s * PITCH + tid * 2)); NL[(size_t)slot * 128 + tid] = sacc; }
        }
    }
}

__device__ void ph_mlB(const P& p, LAS unsigned char* lds) {
    unsigned* CL = (unsigned*)(p.ws + WS_CL); float* VEC = (float*)(p.ws + WS_VEC); float* NL = (float*)(p.ws + WS_NL);
    LAS float* sb = (LAS float*)lds;
    const int tid = TIDX;
    for (int w = blockIdx.x; w < 16 * 16; w += gridDim.x) {
        const int stream = w >> 4, e2 = (w & 15) * 512 + tid;
        __syncthreads();
        if (tid < 130) { const float* vz = VEC + (size_t)(stream * 130 + tid) * 512 + 384; sb[2 * tid] = vz[0]; sb[2 * tid + 1] = vz[1]; }
        __syncthreads();
        float m = 0.f, c0 = 0.f, c1 = 0.f, n0 = 0.f, n1 = 0.f;
        const bool do_n = (w & 15) == 0 && tid < 64;
        unsigned* cp = CL + (size_t)stream * 130 * 8192 + e2;
        float* np = NL + (size_t)stream * 130 * 128 + 2 * tid;
        unsigned cl[13], cn[13]; f32x2 nlv[13], nnv[13];
#pragma unroll
        for (int jj = 0; jj < 13; ++jj) cn[jj] = cp[(size_t)jj * 8192];
        if (do_n) {
#pragma unroll
            for (int jj = 0; jj < 13; ++jj) nnv[jj] = *(const f32x2*)(np + (size_t)jj * 128);
        }
        for (int j0 = 0; j0 < 130; j0 += 13) {
#pragma unroll
            for (int jj = 0; jj < 13; ++jj) { cl[jj] = cn[jj]; nlv[jj] = nnv[jj]; }
            if (j0 + 13 < 130) {
#pragma unroll
                for (int jj = 0; jj < 13; ++jj) cn[jj] = cp[(size_t)(j0 + 13 + jj) * 8192];
                if (do_n) {
#pragma unroll
                    for (int jj = 0; jj < 13; ++jj) nnv[jj] = *(const f32x2*)(np + (size_t)(j0 + 13 + jj) * 128);
                }
            }
#pragma unroll
            for (int jj = 0; jj < 13; ++jj) {
                const int j = j0 + jj;
                const float btot = sb[2 * j], mloc = sb[2 * j + 1];
                cp[(size_t)j * 8192] = cvt_pk_bf16(c0, c1);
                const float mn = fmaxf(btot + m, mloc), ap = __expf(btot + m - mn), al = __expf(mloc - mn);
                if (do_n) { *(f32x2*)(np + (size_t)j * 128) = (f32x2){n0, n1}; n0 = ap * n0 + al * nlv[jj][0]; n1 = ap * n1 + al * nlv[jj][1]; }
                if ((w & 15) == 0 && tid == 0) VEC[(size_t)(stream * 130 + j) * 512 + 386] = m;
                c0 = ap * c0 + al * bflo(cl[jj]); c1 = ap * c1 + al * bfhi(cl[jj]); m = mn;
            }
        }
    }
}

__device__ void ph_mlC_naive(const P& p, LAS unsigned char* lds) {
    const bf16_t* R = (const bf16_t*)(p.ws + WS_R);
    const bf16_t* QB = R + (size_t)3 * TP * 512; const bf16_t* KB = R + (size_t)4 * TP * 512; const bf16_t* VB = R + (size_t)5 * TP * 512; const bf16_t* OB = R + (size_t)6 * TP * 512;
    const bf16_t* CL = (const bf16_t*)(p.ws + WS_CL); const float* VEC = (const float*)(p.ws + WS_VEC); const float* NL = (const float*)(p.ws + WS_NL);
    bf16_t* Y = (bf16_t*)(p.ws + WS_H);
    LAS unsigned char* Qt = lds; LAS unsigned char* Kt = lds + 128 * PITCH; LAS unsigned char* Vt = lds + 2 * 128 * PITCH; LAS unsigned char* Ct = lds + 3 * 128 * PITCH;
    LAS float* vz = (LAS float*)(lds + 4 * 128 * PITCH); LAS float* vb = vz + 128; LAS float* vcm = vb + 128; LAS float* vn = vcm + 128;
    const int tid = TIDX, t = tid >> 2, vq = tid & 3;
    for (int u = blockIdx.x; u < 1024; u += gridDim.x) {
        const int oc = u & 127, h = (u >> 7) & 3, b = u >> 9;
        const int row0 = (b << 14) + oc * 128;
        float hsum[32];
#pragma unroll
        for (int i = 0; i < 32; ++i) hsum[i] = 0.f;
        for (int d = 0; d < 2; ++d) {
            const int j = d ? 129 - oc : oc + 2, slot = ((b * 4 + h) * 2 + d) * 130 + j;
            __syncthreads();
            ml_load_tile(Qt, QB + (size_t)row0 * 512 + h * 128, nullptr);
            ml_load_tile(Kt, KB + (size_t)row0 * 512 + h * 128, nullptr);
            ml_load_tile(Vt, VB + (size_t)row0 * 512 + h * 128, nullptr);
            for (int i = tid; i < 128 * 16; i += NTHR) { const int r = i >> 4, ch = i & 15; *(LAS u32x4*)(Ct + r * PITCH + ch * 16) = *(const u32x4*)(CL + (size_t)slot * 16384 + r * 128 + ch * 8); }
            if (tid < 128) { const float* vp = VEC + (size_t)slot * 512; vz[tid] = vp[tid]; vb[tid] = vp[128 + tid]; vcm[tid] = vp[256 + tid]; vn[tid] = NL[(size_t)slot * 128 + tid]; }
            const float mprev = VEC[(size_t)slot * 512 + 386];
            __syncthreads();
            const float ut = -fmaxf(mprev, vcm[t]), winter = __expf(mprev + ut), flo = __expf(ut - vb[t]);
            float sc[32];
#pragma unroll
            for (int i = 0; i < 32; ++i) sc[i] = 0.f;
            float nq = 0.f;
#pragma unroll 1
            for (int kc = 0; kc < 16; ++kc) {
                const u32x4 qw = *(const LAS u32x4*)(Qt + t * PITCH + kc * 16);
                float qf[8];
#pragma unroll
                for (int e = 0; e < 4; ++e) { qf[2 * e] = bflo(qw[e]); qf[2 * e + 1] = bfhi(qw[e]); }
                if ((kc >> 2) == vq) {
#pragma unroll
                    for (int e = 0; e < 8; ++e) nq += qf[e] * vn[kc * 8 + e]; }
#pragma unroll
                for (int si = 0; si < 32; ++si) { const u32x4 kw = *(const LAS u32x4*)(Kt + (32 * vq + si) * PITCH + kc * 16);
#pragma unroll
                    for (int e = 0; e < 4; ++e) { sc[si] += qf[2 * e] * bflo(kw[e]); sc[si] += qf[2 * e + 1] * bfhi(kw[e]); }
                    asm volatile("" ::: "memory"); }
            }
            float rs = 0.f;
            int tt = t, s_base = 32 * vq; asm volatile("" : "+v"(tt), "+v"(s_base));
#pragma unroll
            for (int si = 0; si < 32; ++si) { const int s = s_base + si; const bool ok = d ? (s >= tt) : (s <= tt);
                const float w = ok ? __expf(ut + vz[s]) : 0.f; sc[si] *= w; rs += sc[si]; }
            rs += __shfl_xor(rs, 1); rs += __shfl_xor(rs, 2);
            nq += __shfl_xor(nq, 1); nq += __shfl_xor(nq, 2);
            __syncthreads();
#pragma unroll
            for (int c = 0; c < 4; ++c) { u32x4 w;
#pragma unroll
                for (int e = 0; e < 4; ++e) w[e] = cvt_pk_bf16(sc[c * 8 + 2 * e], sc[c * 8 + 2 * e + 1]);
                *(LAS u32x4*)(Kt + t * PITCH + vq * 64 + c * 16) = w; }
            __syncthreads();
            const float den = winter * nq + rs, dd = 1.0f / fmaxf(fabsf(den), flo);
#pragma unroll
            for (int hv = 0; hv < 2; ++hv) {
                float num[16];
#pragma unroll
                for (int i = 0; i < 16; ++i) num[i] = 0.f;
#pragma unroll 1
                for (int kc = 0; kc < 16; ++kc) {
                    const u32x4 qw = *(const LAS u32x4*)(Qt + t * PITCH + kc * 16);
                    float qf[8];
#pragma unroll
                    for (int e = 0; e < 4; ++e) { qf[2 * e] = bflo(qw[e]); qf[2 * e + 1] = bfhi(qw[e]); }
#pragma unroll
                    for (int vi = 0; vi < 16; ++vi) { const u32x4 cw = *(const LAS u32x4*)(Ct + (32 * vq + 16 * hv + vi) * PITCH + kc * 16);
#pragma unroll
                        for (int e = 0; e < 4; ++e) { num[vi] += qf[2 * e] * bflo(cw[e]); num[vi] += qf[2 * e + 1] * bfhi(cw[e]); }
                        asm volatile("" ::: "memory"); }
                }
#pragma unroll
                for (int i = 0; i < 16; ++i) num[i] *= winter;
#pragma unroll 1
                for (int s8 = 0; s8 < 16; ++s8) {
                    const u32x4 pw = *(const LAS u32x4*)(Kt + t * PITCH + s8 * 16);
                    float pf[8];
#pragma unroll
                    for (int e = 0; e < 4; ++e) { pf[2 * e] = bflo(pw[e]); pf[2 * e + 1] = bfhi(pw[e]); }
#pragma unroll
                    for (int ss = 0; ss < 8; ++ss) {
#pragma unroll
                        for (int c = 0; c < 2; ++c) { const u32x4 vw = *(const LAS u32x4*)(Vt + (s8 * 8 + ss) * PITCH + vq * 64 + hv * 32 + c * 16);
#pragma unroll
                            for (int e = 0; e < 4; ++e) { num[c * 8 + 2 * e] += pf[ss] * bflo(vw[e]); num[c * 8 + 2 * e + 1] += pf[ss] * bfhi(vw[e]); } }
                        asm volatile("" ::: "memory"); }
                }
#pragma unroll
                for (int i = 0; i < 16; ++i) hsum[hv * 16 + i] += num[i] * dd;
            }
        }
        float ss = 0.f;
#pragma unroll
        for (int i = 0; i < 32; ++i) ss += hsum[i] * hsum[i];
        ss += __shfl_xor(ss, 1); ss += __shfl_xor(ss, 2);
        const float rstd = rsqrtf(ss * (1.0f / 128.0f) + 1e-6f);
        const int row = row0 + t;
        const bf16_t* op = OB + (size_t)row * 512 + h * 128 + vq * 32; const float* hg = p.ml_head_g + h * 128 + vq * 32;
        bf16_t* yp = Y + (size_t)row * 1024 + 512 + h * 128 + vq * 32;
#pragma unroll
        for (int c = 0; c < 4; ++c) { const u32x4 ow = *(const u32x4*)(op + c * 8); u32x4 w;
#pragma unroll
            for (int e = 0; e < 4; ++e) { const int i0 = c * 8 + 2 * e;
                const float y0 = hsum[i0] * rstd * hg[i0] * sigmoid_f(bflo(ow[e])), y1 = hsum[i0 + 1] * rstd * hg[i0 + 1] * sigmoid_f(bfhi(ow[e]));
                w[e] = cvt_pk_bf16(y0, y1); }
            *(u32x4*)(yp + c * 8) = w; }
    }
}

__device__ void ph_sg_stats(const P& p) {
    const bf16_t* V = (const bf16_t*)(p.ws + WS_R) + (size_t)T * 2048; float* ST = (float*)(p.ws + WS_ST);
    const int lane = TIDX & 63, wv = TIDX >> 6;
    for (int row = blockIdx.x * 8 + wv; row < T; row += gridDim.x * 8) {
        float vals[32]; float s = 0.f;
#pragma unroll
        for (int i = 0; i < 4; ++i) { const u32x4 w = *(const u32x4*)(V + (size_t)row * 2048 + 8 * (lane + 64 * i));
#pragma unroll
            for (int e = 0; e < 4; ++e) { vals[i * 8 + 2 * e] = bflo(w[e]); vals[i * 8 + 2 * e + 1] = bfhi(w[e]); s += vals[i * 8 + 2 * e] + vals[i * 8 + 2 * e + 1]; } }
#pragma unroll
        for (int o = 32; o >= 1; o >>= 1) s += __shfl_xor(s, o);
        const float mu = s * (1.0f / 2048.0f); float q = 0.f;
#pragma unroll
        for (int i = 0; i < 32; ++i) { const float dlt = vals[i] - mu; q += dlt * dlt; }
#pragma unroll
        for (int o = 32; o >= 1; o >>= 1) q += __shfl_xor(q, o);
        if (lane == 0) { ST[2 * row] = mu; ST[2 * row + 1] = rsqrtf(q * (1.0f / 2048.0f) + 1e-6f); }
    }
}
__device__ void ph_sg_naive(const P& p, LAS unsigned char* lds) {
    bf16_t* U = (bf16_t*)(p.ws + WS_R); const bf16_t* V = U + (size_t)T * 2048; const float* ST = (const float*)(p.ws + WS_ST);
    constexpr int VP = 528;
    LAS unsigned char* Vn = lds; LAS unsigned char* Wt = lds + 128 * VP;
    const int tid = TIDX, t = tid >> 2, dq = tid & 3;
    for (int u = blockIdx.x; u < 2048; u += gridDim.x) {
        const int g = u & 7, ch = u >> 3, row0 = ch * 128;
        __syncthreads();
        for (int i = tid; i < 128 * 32; i += NTHR) { const int r = i >> 5, c8 = i & 31; const int cbase = g * 256 + c8 * 8;
            const u32x4 w = *(const u32x4*)(V + (size_t)(row0 + r) * 2048 + cbase); const float mu = ST[2 * (row0 + r)], rs = ST[2 * (row0 + r) + 1];
            const f32x4 g0 = *(const f32x4*)(p.sg_ln_g + cbase), g1 = *(const f32x4*)(p.sg_ln_g + cbase + 4), b0 = *(const f32x4*)(p.sg_ln_b + cbase), b1 = *(const f32x4*)(p.sg_ln_b + cbase + 4);
            u32x4 o;
            o[0] = cvt_pk_bf16((bflo(w[0]) - mu) * rs * g0[0] + b0[0], (bfhi(w[0]) - mu) * rs * g0[1] + b0[1]);
            o[1] = cvt_pk_bf16((bflo(w[1]) - mu) * rs * g0[2] + b0[2], (bfhi(w[1]) - mu) * rs * g0[3] + b0[3]);
            o[2] = cvt_pk_bf16((bflo(w[2]) - mu) * rs * g1[0] + b1[0], (bfhi(w[2]) - mu) * rs * g1[1] + b1[1]);
            o[3] = cvt_pk_bf16((bflo(w[3]) - mu) * rs * g1[2] + b1[2], (bfhi(w[3]) - mu) * rs * g1[3] + b1[3]);
            *(LAS u32x4*)(Vn + r * VP + c8 * 16) = o; }
        for (int i = tid; i < 128 * 32; i += NTHR) { const int r = i >> 5, c4 = i & 31; const f32x4 w = *(const f32x4*)(p.sg_w_s + (size_t)g * 16384 + r * 128 + c4 * 4);
            u32x2 o; o.x = cvt_pk_bf16(w[0], w[1]); o.y = cvt_pk_bf16(w[2], w[3]); *(LAS u32x2*)(Wt + r * PITCH + c4 * 8) = o; }
        __syncthreads();
        float acc[64];
#pragma unroll
        for (int i = 0; i < 64; ++i) acc[i] = 0.f;
#pragma unroll 1
        for (int s8 = 0; s8 < 16; ++s8) {
            const u32x4 ww = *(const LAS u32x4*)(Wt + t * PITCH + s8 * 16);
            float wf[8];
#pragma unroll
            for (int e = 0; e < 4; ++e) { wf[2 * e] = bflo(ww[e]); wf[2 * e + 1] = bfhi(ww[e]); }
#pragma unroll
            for (int ss = 0; ss < 8; ++ss) {
#pragma unroll
                for (int c = 0; c < 8; ++c) { const u32x4 vw = *(const LAS u32x4*)(Vn + (s8 * 8 + ss) * VP + dq * 128 + c * 16);
#pragma unroll
                    for (int e = 0; e < 4; ++e) { acc[c * 8 + 2 * e] += wf[ss] * bflo(vw[e]); acc[c * 8 + 2 * e + 1] += wf[ss] * bfhi(vw[e]); }
                    if ((c & 3) == 3) asm volatile("" ::: "memory"); } }
        }
        const float bs = p.sg_b_s[g * 128 + t];
        bf16_t* up = U + (size_t)(row0 + t) * 2048 + g * 256 + dq * 64;
#pragma unroll
        for (int c = 0; c < 8; ++c) { const u32x4 uw = *(const u32x4*)(up + c * 8); u32x4 o;
#pragma unroll
            for (int e = 0; e < 4; ++e) o[e] = cvt_pk_bf16(bflo(uw[e]) * (acc[c * 8 + 2 * e] + bs), bfhi(uw[e]) * (acc[c * 8 + 2 * e + 1] + bs));
            *(u32x4*)(up + c * 8) = o; }
    }
}

typedef short s16x4 __attribute__((ext_vector_type(4)));
__device__ __forceinline__ s16x4 ds_tr(LAS unsigned char* a) { return __builtin_amdgcn_ds_read_tr16_b64_v4i16((LAS s16x4*)a); }
__device__ __forceinline__ bf16x8 cat8(s16x4 lo, s16x4 hi) { return __builtin_shufflevector(lo, hi, 0, 1, 2, 3, 4, 5, 6, 7); }
__device__ __forceinline__ f32x4 mfma16(bf16x8 a, bf16x8 b, f32x4 c) { return __builtin_amdgcn_mfma_f32_16x16x32_bf16(a, b, c, 0, 0, 0); }
__device__ __forceinline__ bf16x8 pk8(f32x4 a, f32x4 b) { u32x4 w; w[0] = cvt_pk_bf16(a[0], a[1]); w[1] = cvt_pk_bf16(a[2], a[3]); w[2] = cvt_pk_bf16(b[0], b[1]); w[3] = cvt_pk_bf16(b[2], b[3]); return __builtin_bit_cast(bf16x8, w); }
constexpr int TPI = 304;
__device__ __forceinline__ void ml_load_tile2(LAS unsigned char* dst, const bf16_t* src, int srcstride, const LAS float* rowscale, int tid) {
    for (int i = tid; i < 128 * 16; i += NTHR) { const int r = i >> 4, ch = i & 15;
        u32x4 w = *(const u32x4*)(src + (size_t)r * srcstride + ch * 8);
        if (rowscale) { const float a = rowscale[r];
#pragma unroll
            for (int e = 0; e < 4; ++e) w[e] = cvt_pk_bf16(bflo(w[e]) * a, bfhi(w[e]) * a); }
        *(LAS u32x4*)(dst + r * TPI + ch * 16) = w; }
}

__device__ void ph_na(const P& p, LAS unsigned char* lds) {
    const bf16_t* R = (const bf16_t*)(p.ws + WS_R);
    const bf16_t* QA = R; const bf16_t* KA = R + (size_t)TP * 512; const bf16_t* VA = R + (size_t)2 * TP * 512;
    bf16_t* Y = (bf16_t*)(p.ws + WS_H);
    constexpr int VP = 144;
    LAS unsigned char* Vl = lds; LAS unsigned char* Vc = lds + 512 * VP;
    LAS float* comb = (LAS float*)(lds + 768 * VP); LAS float* rpbs = comb + 4 * 18 * 64;
    const int tid = TIDX, lane = tid & 63, w = __builtin_amdgcn_readfirstlane(tid >> 6), c = lane & 15, g = lane >> 4, qb = w & 3, half = w >> 2;
    const int qq = (lane & 15) >> 2, pp = lane & 3;
    const int per = (4096 + gridDim.x - 1) / gridDim.x;
    const int u_lo = blockIdx.x * per, u_hi = min(u_lo + per, 4096);
    int last_bh = -1;
    const int cstart = (qb == 0) ? 0 : (qb == 1) ? 8 : (qb == 2) ? 24 : 32;
    u32x4 vnew = {0u, 0u, 0u, 0u}; int pf_row = -1; bf16x8 qn[2] = {};
    int crm[2][4];
    { const int qcol = 16 * qb + c, c0 = min(max(qcol - 8, 0), 48);
#pragma unroll
      for (int chh = 0; chh < 2; ++chh)
#pragma unroll
          for (int j = 0; j < 4; ++j) { const int col = cstart + 16 * chh + 4 * g + j; crm[chh][j] = ((col >= c0) && (col < c0 + 16)) ? (col - qcol + 15) : 31; } }
    for (int u = u_lo; u < u_hi; ++u) {
        const int gi = u & 255, bh = u >> 8, head = bh & 7, b = bh >> 3;
        const int r0 = min(max(gi - 4, 0), 248);
        const int token = (b << 14) + gi * 64 + 16 * qb + c;
        bf16x8 qf[2];
        if (bh != last_bh) {
            for (int i = tid; i < 256 * 8; i += NTHR) { const int key = i >> 3, ch = i & 7;
                *(LAS u32x4*)(Vc + key * VP + ch * 16) = *(const u32x4*)(VA + (size_t)(T + b * 256 + key) * 512 + head * 64 + ch * 8); }
            if (tid < 480) { const int rr = tid >> 5, cc = tid & 31; rpbs[tid] = (cc < 31) ? p.na_rpb[head * 465 + rr * 31 + cc] * 1.4426950408889634f : -1e30f; }
            for (int i = tid; i < 512 * 8; i += NTHR) { const int key = i >> 3, ch = i & 7, row = r0 + (key >> 6);
                *(LAS u32x4*)(Vl + ((row & 7) * 64 + (key & 63)) * VP + ch * 16) = *(const u32x4*)(VA + (size_t)((b << 14) + row * 64 + (key & 63)) * 512 + head * 64 + ch * 8); }
            qf[0] = *(const bf16x8*)(QA + (size_t)token * 512 + head * 64 + 8 * g); qf[1] = *(const bf16x8*)(QA + (size_t)token * 512 + head * 64 + 32 + 8 * g);
            last_bh = bh;
        } else {
            if (pf_row >= 0) *(LAS u32x4*)(Vl + ((pf_row & 7) * 64 + (tid >> 3)) * VP + (tid & 7) * 16) = vnew;
            qf[0] = qn[0]; qf[1] = qn[1];
        }
        __syncthreads();
        pf_row = -1;
        if (u + 1 < u_hi && ((u + 1) >> 8) == bh) {
            const int gin = gi + 1, r0n = min(max(gin - 4, 0), 248);
            if (r0n != r0) { pf_row = r0n + 7; vnew = *(const u32x4*)(VA + (size_t)((b << 14) + pf_row * 64 + (tid >> 3)) * 512 + head * 64 + (tid & 7) * 8); }
            const size_t tn = (size_t)((b << 14) + gin * 64 + 16 * qb + c) * 512 + head * 64 + 8 * g;
            qn[0] = *(const bf16x8*)(QA + tn); qn[1] = *(const bf16x8*)(QA + tn + 32);
        }
        f32x4 sc[16];
        const LAS float* rrow = rpbs + (r0 - gi + 7) * 32;
#pragma unroll
        for (int kt = 0; kt < 16; ++kt) {
            const int a = kt >> 1, chh = kt & 1;
            const int krow = half ? (T + b * 256 + 16 * kt + c) : ((b << 14) + (r0 + a) * 64 + cstart + 16 * chh + c);
            const bf16_t* kp = KA + (size_t)krow * 512 + head * 64 + 8 * g;
            const bf16x8 A0 = *(const bf16x8*)kp, A1 = *(const bf16x8*)(kp + 32);
            f32x4 acc = {0.f, 0.f, 0.f, 0.f};
            acc = mfma16(A0, qf[0], acc); acc = mfma16(A1, qf[1], acc);
            if (half == 0) {
#pragma unroll
                for (int j = 0; j < 4; ++j) acc[j] = acc[j] * 0.18033688011112042f + rrow[a * 32 + crm[chh][j]];
            } else acc = acc * 0.18033688011112042f;
            sc[kt] = acc;
        }
        float m = -1e30f;
#pragma unroll
        for (int kt = 0; kt < 16; ++kt) m = fmaxf(m, fmaxf(fmaxf(sc[kt][0], sc[kt][1]), fmaxf(sc[kt][2], sc[kt][3])));
        m = fmaxf(m, __shfl_xor(m, 16)); m = fmaxf(m, __shfl_xor(m, 32));
        float l = 0.f;
#pragma unroll
        for (int kt = 0; kt < 16; ++kt) {
#pragma unroll
            for (int j = 0; j < 4; ++j) { const float e = __builtin_amdgcn_exp2f(sc[kt][j] - m); sc[kt][j] = e; l += e; } }
        l += __shfl_xor(l, 16); l += __shfl_xor(l, 32);
        f32x4 o[4];
#pragma unroll
        for (int dt = 0; dt < 4; ++dt) o[dt] = (f32x4){0.f, 0.f, 0.f, 0.f};
#pragma unroll
        for (int kp = 0; kp < 8; ++kp) {
            const bf16x8 pf = pk8(sc[2 * kp], sc[2 * kp + 1]);
            LAS unsigned char* vb = half ? (Vc + (32 * kp + 4 * g + qq) * VP + 8 * pp) : (Vl + ((((r0 + kp) & 7) * 64) + cstart + 4 * g + qq) * VP + 8 * pp);
#pragma unroll
            for (int dt = 0; dt < 4; ++dt) { const s16x4 lo = ds_tr(vb + dt * 32), hi = ds_tr(vb + 16 * VP + dt * 32); o[dt] = mfma16(cat8(lo, hi), pf, o[dt]); }
        }
        if (half == 1) { LAS float* cb = comb + qb * 18 * 64 + lane; cb[0] = m; cb[64] = l;
#pragma unroll
            for (int dt = 0; dt < 4; ++dt)
#pragma unroll
                for (int j = 0; j < 4; ++j) cb[(2 + 4 * dt + j) * 64] = o[dt][j]; }
        __syncthreads();
        if (half == 0) { const LAS float* cb = comb + qb * 18 * 64 + lane; const float m1 = cb[0], l1 = cb[64];
            const float M = fmaxf(m, m1), e0 = __builtin_amdgcn_exp2f(m - M), e1 = __builtin_amdgcn_exp2f(m1 - M), il = 1.0f / (l * e0 + l1 * e1);
            bf16_t* yp = Y + (size_t)token * 1024 + head * 64 + 4 * g;
#pragma unroll
            for (int dt = 0; dt < 4; ++dt) { f32x4 r;
#pragma unroll
                for (int j = 0; j < 4; ++j) r[j] = (o[dt][j] * e0 + cb[(2 + 4 * dt + j) * 64] * e1) * il;
                u32x2 wv; wv.x = cvt_pk_bf16(r[0], r[1]); wv.y = cvt_pk_bf16(r[2], r[3]); *(u32x2*)(yp + 16 * dt) = wv; } }
    }
}

__device__ void ph_na2(const P& p, LAS unsigned char* lds) {
    const bf16_t* R = (const bf16_t*)(p.ws + WS_R);
    const bf16_t* QA = R; const bf16_t* KA = R + (size_t)TP * 512; const bf16_t* VA = R + (size_t)2 * TP * 512;
    bf16_t* Y = (bf16_t*)(p.ws + WS_H);
    constexpr int VP = 144, RING = 11;
    LAS unsigned char* Vl = lds; LAS unsigned char* Vc = lds + RING * 64 * VP; LAS float* rpbs = (LAS float*)(lds + (RING * 64 + 256) * VP);
    const int tid = TIDX, lane = tid & 63, w = __builtin_amdgcn_readfirstlane(tid >> 6), c = lane & 15, g = lane >> 4, qb = w & 3, ur = w >> 2;
    const int qq = (lane & 15) >> 2, pp = lane & 3;
    const int per = (4096 + gridDim.x - 1) / gridDim.x;
    const int u_lo = blockIdx.x * per, u_hi = min(u_lo + per, 4096);
    int last_bh = -1, have_hi = -1;
    const int cstart = (qb == 0) ? 0 : (qb == 1) ? 8 : (qb == 2) ? 24 : 32;
    u32x4 vnew0 = {0u, 0u, 0u, 0u}, vnew1 = vnew0; int pf_n = 0; bf16x8 qn[2] = {};
    int crm[2][4];
    { const int qcol = 16 * qb + c, c0 = min(max(qcol - 8, 0), 48);
#pragma unroll
      for (int chh = 0; chh < 2; ++chh)
#pragma unroll
          for (int j = 0; j < 4; ++j) { const int col = cstart + 16 * chh + 4 * g + j; crm[chh][j] = ((col >= c0) && (col < c0 + 16)) ? (col - qcol + 15) : 31; } }
    for (int u0 = u_lo; u0 < u_hi; u0 += 2) {
        const int bh = u0 >> 8, head = bh & 7, b = bh >> 3, gi0 = u0 & 255;
        const int r0a = min(max(gi0 - 4, 0), 248), r0b = min(max(gi0 - 3, 0), 248);
        const int gi = gi0 + ur, r0 = ur ? r0b : r0a;
        const bool valid = (u0 + ur) < u_hi;
        const int token = (b << 14) + gi * 64 + 16 * qb + c;
        bf16x8 qf[2];
        if (bh != last_bh) {
            __syncthreads();
            for (int i = tid; i < 256 * 8; i += NTHR) { const int key = i >> 3, ch = i & 7;
                *(LAS u32x4*)(Vc + key * VP + ch * 16) = *(const u32x4*)(VA + (size_t)(T + b * 256 + key) * 512 + head * 64 + ch * 8); }
            if (tid < 480) { const int rr = tid >> 5, cc = tid & 31; rpbs[tid] = (cc < 31) ? p.na_rpb[head * 465 + rr * 31 + cc] * 1.4426950408889634f : -1e30f; }
            for (int i = tid; i < 9 * 64 * 8; i += NTHR) { const int key = i >> 3, ch = i & 7, row = r0a + (key >> 6);
                if (row <= r0b + 7) *(LAS u32x4*)(Vl + ((row % RING) * 64 + (key & 63)) * VP + ch * 16) = *(const u32x4*)(VA + (size_t)((b << 14) + row * 64 + (key & 63)) * 512 + head * 64 + ch * 8); }
            qf[0] = *(const bf16x8*)(QA + (size_t)token * 512 + head * 64 + 8 * g); qf[1] = *(const bf16x8*)(QA + (size_t)token * 512 + head * 64 + 32 + 8 * g);
            last_bh = bh; have_hi = r0b + 7;
        } else {
            if (pf_n > 0) *(LAS u32x4*)(Vl + (((have_hi + 1) % RING) * 64 + (tid >> 3)) * VP + (tid & 7) * 16) = vnew0;
            if (pf_n > 1) *(LAS u32x4*)(Vl + (((have_hi + 2) % RING) * 64 + (tid >> 3)) * VP + (tid & 7) * 16) = vnew1;
            have_hi += pf_n;
            qf[0] = qn[0]; qf[1] = qn[1];
        }
        __syncthreads();
        pf_n = 0;
        if (u0 + 2 < u_hi && ((u0 + 2) >> 8) == bh) {
            const int need_hi = min(max(gi0 - 1, 0), 248) + 7;
            pf_n = need_hi - have_hi;
            if (pf_n > 0) vnew0 = *(const u32x4*)(VA + (size_t)((b << 14) + (have_hi + 1) * 64 + (tid >> 3)) * 512 + head * 64 + (tid & 7) * 8);
            if (pf_n > 1) vnew1 = *(const u32x4*)(VA + (size_t)((b << 14) + (have_hi + 2) * 64 + (tid >> 3)) * 512 + head * 64 + (tid & 7) * 8);
            const size_t tn = (size_t)((b << 14) + (gi + 2) * 64 + 16 * qb + c) * 512 + head * 64 + 8 * g;
            qn[0] = *(const bf16x8*)(QA + tn); qn[1] = *(const bf16x8*)(QA + tn + 32);
        }
        if (valid) {
            const LAS float* rrow = rpbs + (r0 - gi + 7) * 32;
            const bf16_t* kl = KA + (size_t)((b << 14) + r0 * 64 + cstart + c) * 512 + head * 64 + 8 * g;
            const bf16_t* kc = KA + (size_t)(T + b * 256 + c) * 512 + head * 64 + 8 * g;
            float M = -1e30f, L = 0.f;
            f32x4 o[4];
#pragma unroll
            for (int dt = 0; dt < 4; ++dt) o[dt] = (f32x4){0.f, 0.f, 0.f, 0.f};
#pragma unroll 1
            for (int hf = 0; hf < 2; ++hf) {
                f32x4 sc[16];
#pragma unroll
                for (int kt = 0; kt < 16; ++kt) {
                    const int a = kt >> 1, chh = kt & 1;
                    const bf16_t* kp = hf ? kc : kl;
                    if (hf) kc += 16 * 512; else kl += (chh ? 48 : 16) * 512;
                    const bf16x8 A0 = *(const bf16x8*)kp, A1 = *(const bf16x8*)(kp + 32);
                    f32x4 acc = {0.f, 0.f, 0.f, 0.f};
                    acc = mfma16(A0, qf[0], acc); acc = mfma16(A1, qf[1], acc);
                    if (hf == 0) {
#pragma unroll
                        for (int j = 0; j < 4; ++j) acc[j] = acc[j] * 0.18033688011112042f + rrow[a * 32 + crm[chh][j]];
                    } else acc = acc * 0.18033688011112042f;
                    sc[kt] = acc;
                    if ((kt & 7) == 7) asm volatile("" : "+v"(kl), "+v"(kc) :: "memory");
                }
                float m = -1e30f;
#pragma unroll
                for (int kt = 0; kt < 16; ++kt) m = fmaxf(m, fmaxf(fmaxf(sc[kt][0], sc[kt][1]), fmaxf(sc[kt][2], sc[kt][3])));
                m = fmaxf(m, __shfl_xor(m, 16)); m = fmaxf(m, __shfl_xor(m, 32));
                const float mn = fmaxf(M, m), es = __builtin_amdgcn_exp2f(M - mn);
                float l = 0.f;
#pragma unroll
                for (int kt = 0; kt < 16; ++kt) {
#pragma unroll
                    for (int j = 0; j < 4; ++j) { const float e = __builtin_amdgcn_exp2f(sc[kt][j] - mn); sc[kt][j] = e; l += e; } }
                l += __shfl_xor(l, 16); l += __shfl_xor(l, 32);
                L = L * es + l; M = mn;
#pragma unroll
                for (int dt = 0; dt < 4; ++dt) o[dt] = o[dt] * es;
#pragma unroll
                for (int kp = 0; kp < 8; ++kp) {
                    const bf16x8 pf = pk8(sc[2 * kp], sc[2 * kp + 1]);
                    LAS unsigned char* vb = hf ? (Vc + (32 * kp + 4 * g + qq) * VP + 8 * pp) : (Vl + ((((r0 + kp) % RING) * 64) + cstart + 4 * g + qq) * VP + 8 * pp);
#pragma unroll
                    for (int dt = 0; dt < 4; ++dt) { const s16x4 lo = ds_tr(vb + dt * 32), hi = ds_tr(vb + 16 * VP + dt * 32); o[dt] = mfma16(cat8(lo, hi), pf, o[dt]); }
                    if (kp & 1) asm volatile("" ::: "memory");
                }
            }
            const float il = 1.0f / L;
            bf16_t* yp = Y + (size_t)token * 1024 + head * 64 + 4 * g;
#pragma unroll
            for (int dt = 0; dt < 4; ++dt) { u32x2 wv; wv.x = cvt_pk_bf16(o[dt][0] * il, o[dt][1] * il); wv.y = cvt_pk_bf16(o[dt][2] * il, o[dt][3] * il); *(u32x2*)(yp + 16 * dt) = wv; }
        }
    }
}

__device__ void ph_mlA(const P& p, LAS unsigned char* lds) {
    const bf16_t* R = (const bf16_t*)(p.ws + WS_R);
    const bf16_t* KB = R + (size_t)4 * TP * 512; const bf16_t* VB = R + (size_t)5 * TP * 512; const float* Gt = (const float*)(R + (size_t)7 * TP * 512);
    bf16_t* CL = (bf16_t*)(p.ws + WS_CL); float* VEC = (float*)(p.ws + WS_VEC); float* NL = (float*)(p.ws + WS_NL);
    LAS unsigned char* Kt = lds; LAS unsigned char* Vt = lds + 128 * TPI; LAS float* av = (LAS float*)(lds + 2 * 128 * TPI);
    const int tid = TIDX, lane = tid & 63, w = __builtin_amdgcn_readfirstlane(tid >> 6), c = lane & 15, g = lane >> 4, qq = (lane & 15) >> 2, pp = lane & 3;
    const int ch = tid & 15, rb = tid >> 4;
    u32x4 kr[4], vr[4]; float gi0 = 0.f, gf0 = 0.f, gi1 = 0.f, gf1 = 0.f;
#define MLA_PREFETCH(sl) { const int j_ = (sl) % 130, bhd_ = (sl) / 130, d_ = bhd_ & 1, h_ = (bhd_ >> 1) & 3, b_ = bhd_ >> 3; const int row0_ = ml_chunk_row0(b_, d_, j_); \
        _Pragma("unroll") for (int k = 0; k < 4; ++k) { const size_t o_ = (size_t)(row0_ + rb + 32 * k) * 512 + h_ * 128 + ch * 8; kr[k] = *(const u32x4*)(KB + o_); vr[k] = *(const u32x4*)(VB + o_); } \
        if (w == 0) { const int p0 = 2 * lane, t0 = d_ ? 127 - p0 : p0, t1 = d_ ? 126 - p0 : p0 + 1; const int gofs = (h_ * 2 + d_) * 2; \
            gi0 = Gt[(size_t)(row0_ + t0) * 16 + gofs]; gf0 = Gt[(size_t)(row0_ + t0) * 16 + gofs + 1]; gi1 = Gt[(size_t)(row0_ + t1) * 16 + gofs]; gf1 = Gt[(size_t)(row0_ + t1) * 16 + gofs + 1]; } }
    int slot = blockIdx.x;
    if (slot < NSLOT) MLA_PREFETCH(slot)
    while (slot < NSLOT) {
        const int d = (slot / 130) & 1;
        __syncthreads();
        if (w == 0) {
            const int p0 = 2 * lane, p1 = 2 * lane + 1, t0 = d ? 127 - p0 : p0, t1 = d ? 127 - p1 : p1;
            const float i0 = gi0, f0 = gf0, i1 = gi1, f1 = gf1;
            float s = f0 + f1;
#pragma unroll
            for (int o = 1; o < 64; o <<= 1) { const float t = __shfl_up(s, o); if (lane >= o) s += t; }
            const float b1 = s, b0 = s - f1, z0 = i0 - b0, z1 = i1 - b1;
            float cmx = fmaxf(z0, z1);
#pragma unroll
            for (int o = 1; o < 64; o <<= 1) { const float t = __shfl_up(cmx, o); if (lane >= o) cmx = fmaxf(cmx, t); }
            float prev = __shfl_up(cmx, 1); if (lane == 0) prev = -1e30f;
            const float cm0 = fmaxf(prev, z0), cm1 = cmx;
            const float btot = __shfl(b1, 63), cml = __shfl(cm1, 63);
            float* vz = VEC + (size_t)slot * 512;
            vz[t0] = z0; vz[t1] = z1; vz[128 + t0] = b0; vz[128 + t1] = b1; vz[256 + t0] = cm0; vz[256 + t1] = cm1;
            if (lane == 0) { vz[384] = btot; vz[385] = btot + cml; }
            av[t0] = __expf(z0 - cml); av[t1] = __expf(z1 - cml);
        }
#pragma unroll
        for (int k = 0; k < 4; ++k) *(LAS u32x4*)(Kt + (rb + 32 * k) * TPI + ch * 16) = kr[k];
        __syncthreads();
#pragma unroll
        for (int k = 0; k < 4; ++k) { const float a = av[rb + 32 * k]; u32x4 wv = vr[k];
#pragma unroll
            for (int e = 0; e < 4; ++e) wv[e] = cvt_pk_bf16(bflo(wv[e]) * a, bfhi(wv[e]) * a);
            *(LAS u32x4*)(Vt + (rb + 32 * k) * TPI + ch * 16) = wv; }
        const int nslot = slot + gridDim.x;
        if (nslot < NSLOT) MLA_PREFETCH(nslot)
        __syncthreads();
        bf16x8 bv[4], af[4];
#pragma unroll
        for (int ks = 0; ks < 4; ++ks) { LAS unsigned char* a = Vt + (32 * ks + 8 * g + qq) * TPI + (16 * w + 4 * pp) * 2; bv[ks] = cat8(ds_tr(a), ds_tr(a + 4 * TPI));
            const f32x4 a0 = *(const LAS f32x4*)(av + 32 * ks + 8 * g), a1 = *(const LAS f32x4*)(av + 32 * ks + 8 * g + 4); af[ks] = pk8(a0, a1); }
        bf16_t* cp = CL + (size_t)slot * 16384 + (16 * w + c) * 128 + 4 * g;
#pragma unroll
        for (int kt = 0; kt < 8; ++kt) { f32x4 acc = {0.f, 0.f, 0.f, 0.f}, nacc = {0.f, 0.f, 0.f, 0.f};
#pragma unroll
            for (int ks = 0; ks < 4; ++ks) { LAS unsigned char* a = Kt + (32 * ks + 8 * g + qq) * TPI + (16 * kt + 4 * pp) * 2; const bf16x8 kf = cat8(ds_tr(a), ds_tr(a + 4 * TPI));
                acc = mfma16(kf, bv[ks], acc);
                if (kt == w) nacc = mfma16(kf, af[ks], nacc); }
            u32x2 wv; wv.x = cvt_pk_bf16(acc[0], acc[1]); wv.y = cvt_pk_bf16(acc[2], acc[3]); *(u32x2*)(cp + 16 * kt) = wv;
            if (kt == w && c == 0) *(f32x4*)(NL + (size_t)slot * 128 + 16 * kt + 4 * g) = nacc; }
        slot = nslot;
    }
#undef MLA_PREFETCH
}

__device__ void ph_mlC(const P& p, LAS unsigned char* lds) {
    const bf16_t* R = (const bf16_t*)(p.ws + WS_R);
    const bf16_t* QB = R + (size_t)3 * TP * 512; const bf16_t* KB = R + (size_t)4 * TP * 512; const bf16_t* VB = R + (size_t)5 * TP * 512; const bf16_t* OB = R + (size_t)6 * TP * 512;
    const bf16_t* CL = (const bf16_t*)(p.ws + WS_CL); const float* VEC = (const float*)(p.ws + WS_VEC); const float* NL = (const float*)(p.ws + WS_NL);
    bf16_t* Y = (bf16_t*)(p.ws + WS_H);
    LAS unsigned char* Kt = lds; LAS unsigned char* Vt = lds + 128 * TPI; LAS unsigned char* Ct = lds + 2 * 128 * TPI;
    LAS float* vz = (LAS float*)(lds + 3 * 128 * TPI); LAS float* vb = vz + 128; LAS float* vcm = vb + 128; LAS float* vn = vcm + 128;
    const int tid = TIDX, lane = tid & 63, w = __builtin_amdgcn_readfirstlane(tid >> 6), c = lane & 15, g = lane >> 4, qq = (lane & 15) >> 2, pp = lane & 3;
    const int t = 16 * w + c;
    for (int u = blockIdx.x; u < 1024; u += gridDim.x) {
        const int oc = u & 127, h = (u >> 7) & 3, b = u >> 9;
        const int row0 = (b << 14) + oc * 128;
        __syncthreads();
        {
            const int ch = tid & 15, rb = tid >> 4; u32x4 kr[4], vr[4];
#pragma unroll
            for (int k = 0; k < 4; ++k) { const size_t o = (size_t)(row0 + rb + 32 * k) * 512 + h * 128 + ch * 8; kr[k] = *(const u32x4*)(KB + o); vr[k] = *(const u32x4*)(VB + o); }
#pragma unroll
            for (int k = 0; k < 4; ++k) { *(LAS u32x4*)(Kt + (rb + 32 * k) * TPI + ch * 16) = kr[k]; *(LAS u32x4*)(Vt + (rb + 32 * k) * TPI + ch * 16) = vr[k]; }
        }
        bf16x8 qf[4];
#pragma unroll
        for (int ks = 0; ks < 4; ++ks) qf[ks] = *(const bf16x8*)(QB + (size_t)(row0 + t) * 512 + h * 128 + 32 * ks + 8 * g);
        f32x4 hsum[8];
#pragma unroll
        for (int vt = 0; vt < 8; ++vt) hsum[vt] = (f32x4){0.f, 0.f, 0.f, 0.f};
#pragma unroll 1
        for (int d = 0; d < 2; ++d) {
            const int j = d ? 129 - oc : oc + 2, slot = ((b * 4 + h) * 2 + d) * 130 + j;
            if (d == 1) __syncthreads();
            ml_load_tile2(Ct, CL + (size_t)slot * 16384, 128, nullptr, tid);
            if (tid < 128) { const float* vp = VEC + (size_t)slot * 512; vz[tid] = vp[tid]; vb[tid] = vp[128 + tid]; vcm[tid] = vp[256 + tid]; vn[tid] = NL[(size_t)slot * 128 + tid]; }
            const float mprev = VEC[(size_t)slot * 512 + 386];
            __syncthreads();
            const float ut = -fmaxf(mprev, vcm[t]), winter = __expf(mprev + ut), flo = __expf(ut - vb[t]);
            float nq = 0.f;
#pragma unroll
            for (int ks = 0; ks < 4; ++ks) { const u32x4 qw = __builtin_bit_cast(u32x4, qf[ks]); const f32x4 n0 = *(const LAS f32x4*)(vn + 32 * ks + 8 * g), n1 = *(const LAS f32x4*)(vn + 32 * ks + 8 * g + 4);
                nq += bflo(qw[0]) * n0[0] + bfhi(qw[0]) * n0[1] + bflo(qw[1]) * n0[2] + bfhi(qw[1]) * n0[3] + bflo(qw[2]) * n1[0] + bfhi(qw[2]) * n1[1] + bflo(qw[3]) * n1[2] + bfhi(qw[3]) * n1[3]; }
            nq += __shfl_xor(nq, 16); nq += __shfl_xor(nq, 32);
            f32x4 hacc[8];
#pragma unroll
            for (int vt = 0; vt < 8; ++vt) { f32x4 acc = {0.f, 0.f, 0.f, 0.f};
#pragma unroll
                for (int ks = 0; ks < 4; ++ks) acc = mfma16(*(const LAS bf16x8*)(Ct + (16 * vt + c) * TPI + (32 * ks + 8 * g) * 2), qf[ks], acc);
                hacc[vt] = acc * winter; }
            float rs = 0.f;
            bf16x8 pf[4];
#pragma unroll
            for (int kp = 0; kp < 4; ++kp) {
                f32x4 sa[2];
#pragma unroll
                for (int hh = 0; hh < 2; ++hh) { const int st = 2 * kp + hh; const bool active = d ? (st >= w) : (st <= w);
                    f32x4 acc = {0.f, 0.f, 0.f, 0.f};
                    if (active) {
#pragma unroll
                        for (int ks = 0; ks < 4; ++ks) acc = mfma16(*(const LAS bf16x8*)(Kt + (16 * st + c) * TPI + (32 * ks + 8 * g) * 2), qf[ks], acc);
                        const f32x4 zz = *(const LAS f32x4*)(vz + 16 * st + 4 * g);
#pragma unroll
                        for (int jj = 0; jj < 4; ++jj) { const int s = 16 * st + 4 * g + jj; const bool ok = d ? (s >= t) : (s <= t);
                            const float wgt = ok ? __expf(ut + zz[jj]) : 0.f; acc[jj] *= wgt; rs += acc[jj]; }
                    }
                    sa[hh] = acc; }
                pf[kp] = pk8(sa[0], sa[1]);
            }
            rs += __shfl_xor(rs, 16); rs += __shfl_xor(rs, 32);
#pragma unroll
            for (int kp = 0; kp < 4; ++kp) { const bool active = d ? (2 * kp + 1 >= w) : (2 * kp <= w);
                if (active) { LAS unsigned char* vbp = Vt + (32 * kp + 4 * g + qq) * TPI + 8 * pp;
#pragma unroll
                    for (int vt = 0; vt < 8; ++vt) { const s16x4 lo = ds_tr(vbp + vt * 32), hi = ds_tr(vbp + 16 * TPI + vt * 32); hacc[vt] = mfma16(cat8(lo, hi), pf[kp], hacc[vt]); } } }
            const float den = winter * nq + rs, dd = 1.0f / fmaxf(fabsf(den), flo);
#pragma unroll
            for (int vt = 0; vt < 8; ++vt) hsum[vt] += hacc[vt] * dd;
        }
        float ss = 0.f;
#pragma unroll
        for (int vt = 0; vt < 8; ++vt) ss += hsum[vt][0] * hsum[vt][0] + hsum[vt][1] * hsum[vt][1] + hsum[vt][2] * hsum[vt][2] + hsum[vt][3] * hsum[vt][3];
        ss += __shfl_xor(ss, 16); ss += __shfl_xor(ss, 32);
        const float rstd = rsqrtf(ss * (1.0f / 128.0f) + 1e-6f);
        const int row = row0 + t;
        u32x2 owv[8]; f32x4 hgv[8];
#pragma unroll
        for (int vt = 0; vt < 8; ++vt) { const int v0 = 16 * vt + 4 * g; owv[vt] = *(const u32x2*)(OB + (size_t)row * 512 + h * 128 + v0); hgv[vt] = *(const f32x4*)(p.ml_head_g + h * 128 + v0); }
#pragma unroll
        for (int vt = 0; vt < 8; ++vt) { const int v0 = 16 * vt + 4 * g;
            const u32x2 ow = owv[vt]; const f32x4 hg = hgv[vt];
            const float y0 = hsum[vt][0] * rstd * hg[0] * sigmoid_f(bflo(ow.x)), y1 = hsum[vt][1] * rstd * hg[1] * sigmoid_f(bfhi(ow.x));
            const float y2 = hsum[vt][2] * rstd * hg[2] * sigmoid_f(bflo(ow.y)), y3 = hsum[vt][3] * rstd * hg[3] * sigmoid_f(bfhi(ow.y));
            u32x2 wv; wv.x = cvt_pk_bf16(y0, y1); wv.y = cvt_pk_bf16(y2, y3); *(u32x2*)(Y + (size_t)row * 1024 + 512 + h * 128 + v0) = wv; }
    }
}

__device__ void ph_sg(const P& p, LAS unsigned char* lds) {
    bf16_t* U = (bf16_t*)(p.ws + WS_R); const bf16_t* V = U + (size_t)T * 2048; const float* ST = (const float*)(p.ws + WS_ST);
    constexpr int VP = 560;
    LAS unsigned char* Vn = lds; LAS unsigned char* Wt = lds + 128 * VP;
    const int tid = TIDX, lane = tid & 63, w = __builtin_amdgcn_readfirstlane(tid >> 6), c = lane & 15, g = lane >> 4, qq = (lane & 15) >> 2, pp = lane & 3;
    const int c8 = tid & 31, rb = tid >> 5;
    int last_gg = -1;
    f32x4 g0, g1, b0, b1; bf16x8 bw[4]; float bs = 0.f;
    u32x4 vr[8]; f32x2 st[8];
#define SG_PREFETCH(uu) { const int gg_ = (uu) & 7, row0_ = ((uu) >> 3) * 128; \
        _Pragma("unroll") for (int k = 0; k < 8; ++k) { const int r = rb + 16 * k; vr[k] = *(const u32x4*)(V + (size_t)(row0_ + r) * 2048 + gg_ * 256 + c8 * 8); st[k] = *(const f32x2*)(ST + 2 * (row0_ + r)); } }
    int u = blockIdx.x;
    if (u < 2048) SG_PREFETCH(u)
    while (u < 2048) {
        const int gg = u & 7, ch = u >> 3, row0 = ch * 128;
        if (gg != last_gg) { const int cbase = gg * 256 + c8 * 8;
            g0 = *(const f32x4*)(p.sg_ln_g + cbase); g1 = *(const f32x4*)(p.sg_ln_g + cbase + 4); b0 = *(const f32x4*)(p.sg_ln_b + cbase); b1 = *(const f32x4*)(p.sg_ln_b + cbase + 4); }
        __syncthreads();
#pragma unroll
        for (int k = 0; k < 8; ++k) { const int r = rb + 16 * k; const u32x4 wv = vr[k]; const float mu = st[k][0] * (1.0f / 2048.0f), rs = rsqrtf(fmaxf(st[k][1] * (1.0f / 2048.0f) - mu * mu, 0.f) + 1e-6f);
            u32x4 o;
            o[0] = cvt_pk_bf16((bflo(wv[0]) - mu) * rs * g0[0] + b0[0], (bfhi(wv[0]) - mu) * rs * g0[1] + b0[1]);
            o[1] = cvt_pk_bf16((bflo(wv[1]) - mu) * rs * g0[2] + b0[2], (bfhi(wv[1]) - mu) * rs * g0[3] + b0[3]);
            o[2] = cvt_pk_bf16((bflo(wv[2]) - mu) * rs * g1[0] + b1[0], (bfhi(wv[2]) - mu) * rs * g1[1] + b1[1]);
            o[3] = cvt_pk_bf16((bflo(wv[3]) - mu) * rs * g1[2] + b1[2], (bfhi(wv[3]) - mu) * rs * g1[3] + b1[3]);
            *(LAS u32x4*)(Vn + r * VP + c8 * 16) = o; }
        if (gg != last_gg) {
            for (int i = tid; i < 128 * 32; i += NTHR) { const int r = i >> 5, c4 = i & 31; const f32x4 wv = *(const f32x4*)(p.sg_w_s + (size_t)gg * 16384 + r * 128 + c4 * 4);
                u32x2 o; o.x = cvt_pk_bf16(wv[0], wv[1]); o.y = cvt_pk_bf16(wv[2], wv[3]); *(LAS u32x2*)(Wt + r * TPI + c4 * 8) = o; } }
        __syncthreads();
        const int tt = 16 * w + c;
        if (gg != last_gg) {
#pragma unroll
            for (int ks = 0; ks < 4; ++ks) bw[ks] = *(const LAS bf16x8*)(Wt + (16 * w + c) * TPI + (32 * ks + 8 * g) * 2);
            bs = p.sg_b_s[gg * 128 + tt]; last_gg = gg; }
        bf16_t* up = U + (size_t)(row0 + tt) * 2048 + gg * 256 + 8 * g;
        u32x4 uw[8];
#pragma unroll
        for (int q = 0; q < 8; ++q) uw[q] = *(const u32x4*)(up + 32 * q);
        const int un = u + gridDim.x;
        if (un < 2048) SG_PREFETCH(un)
#pragma unroll
        for (int q = 0; q < 8; ++q) { u32x4 o;
#pragma unroll
            for (int hd = 0; hd < 2; ++hd) { f32x4 acc = {0.f, 0.f, 0.f, 0.f};
#pragma unroll
                for (int ks = 0; ks < 4; ++ks) { LAS unsigned char* a = Vn + (32 * ks + 8 * g + qq) * VP + (32 * q + 8 * pp + 4 * hd) * 2; acc = mfma16(cat8(ds_tr(a), ds_tr(a + 4 * VP)), bw[ks], acc); }
                o[2 * hd] = cvt_pk_bf16(bflo(uw[q][2 * hd]) * (acc[0] + bs), bfhi(uw[q][2 * hd]) * (acc[1] + bs));
                o[2 * hd + 1] = cvt_pk_bf16(bflo(uw[q][2 * hd + 1]) * (acc[2] + bs), bfhi(uw[q][2 * hd + 1]) * (acc[3] + bs)); }
            *(u32x4*)(up + 32 * q) = o; }
        u = un;
    }
#undef SG_PREFETCH
}

#define XB_TMO      128
#define XB_XCNT(j)  (256  + 64 * (j))
#define XB_XSUB(j)  (1280 + 64 * (j))
#define XB_XGEN(j)  (2304 + 64 * (j))
#define XB_TOP      3328
#define XB_TOPGEN   3392
#define XCD_BAR_WORDS 3456
#define XB_SPIN_CAP (1u << 18)

__device__ __forceinline__ unsigned xb_ld(unsigned* p)              { return __hip_atomic_load(p, __ATOMIC_RELAXED, __HIP_MEMORY_SCOPE_AGENT); }
__device__ __forceinline__ unsigned xb_add(unsigned* p, unsigned v) { return __hip_atomic_fetch_add(p, v, __ATOMIC_RELAXED, __HIP_MEMORY_SCOPE_AGENT); }
__device__ __forceinline__ unsigned xb_xcc_id() { return (unsigned)__builtin_amdgcn_s_getreg((3 << 11) | 20) & 0xFu; }
#define XB_SPIN(cond, bar) do { unsigned _sp = 0; while (cond) { __builtin_amdgcn_s_sleep(1); \
    if ((++_sp & 255u) == 0u) { if (xb_ld(&(bar)[XB_TMO])) break; if (_sp > XB_SPIN_CAP) { atomicAdd(&(bar)[XB_TMO], 1u); break; } } } } while (0)

struct XcdBarrier {
    unsigned* bar; unsigned x;
    volatile LAS unsigned* st;
};

__device__ __forceinline__ XcdBarrier xcd_barrier_post(unsigned* bar, volatile LAS unsigned* st) {
    XcdBarrier b; b.bar = bar; b.x = xb_xcc_id(); b.st = st;
    if (threadIdx.x == 0) (void)xb_add(&bar[XB_XCNT(b.x)], 1u);
    return b;
}
__device__ __forceinline__ void xcd_barrier_complete(unsigned* bar, unsigned x, unsigned& nloc, unsigned& nx) {
    const unsigned G = gridDim.x * gridDim.y * gridDim.z;
    unsigned sum, cnt, mine, sp = 0u;
    for (;;) {
        sum = 0u; cnt = 0u; mine = 0u;
#pragma unroll
        for (unsigned j = 0; j < 16; ++j) { const unsigned c = xb_ld(&bar[XB_XCNT(j)]); sum += c; cnt += (c > 0u) ? 1u : 0u; mine = (j == x) ? c : mine; }
        if (sum == G) break;
        __builtin_amdgcn_s_sleep(1);
        if ((++sp & 255u) == 0u) { if (xb_ld(&bar[XB_TMO])) break; if (sp > XB_SPIN_CAP) { atomicAdd(&bar[XB_TMO], 1u); break; } }
    }
    nloc = mine > 0u ? mine : 1u; nx = cnt > 0u ? cnt : 1u;
}

__device__ __forceinline__ void xcd_barrier(const XcdBarrier& b) {
    asm volatile("s_waitcnt vmcnt(0)" ::: "memory");
    __syncthreads();
    if (threadIdx.x == 0) {
        unsigned* bar = b.bar;
        __builtin_amdgcn_s_waitcnt(0);
        unsigned nloc = b.st[0], nx = b.st[1];
        if (nloc == 0u) { xcd_barrier_complete(bar, b.x, nloc, nx); b.st[0] = nloc; b.st[1] = nx; }
        const unsigned old = xb_add(&bar[XB_XSUB(b.x)], 1u);
        const unsigned gen = old / nloc;
        if (old + 1u == (gen + 1u) * nloc) {
            __builtin_amdgcn_fence(__ATOMIC_RELEASE, "agent");
            asm volatile("s_waitcnt vmcnt(0)" ::: "memory");
            const unsigned og = xb_add(&bar[XB_TOP], 1u);
            const unsigned tg = og / nx;
            if (og + 1u == (tg + 1u) * nx) xb_add(&bar[XB_TOPGEN], 1u);
            else XB_SPIN(xb_ld(&bar[XB_TOPGEN]) == tg, bar);
            __builtin_amdgcn_fence(__ATOMIC_ACQUIRE, "agent");
            xb_add(&bar[XB_XGEN(b.x)], 1u);
            asm volatile("s_waitcnt vmcnt(0)" ::: "memory");
        } else {
            XB_SPIN(xb_ld(&bar[XB_XGEN(b.x)]) == gen, bar);
            __builtin_amdgcn_fence(__ATOMIC_ACQUIRE, "agent");
            asm volatile("s_waitcnt vmcnt(0)" ::: "memory");
        }
    }
    __syncthreads();
}


constexpr int NPHASE = 25;
constexpr int CONV_L1_EARLY = 1144;
#ifndef PH_EN
#define PH_EN 0xFFFFFFFFu
#endif
#define EN(k) (((PH_EN) >> (k)) & 1u)
__device__ __forceinline__ void run_phase(const P& p, int ph_in, bool second, LAS unsigned char* lds) {
    const int G = gridDim.x, c = blockIdx.x;
    const bool ctx_units = (ph_in == 4) && !second && (c < 8);
    const int ph = ctx_units ? 3 : ph_in;
    unsigned char* ws = p.ws;
    const float* mod = (const float*)(ws + WS_MOD);
    bf16_t* Wb = (bf16_t*)(ws + WS_W); bf16_t* R = (bf16_t*)(ws + WS_R); bf16_t* H = (bf16_t*)(ws + WS_H); float* XC = (float*)(ws + WS_XC);
    pg8::StaticOrder S;
    if (!((PH_EN >> ph_in) & 1u)) return;
    switch (ph) {
    case 0: if (EN(0)) { ph_prep(p, lds); ph_convert(p, lds, 0, c, G, 0, 2720); ph_convert(p, lds, 1, c, G, 0, CONV_L1_EARLY); } break;
    case 1: case 4: case 10: case 13: case 16: case 21: if (EN(1)) {
        const int l = ph >= 13, sub = (ph == 1 || ph == 13) ? 0 : ((ph == 4 || ph == 16) ? 1 : 2);
        const float* xl = (ph == 1) ? p.x : p.out; const float* xc = (ph == 1) ? p.ctx : XC;
        if (ph == 1) ph_norm(p, xl, xc, 0, TP, 0, G, p.norm_g + (l * 3 + sub) * 1024, mod + (size_t)l * 3 * 9216, sub, H);
        else if (ph == 4 && !second) { ph_norm(p, xl, xc, 0, T, 8, G - 8, p.norm_g + (l * 3 + sub) * 1024, mod + (size_t)l * 3 * 9216, sub, H);
            ph_convert(p, lds, 1, c - 8, G - 8, CONV_L1_EARLY, 2880); }
        else if (ph == 4) ph_norm(p, xl, xc, T, TP, 0, G, p.norm_g + (l * 3 + sub) * 1024, mod + (size_t)l * 3 * 9216, sub, H);
        else ph_norm(p, xl, xc, 0, T, 0, G, p.norm_g + (l * 3 + sub) * 1024, mod + (size_t)l * 3 * 9216, sub, H); } break;
    case 2: case 11: case 14: case 22: if (EN(2)) {
        const int l = ph >= 13, s = (ph == 11 || ph == 22), M = (ph == 2) ? TP : T;
        pg8::Gemm g{H, Wb + W_FFN_IN + (size_t)(l * 2 + s) * 5632 * 1024, M, 5632, 1024, 0, 0}; S.init(M, 5632, G, c); EpiSwiglu E{R}; pg8::gemm_phase(lds, g, S, E); } break;
    case 3: case 12: case 15: case 23: case 9: case 20: if (EN(3)) {
        const int l = ph >= 13; pg8::Gemm g; float coef; int sub;
        if (ph == 9) { g = pg8::Gemm{H, Wb + W_MIXOUT, T, 1024, 1024, 0, 0}; coef = 1.0f; sub = 1; }
        else if (ph == 20) { g = pg8::Gemm{R, Wb + W_SGOUT, T, 1024, 2048, 0, 0}; coef = 1.0f; sub = 1; }
        else { const int s = (ph == 12 || ph == 23); g = pg8::Gemm{R, Wb + W_FFN_OUT + (size_t)(l * 2 + s) * 1024 * 2816, ctx_units ? TP : T, 1024, 2816, 1, 1}; coef = 0.5f; sub = s ? 2 : 0; }
        S.init(g.M, 1024, G, c);
        if (ctx_units) { S.fpm = T / 256 + (c >> 2); S.fpn = c & 3; }
        S.rev = REV_PANELS;
        EpiResid E{(ph == 3) ? p.x : p.out, (ph == 3) ? p.ctx : XC, p.out, XC, mod + (size_t)l * 3 * 9216 + (sub * 3 + 2) * 1024, coef}; pg8::gemm_phase(lds, g, S, E); } break;
    case 5: if (EN(5)) { pg8::Gemm g{H, Wb + W_MIXIN, TP, 3840, 1024, 0, 0}; S.init(TP, 3840, G, c);
        EpiProj E{R, (float*)(R + (size_t)7 * TP * 512), (const float2*)(ws + WS_ROPE), p.ml_gate_b}; pg8::gemm_phase(lds, g, S, E); } break;
    case 6:
#if NAIVE_NA
        if (EN(6)) ph_na_naive(p);
#else
        if (EN(6)) ph_na2(p, lds);
#endif
        __syncthreads();
#if NAIVE_MLA
        if (EN(26)) ph_mlA_naive(p, lds);
#else
        if (EN(26)) ph_mlA(p, lds);
#endif
        break;
    case 7: if (EN(7)) ph_mlB(p, lds); break;
    case 8:
#if NAIVE_MLC
        if (EN(8)) ph_mlC_naive(p, lds);
#else
        if (EN(8)) ph_mlC(p, lds);
#endif
        break;
    case 17: if (EN(17)) { pg8::Gemm g{H, Wb + W_SGIN, T, 4096, 1024, 0, 0}; S.init(T, 4096, G, c); EpiGeluUV E{R, (float*)(ws + WS_ST)}; pg8::gemm_phase(lds, g, S, E); } break;
    case 18: if (EN(18)) ph_sg_stats(p); break;
    case 19:
#if NAIVE_SG
        if (EN(19)) ph_sg_naive(p, lds);
#else
        if (EN(19)) ph_sg(p, lds);
#endif
        break;
    case 24: if (EN(24)) ph_final_norm(p); break;
    }
}

__global__ void __launch_bounds__(NTHR, 2) fwd_kernel(P p) {
    extern __shared__ __attribute__((aligned(16))) unsigned char lds_raw[];
    LAS unsigned char* lds = (LAS unsigned char*)lds_raw;
#if MULTI_LAUNCH
    run_phase(p, p.ph_lo, false, lds);
#else
    cg::grid_group grid = cg::this_grid();
    volatile LAS unsigned* bar_st = (volatile LAS unsigned*)(lds + (LDS_BYTES - 16));
    if (threadIdx.x < 4) bar_st[threadIdx.x] = 0u;
    __syncthreads();
    (void)xcd_barrier_post((unsigned*)(p.ws + WS_BAR), bar_st);
    for (int it = 2 * p.ph_lo; it < 2 * p.ph_hi; ++it) {
        const int ph = it >> 1;
        if (ph == 18) continue;
        if ((it & 1) && ph != 4 && !((DBL_MASK >> ph) & 1u)) continue;
        if (it > 2 * p.ph_lo) {
            if (it == 2 * p.ph_lo + 2) grid.sync();
            else { XcdBarrier xb; xb.bar = (unsigned*)(p.ws + WS_BAR); xb.x = xb_xcc_id(); xb.st = bar_st; xcd_barrier(xb); }
        }
        run_phase(p, ph, (it & 1) != 0, lds);
    }
#endif
}

extern "C" void kernel_launch(void* const* d_in, const int* in_sizes, int n_in, void* d_out, int out_size, void* d_ws, size_t ws_size, hipStream_t stream) {
    static int grid = 0;
    if (grid == 0) {
        if (ws_size < WS_END) { fprintf(stderr, "kernel_launch: workspace too small: %zu < %zu\n", ws_size, (size_t)WS_END); grid = -1; return; }
        int dev = 0, cus = 0, per_cu = 0;
        (void)hipGetDevice(&dev); (void)hipDeviceGetAttribute(&cus, hipDeviceAttributeMultiprocessorCount, dev);
        if (hipFuncSetAttribute((const void*)fwd_kernel, hipFuncAttributeMaxDynamicSharedMemorySize, LDS_BYTES) != hipSuccess) { fprintf(stderr, "kernel_launch: hipFuncSetAttribute failed\n"); grid = -1; return; }
        if (hipOccupancyMaxActiveBlocksPerMultiprocessor(&per_cu, (const void*)fwd_kernel, NTHR, LDS_BYTES) != hipSuccess || per_cu < 1) { fprintf(stderr, "kernel_launch: occupancy query gave %d\n", per_cu); per_cu = 1; }
        (void)hipGetLastError();
        grid = cus * 1;
    }
    if (grid < 0) return;
    (void)hipMemsetAsync((char*)d_ws + WS_MOD, 0, WS_ZERO_END, stream);
    P p{};
    const float** pp = (const float**)&p;
    for (int i = 0; i < 21; ++i) pp[i] = (const float*)d_in[i];
    p.out = (float*)d_out; p.ws = (unsigned char*)d_ws;
#if MULTI_LAUNCH
    for (int ph = 0; ph < NPHASE; ++ph) { p.ph_lo = ph; p.ph_hi = ph + 1; hipLaunchKernelGGL(fwd_kernel, dim3(grid), dim3(NTHR), LDS_BYTES, stream, p); }
#else
    p.ph_lo = 0; p.ph_hi = NPHASE;
    void* args[] = {&p};
    hipError_t e = hipLaunchCooperativeKernel((const void*)fwd_kernel, dim3(grid), dim3(NTHR), args, LDS_BYTES, stream);
    if (e != hipSuccess) fprintf(stderr, "cooperative launch failed: %s (grid %d)\n", hipGetErrorString(e), grid);
#endif
}
```

```cpp
#include <hip/hip_runtime.h>
#include <hip/hip_cooperative_groups.h>
#include <cstdio>
namespace cg = cooperative_groups;

#ifndef NAIVE_NA
#define NAIVE_NA 0
#endif
#ifndef NAIVE_MLA
#define NAIVE_MLA 0
#endif
#ifndef NAIVE_MLC
#define NAIVE_MLC 0
#endif
#ifndef NAIVE_SG
#define NAIVE_SG 0
#endif
#ifndef DBL_MASK
#define DBL_MASK 0u
#endif
#ifndef REV_PANELS
#define REV_PANELS 1
#endif
#ifndef MULTI_LAUNCH
#define MULTI_LAUNCH 0
#endif

#define LAS __attribute__((address_space(3)))
typedef unsigned short bf16_t;
typedef short bf16x8 __attribute__((ext_vector_type(8)));
typedef float f32x4 __attribute__((ext_vector_type(4)));
typedef float f32x2 __attribute__((ext_vector_type(2)));
typedef unsigned u32x4 __attribute__((ext_vector_type(4)));
typedef unsigned u32x2 __attribute__((ext_vector_type(2)));

constexpr int T = 32768, TC = 512, TP = T + TC, D = 1024, DFF = 2816, NSEQ = 16384;
constexpr int NTHR = 512;
constexpr int LDS_BYTES = 147456;
constexpr int NSLOT = 2 * 4 * 2 * 130;
constexpr int PITCH = 272;

constexpr size_t WS_MOD = 0;
constexpr size_t WS_BAR = 229376;
constexpr size_t WS_ST = 243712;
constexpr size_t WS_ZERO_END = WS_ST + (size_t)T * 8;
constexpr size_t WS_ROPE = WS_ZERO_END + 256;
constexpr size_t WS_W = WS_ROPE + 65536;
constexpr size_t W_FFN_IN = 0, W_FFN_OUT = W_FFN_IN + 4ull * 5632 * 1024, W_MIXIN = W_FFN_OUT + 4ull * 1024 * 2816,
                 W_MIXOUT = W_MIXIN + 3840ull * 1024, W_SGIN = W_MIXOUT + 1024ull * 1024, W_SGOUT = W_SGIN + 4096ull * 1024,
                 W_END = W_SGOUT + 1024ull * 2048;
constexpr size_t WS_R = WS_W + W_END * 2;
constexpr size_t WS_H = WS_R + 268435456ull;
constexpr size_t WS_CL = WS_H + (size_t)TP * 1024 * 2;
constexpr size_t WS_XC = WS_CL + (size_t)NSLOT * 32768;
constexpr size_t WS_VEC = WS_XC + (size_t)TC * 1024 * 4;
constexpr size_t WS_NL = WS_VEC + (size_t)NSLOT * 2048;
constexpr size_t WS_END = WS_NL + (size_t)NSLOT * 512;

struct P {
    const float *x, *c, *ctx, *c_ctx, *w_mod, *b_mod, *norm_g, *ffn_w_in, *ffn_w_out, *mix_w_in, *na_rpb, *ml_gate_b, *ml_head_g,
        *mix_w_out, *sg_w_in, *sg_ln_g, *sg_ln_b, *sg_w_s, *sg_b_s, *sg_w_out, *final_g;
    float* out; unsigned char* ws; int ph_lo, ph_hi;
};

__device__ __forceinline__ int opaque_tid() { int t = threadIdx.x; asm volatile("" : "+v"(t)); return t; }
#define TIDX (opaque_tid())
__device__ __forceinline__ float bf2f(bf16_t v) { return __uint_as_float(((unsigned)v) << 16); }
__device__ __forceinline__ float bflo(unsigned u) { return __uint_as_float(u << 16); }
__device__ __forceinline__ float bfhi(unsigned u) { return __uint_as_float(u & 0xffff0000u); }
typedef __bf16 bf16v2_t __attribute__((ext_vector_type(2)));
__device__ __forceinline__ unsigned cvt_pk_bf16(float lo, float hi) { const f32x2 v = {lo, hi}; return __builtin_bit_cast(unsigned, __builtin_convertvector(v, bf16v2_t)); }
__device__ __forceinline__ bf16_t f2bf(float f) { return (bf16_t)(cvt_pk_bf16(f, 0.f) & 0xffffu); }
__device__ __forceinline__ float fexp(float v) { return __builtin_amdgcn_exp2f(v * 1.4426950408889634f); }
__device__ __forceinline__ float silu_f(float v) { return v * __builtin_amdgcn_rcpf(1.0f + fexp(-v)); }
__device__ __forceinline__ float sigmoid_f(float v) { return __builtin_amdgcn_rcpf(1.0f + fexp(-v)); }
__device__ __forceinline__ float gelu_tanh(float v) { const float u = 0.7978845608028654f * (v + 0.044715f * v * v * v); const float e = fexp(2.0f * u); return v * (1.0f - __builtin_amdgcn_rcpf(e + 1.0f)); }
__device__ __forceinline__ float log_sigmoid_f(float v) { return fminf(v, 0.f) - log1pf(__expf(-fabsf(v))); }

namespace pg8 {
constexpr int BM = 256, BK = 64, HALF = 128, HTB = HALF * BK * 2, STAGE_BYTES = 8 * HTB, NXCD = 8, WGM = 8;
__device__ __forceinline__ int lds_byte(int r, int c) { const int st = (r >> 4) * 2 + (c >> 5), rr = r & 15, cc = c & 31, ob = rr * 64 + cc * 2; return st * 1024 + (ob ^ (((ob >> 9) & 1) << 5)); }
__device__ __forceinline__ void stage_rc(int b, int& R, int& C) { const int st = b / 1024, sb = b % 1024, swz = sb ^ (((sb >> 9) & 1) << 5); R = (st >> 1) * 16 + swz / 64; C = (st & 1) * 32 + (swz % 64) / 2; }
struct Unit { int pm, pn; };
struct Gemm { const bf16_t* A; const bf16_t* Bt; int M, N, K; int tiledA, tiledB; };
struct StaticOrder {
    int nM, nN, nwg, G, c, fpm, fpn, rev;
    __device__ void init(int M, int N, int G_, int c_) { nM = M / BM; nN = N / BM; nwg = nM * nN; G = G_; c = c_; fpm = -1; fpn = 0; rev = 0; }
    __device__ bool next(int i, Unit& u) const {
        if (fpm >= 0) { if (i > 0) return false; u.pm = fpm; u.pn = fpn; return true; }
        const long L = (long)i * G + c; if (L >= nwg) return false;
        int wgid = (int)L; { const int q = nwg / NXCD, r = nwg % NXCD, xcd = wgid % NXCD, off = wgid / NXCD; wgid = (xcd < r ? xcd * (q + 1) : r * (q + 1) + (xcd - r) * q) + off; }
        const int nig = WGM * nN, gid = wgid / nig, fm = gid * WGM, gsz = (nM - fm) < WGM ? (nM - fm) : WGM;
        u.pm = fm + ((wgid % nig) % gsz); u.pn = (wgid % nig) / gsz; if (rev) u.pm = nM - 1 - u.pm; return true;
    }
};

#ifndef PG8_SP2
#define PG8_SP2 true
#endif
#ifndef PG8_ALIGN
#define PG8_ALIGN true
#endif
template <class Epi, bool ALIGN_EPI = PG8_ALIGN, bool SP2 = PG8_SP2>
__device__ __forceinline__ void gemm_phase(LAS unsigned char* lds, const Gemm g, const StaticOrder& S, const Epi& E) {
    const int tid = TIDX, wid = __builtin_amdgcn_readfirstlane(tid >> 6), lane = tid & 63, wr = wid >> 2, wc = wid & 3, fr = lane & 15, fq = lane >> 4;
    const int K = g.K, nt = K / BK;
    unsigned voffA[2], voffB[2];
#pragma unroll
    for (int i = 0; i < 2; ++i) { int R, C; stage_rc(tid * 16 + i * 8192, R, C); voffA[i] = (unsigned)(R * (g.tiledA ? BK : K) + C) * 2u; voffB[i] = (unsigned)(R * (g.tiledB ? BK : K) + C) * 2u; }
    const size_t kstepA = g.tiledA ? (size_t)(2 * HTB) : (size_t)(BK * 2), kstepB = g.tiledB ? (size_t)(2 * HTB) : (size_t)(BK * 2);
    const size_t hstepA = g.tiledA ? (size_t)HTB : (size_t)HALF * K * 2, hstepB = g.tiledB ? (size_t)HTB : (size_t)HALF * K * 2;
    const size_t tstepA = (size_t)BM * K * 2, tstepB = (size_t)BM * K * 2;
    const unsigned ldsw = (unsigned)wid * 1024u;
    const int aoff = lds_byte(wr * 64 + fr, fq * 8), boff = lds_byte(wc * 32 + fr, fq * 8);
#define PG8_SA(b, h) (((b) * 2 + (h)) * HTB)
#define PG8_SB(b, h) ((4 + (b) * 2 + (h)) * HTB)
#define PG8_STAGE(bufoff, gbase, voff) do { _Pragma("unroll") for (int _i = 0; _i < 2; ++_i) \
        __builtin_amdgcn_global_load_lds((const unsigned*)((const char*)(gbase) + (voff)[_i]), (LAS unsigned*)(lds + (bufoff) + ldsw + _i * 8192), 16, 0, 0); } while (0)
#define PG8_LDA(dst, b, h) do { _Pragma("unroll") for (int m = 0; m < 4; ++m) _Pragma("unroll") for (int k = 0; k < 2; ++k) dst[m][k] = *(const LAS bf16x8*)(lds + PG8_SA(b, h) + aoff + m * 2048 + k * 1024); } while (0)
#define PG8_LDB(dst, b, h) do { _Pragma("unroll") for (int n = 0; n < 2; ++n) _Pragma("unroll") for (int k = 0; k < 2; ++k) dst[n][k] = *(const LAS bf16x8*)(lds + PG8_SB(b, h) + boff + n * 2048 + k * 1024); } while (0)
#define PG8_MMA(ai, bj, At, Bt) do { __builtin_amdgcn_s_setprio(1); _Pragma("unroll") for (int m = 0; m < 4; ++m) _Pragma("unroll") for (int n = 0; n < 2; ++n) _Pragma("unroll") for (int k = 0; k < 2; ++k) \
        acc[ai][bj][m][n] = __builtin_amdgcn_mfma_f32_16x16x32_bf16(Bt[n][k], At[m][k], acc[ai][bj][m][n], 0, 0, 0); __builtin_amdgcn_s_setprio(0); } while (0)
#define PG8_WAIT_V(n) asm volatile("s_waitcnt vmcnt(" #n ")" ::: "memory")
#define PG8_WAIT_L(n) asm volatile("s_waitcnt lgkmcnt(" #n ")" ::: "memory")
#define PG8_BAR __builtin_amdgcn_s_barrier()
#define PG8_SCHED __builtin_amdgcn_sched_barrier(0)
    Unit cur, nxt; int ui = 0;
    if (!S.next(0, cur)) return;
    f32x4 acc[2][2][4][2];
#pragma unroll
    for (int a = 0; a < 2; ++a)
#pragma unroll
        for (int b = 0; b < 2; ++b)
#pragma unroll
            for (int m = 0; m < 4; ++m)
#pragma unroll
                for (int n = 0; n < 2; ++n) acc[a][b][m][n] = (f32x4){0.f, 0.f, 0.f, 0.f};
    bf16x8 At[4][2], B0[2][2], B1[2][2];
    const char* cA = (const char*)g.A + (size_t)cur.pm * tstepA; const char* cB = (const char*)g.Bt + (size_t)cur.pn * tstepB;
    if constexpr (SP2) {
        PG8_STAGE(PG8_SB(0, 0), cB, voffB); PG8_STAGE(PG8_SB(0, 1), cB + hstepB, voffB); PG8_STAGE(PG8_SA(0, 0), cA, voffA); PG8_STAGE(PG8_SA(0, 1), cA + hstepA, voffA);
        if (wr == 1) PG8_BAR;
        PG8_WAIT_V(2); PG8_BAR;
        PG8_STAGE(PG8_SB(1, 0), cB + kstepB, voffB); PG8_STAGE(PG8_SA(1, 0), cA + kstepA, voffA); PG8_STAGE(PG8_SB(1, 1), cB + hstepB + kstepB, voffB);
        PG8_WAIT_V(6); PG8_BAR;
    } else {
        PG8_STAGE(PG8_SB(0, 0), cB, voffB); PG8_STAGE(PG8_SA(0, 0), cA, voffA); PG8_STAGE(PG8_SB(0, 1), cB + hstepB, voffB); PG8_STAGE(PG8_SA(0, 1), cA + hstepA, voffA);
        if (wr == 1) PG8_BAR;
        PG8_WAIT_V(4); PG8_BAR;
        PG8_STAGE(PG8_SB(1, 0), cB + kstepB, voffB); PG8_STAGE(PG8_SA(1, 0), cA + kstepA, voffA); PG8_STAGE(PG8_SB(1, 1), cB + hstepB + kstepB, voffB);
        PG8_WAIT_V(6); PG8_BAR;
    }
    for (;;) {
        const bool has_next = S.next(ui + 1, nxt);
        const char* nA = has_next ? (const char*)g.A + (size_t)nxt.pm * tstepA : cA; const char* nB = has_next ? (const char*)g.Bt + (size_t)nxt.pn * tstepB : cB;
        for (int t = 0; t < nt; t += 2) {
            const bool last = (t == nt - 2);
            const char* a1 = cA + (size_t)(t + 1) * kstepA;
            const char* a2 = last ? nA : cA + (size_t)(t + 2) * kstepA; const char* b2 = last ? nB : cB + (size_t)(t + 2) * kstepB;
            const char* a3 = a2 + kstepA; const char* b3 = b2 + kstepB;
            if constexpr (SP2) {
            PG8_LDB(B0, 0, 0); PG8_LDB(B1, 0, 1); PG8_SCHED; PG8_LDA(At, 0, 0); PG8_STAGE(PG8_SA(1, 1), a1 + hstepA, voffA);
            PG8_WAIT_V(8); PG8_WAIT_L(0); PG8_BAR; PG8_MMA(0, 0, At, B0); PG8_MMA(0, 1, At, B1); PG8_BAR; PG8_SCHED;
            PG8_LDA(At, 0, 1); PG8_STAGE(PG8_SB(0, 0), b2, voffB); PG8_STAGE(PG8_SB(0, 1), b2 + hstepB, voffB); PG8_STAGE(PG8_SA(0, 0), a2, voffA);
            PG8_WAIT_V(8); PG8_WAIT_L(0); PG8_BAR; PG8_MMA(1, 0, At, B0); PG8_MMA(1, 1, At, B1); PG8_BAR; PG8_SCHED;
            PG8_LDB(B0, 1, 0); PG8_LDB(B1, 1, 1); PG8_SCHED; PG8_LDA(At, 1, 0); PG8_STAGE(PG8_SA(0, 1), a2 + hstepA, voffA);
            PG8_WAIT_V(8); PG8_WAIT_L(0); PG8_BAR; PG8_MMA(0, 0, At, B0); PG8_MMA(0, 1, At, B1); PG8_BAR; PG8_SCHED;
            PG8_LDA(At, 1, 1); PG8_STAGE(PG8_SB(1, 0), b3, voffB); PG8_STAGE(PG8_SB(1, 1), b3 + hstepB, voffB); PG8_STAGE(PG8_SA(1, 0), a3, voffA);
            PG8_WAIT_V(8); PG8_WAIT_L(0); PG8_BAR; PG8_MMA(1, 0, At, B0); PG8_MMA(1, 1, At, B1); PG8_BAR; PG8_SCHED;
            } else {
            PG8_LDB(B0, 0, 0); PG8_SCHED; PG8_LDA(At, 0, 0); PG8_STAGE(PG8_SA(1, 1), a1 + hstepA, voffA);
            PG8_WAIT_L(8); PG8_BAR; PG8_WAIT_L(0); PG8_MMA(0, 0, At, B0); PG8_BAR; PG8_SCHED;
            PG8_LDB(B1, 0, 1); PG8_STAGE(PG8_SB(0, 0), b2, voffB);
            PG8_BAR; PG8_WAIT_L(0); PG8_MMA(0, 1, At, B1); PG8_BAR;
            PG8_LDA(At, 0, 1); PG8_STAGE(PG8_SA(0, 0), a2, voffA);
            PG8_BAR; PG8_WAIT_L(0); PG8_MMA(1, 0, At, B0); PG8_BAR; PG8_SCHED;
            PG8_STAGE(PG8_SB(0, 1), b2 + hstepB, voffB);
            PG8_WAIT_V(6); PG8_BAR; PG8_MMA(1, 1, At, B1); PG8_BAR;
            PG8_LDB(B0, 1, 0); PG8_SCHED; PG8_LDA(At, 1, 0); PG8_STAGE(PG8_SA(0, 1), a2 + hstepA, voffA);
            PG8_WAIT_L(8); PG8_BAR; PG8_WAIT_L(0); PG8_MMA(0, 0, At, B0); PG8_BAR; PG8_SCHED;
            PG8_LDB(B1, 1, 1); PG8_STAGE(PG8_SB(1, 0), b3, voffB);
            PG8_BAR; PG8_WAIT_L(0); PG8_MMA(0, 1, At, B1); PG8_BAR;
            PG8_LDA(At, 1, 1); PG8_STAGE(PG8_SA(1, 0), a3, voffA);
            PG8_BAR; PG8_WAIT_L(0); PG8_MMA(1, 0, At, B0); PG8_BAR; PG8_SCHED;
            PG8_STAGE(PG8_SB(1, 1), b3 + hstepB, voffB);
            PG8_WAIT_V(6); PG8_BAR; PG8_MMA(1, 1, At, B1); PG8_BAR;
            }
        }
        if constexpr (ALIGN_EPI) { if (wr == 0) PG8_BAR; }
        E(acc, cur, wr, wc, fr, fq);
        if (!has_next) break;
#pragma unroll
        for (int a = 0; a < 2; ++a)
#pragma unroll
            for (int b = 0; b < 2; ++b)
#pragma unroll
                for (int m = 0; m < 4; ++m)
#pragma unroll
                    for (int n = 0; n < 2; ++n) acc[a][b][m][n] = (f32x4){0.f, 0.f, 0.f, 0.f};
        cur = nxt; cA = nA; cB = nB; ++ui;
        if constexpr (ALIGN_EPI) { if (wr == 1) PG8_BAR; }
    }
    PG8_WAIT_V(0);
    if constexpr (!ALIGN_EPI) { if (wr == 0) PG8_BAR; }
    PG8_BAR;
#undef PG8_SA
#undef PG8_SB
#undef PG8_STAGE
#undef PG8_LDA
#undef PG8_LDB
#undef PG8_MMA
#undef PG8_WAIT_V
#undef PG8_WAIT_L
#undef PG8_BAR
#undef PG8_SCHED
}
}

struct EpiSwiglu {
    bf16_t* hid;
    __device__ __forceinline__ void operator()(const f32x4 (&acc)[2][2][4][2], const pg8::Unit& u, int wr, int wc, int fr, int fq) const {
        const int row0 = u.pm * 256 + wr * 64 + fr, hc0 = u.pn * 128 + wc * 32 + 8 * fq;
#pragma unroll
        for (int ai = 0; ai < 2; ++ai)
#pragma unroll
            for (int m = 0; m < 4; ++m) { u32x4 w;
#pragma unroll
                for (int n = 0; n < 2; ++n) { const f32x4 a = acc[ai][0][m][n], b = acc[ai][1][m][n];
                    w[2 * n] = cvt_pk_bf16(silu_f(a[0]) * b[0], silu_f(a[1]) * b[1]); w[2 * n + 1] = cvt_pk_bf16(silu_f(a[2]) * b[2], silu_f(a[3]) * b[3]); }
                const int row = row0 + ai * 128 + m * 16;
                *(u32x4*)(hid + ((size_t)((row >> 8) * (DFF / 64) + (hc0 >> 6)) * 2 + ((row >> 7) & 1)) * 8192 + (row & 127) * 64 + (hc0 & 63)) = w; }
    }
};
struct EpiResid {
    const float* xin_lat; const float* xin_ctx; float* xout_lat; float* xout_ctx; const float* gate; float coef;
    __device__ __forceinline__ void operator()(const f32x4 (&acc)[2][2][4][2], const pg8::Unit& u, int wr, int wc, int fr, int fq) const {
        const int row0 = u.pm * 256 + wr * 64 + fr, col0 = u.pn * 256 + wc * 32 + 8 * fq;
        const bool isctx = u.pm >= T / 256; const int mb = isctx ? 2 : (u.pm >> 6);
        const float* xi = isctx ? xin_ctx - (size_t)T * D : xin_lat; float* xo = isctx ? xout_ctx - (size_t)T * D : xout_lat;
        const float* gp = gate + mb * 9216 + col0;
        f32x4 gv[2][2];
#pragma unroll
        for (int bj = 0; bj < 2; ++bj)
#pragma unroll
            for (int n = 0; n < 2; ++n) gv[bj][n] = *(const f32x4*)(gp + bj * 128 + n * 4) * coef;
#pragma unroll
        for (int ai = 0; ai < 2; ++ai) {
            f32x4 xv[4][2][2];
#pragma unroll
            for (int m = 0; m < 4; ++m)
#pragma unroll
                for (int bj = 0; bj < 2; ++bj)
#pragma unroll
                    for (int n = 0; n < 2; ++n) xv[m][bj][n] = *(const f32x4*)(xi + (size_t)(row0 + ai * 128 + m * 16) * D + col0 + bj * 128 + n * 4);
#pragma unroll
            for (int m = 0; m < 4; ++m)
#pragma unroll
                for (int bj = 0; bj < 2; ++bj)
#pragma unroll
                    for (int n = 0; n < 2; ++n) *(f32x4*)(xo + (size_t)(row0 + ai * 128 + m * 16) * D + col0 + bj * 128 + n * 4) = xv[m][bj][n] + gv[bj][n] * acc[ai][bj][m][n];
        }
    }
};
struct EpiProj {
    bf16_t* base; float* G; const float2* rope; const float* gate_b;
    __device__ __forceinline__ void operator()(const f32x4 (&acc)[2][2][4][2], const pg8::Unit& u, int wr, int wc, int fr, int fq) const {
        const int row0 = u.pm * 256 + wr * 64 + fr;
        if (u.pn == 14) {
            if (wc == 0 && fq < 2) {
#pragma unroll
                for (int nn = 0; nn < 2; ++nn) { const int head = 2 * fq + nn; const f32x4 gb = *(const f32x4*)(gate_b + 4 * head);
#pragma unroll
                    for (int ai = 0; ai < 2; ++ai)
#pragma unroll
                        for (int m = 0; m < 4; ++m) { const int row = row0 + ai * 128 + m * 16; f32x4 v = acc[ai][0][m][nn] + gb;
                            v[1] = log_sigmoid_f(v[1]); v[3] = log_sigmoid_f(v[3]);
                            *(f32x4*)(G + (size_t)row * 16 + 4 * head) = v; } }
            }
            return;
        }
        const int kind = u.pn >> 1; bf16_t* dst = base + (size_t)kind * TP * 512;
        const int cc0 = (u.pn & 1) * 256 + wc * 32 + 8 * fq;
        const bool rope_k = (kind == 3 || kind == 4) && (u.pm < T / 256);
        const float sc = (kind == 4) ? 0.08838834764831845f : 1.0f;
#pragma unroll
        for (int ai = 0; ai < 2; ++ai) {
            float2 csA[4][2][2], csB[4][2][2];
            if (rope_k) {
#pragma unroll
                for (int m = 0; m < 4; ++m) { const int row = row0 + ai * 128 + m * 16; const int n = row & (NSEQ - 1), gi = n >> 6, gj = n & 63;
#pragma unroll
                    for (int bj = 0; bj < 2; ++bj)
#pragma unroll
                        for (int nn = 0; nn < 2; ++nn) { const int cc = cc0 + bj * 128 + nn * 4; const int pr = (cc & 127) >> 1; const int pos = (pr < 32) ? gi : gj; const int fi = pr & 31;
                            csA[m][bj][nn] = rope[pos * 32 + fi]; csB[m][bj][nn] = rope[pos * 32 + fi + 1]; } }
            }
#pragma unroll
            for (int m = 0; m < 4; ++m) { const int row = row0 + ai * 128 + m * 16;
#pragma unroll
                for (int bj = 0; bj < 2; ++bj) { u32x4 w;
#pragma unroll
                    for (int nn = 0; nn < 2; ++nn) { f32x4 v = acc[ai][bj][m][nn];
                        if (rope_k) { const float2 cs0 = csA[m][bj][nn], cs1 = csB[m][bj][nn];
                            const float a0 = v[0] * cs0.x - v[1] * cs0.y, a1 = v[0] * cs0.y + v[1] * cs0.x, a2 = v[2] * cs1.x - v[3] * cs1.y, a3 = v[2] * cs1.y + v[3] * cs1.x;
                            v = (f32x4){a0, a1, a2, a3}; }
                        v = v * sc;
                        w[2 * nn] = cvt_pk_bf16(v[0], v[1]); w[2 * nn + 1] = cvt_pk_bf16(v[2], v[3]); }
                    *(u32x4*)(dst + (size_t)row * 512 + cc0 + bj * 128) = w; } }
        }
    }
};
struct EpiGeluUV {
    bf16_t* base; float* st;
    __device__ __forceinline__ void operator()(const f32x4 (&acc)[2][2][4][2], const pg8::Unit& u, int wr, int wc, int fr, int fq) const {
        const int row0 = u.pm * 256 + wr * 64 + fr; bf16_t* dst = base + (size_t)(u.pn >> 3) * T * 2048; const int cc0 = (u.pn & 7) * 256 + wc * 32 + 8 * fq;
        const bool isv = u.pn >= 8;
#define GU_ROW(ai, m) { bf16_t* rowp = dst + (size_t)(row0 + (ai) * 128 + (m) * 16) * 2048 + cc0; float s1 = 0.f, s2 = 0.f; \
            _Pragma("unroll") for (int bj = 0; bj < 2; ++bj) { u32x4 w; \
                _Pragma("unroll") for (int n = 0; n < 2; ++n) { const f32x4 v = acc[ai][bj][m][n]; const float g0 = gelu_tanh(v[0]), g1 = gelu_tanh(v[1]), g2 = gelu_tanh(v[2]), g3 = gelu_tanh(v[3]); \
                    s1 += (g0 + g1) + (g2 + g3); s2 += (g0 * g0 + g1 * g1) + (g2 * g2 + g3 * g3); \
                    w[2 * n] = cvt_pk_bf16(g0, g1); w[2 * n + 1] = cvt_pk_bf16(g2, g3); } \
                *(u32x4*)(rowp + bj * 128) = w; } \
            if (isv) { s1 += __shfl_xor(s1, 16); s1 += __shfl_xor(s1, 32); s2 += __shfl_xor(s2, 16); s2 += __shfl_xor(s2, 32); \
                if (fq == 0) { atomicAdd(st + 2 * (row0 + (ai) * 128 + (m) * 16), s1); atomicAdd(st + 2 * (row0 + (ai) * 128 + (m) * 16) + 1, s2); } } }
        GU_ROW(0, 0) GU_ROW(0, 1) GU_ROW(0, 2) GU_ROW(0, 3) GU_ROW(1, 0) GU_ROW(1, 1) GU_ROW(1, 2) GU_ROW(1, 3)
#undef GU_ROW
    }
};

__device__ void ph_prep(const P& p, LAS unsigned char* lds) {
    const int tid = TIDX, G = gridDim.x, bid = blockIdx.x;
    float* mod = (float*)(p.ws + WS_MOD);
    for (int idx = bid * NTHR + tid; idx < 256 * 32; idx += G * NTHR) {
        const int pos = idx >> 5, fi = idx & 31;
        const float inv = exp2f(-(float)fi * (13.287712379549449f / 32.0f));
        const float ang = (float)pos * inv;
        const double a = (double)ang; const double kq = rint(a * 0.6366197723675814); const double r = a - kq * 1.5707963267948966;
        const float rf = (float)r, r2 = rf * rf; const int q = ((int)kq) & 3;
        const float s = rf + rf * r2 * (-1.6666654611e-1f + r2 * (8.3321608736e-3f + r2 * (-1.9515295891e-4f)));
        const float c = 1.0f - 0.5f * r2 + r2 * r2 * (4.166664568298827e-2f + r2 * (-1.388731625493765e-3f + r2 * 2.443315711809948e-5f));
        float co, si;
        if (q == 0) { co = c; si = s; } else if (q == 1) { co = -s; si = c; } else if (q == 2) { co = -c; si = -s; } else { co = s; si = -c; }
        ((float2*)(p.ws + WS_ROPE))[idx] = make_float2(co, si);
    }
    LAS float* sv = (LAS float*)lds;
    for (int item = bid; item < 288; item += G) {
        const int l = item / 144, rem = item % 144, ks = rem / 9, cgp = rem % 9;
        __syncthreads();
        if (tid < 192) { const int mb = tid >> 6, kk = tid & 63, k = ks * 64 + kk; const float cv = (mb < 2) ? p.c[mb * 1024 + k] : p.c_ctx[k]; sv[mb * 64 + kk] = silu_f(cv); }
        __syncthreads();
        const int half = tid >> 8, cq = tid & 255, col = cgp * 1024 + cq * 4;
        f32x4 a0 = {0, 0, 0, 0}, a1 = a0, a2 = a0;
        const float* wp = p.w_mod + ((size_t)(l * 1024 + ks * 64 + half * 32)) * 9216 + col;
#pragma unroll 16
        for (int kk = 0; kk < 32; ++kk) { const f32x4 w = *(const f32x4*)(wp + (size_t)kk * 9216); const int si = half * 32 + kk;
            a0 += w * sv[si]; a1 += w * sv[64 + si]; a2 += w * sv[128 + si]; }
        if (ks == 0 && half == 0) { const f32x4 bb = *(const f32x4*)(p.b_mod + l * 9216 + col); a0 += bb; a1 += bb; a2 += bb; }
        float* m0 = mod + (size_t)(l * 3) * 9216 + col;
#pragma unroll
        for (int j = 0; j < 4; ++j) { atomicAdd(m0 + j, a0[j]); atomicAdd(m0 + 9216 + j, a1[j]); atomicAdd(m0 + 2 * 9216 + j, a2[j]); }
    }
}

__device__ void ph_convert(const P& p, LAS unsigned char* lds, int layer, int wid, int nwg, int v_lo, int v_hi) {
    const int tid = TIDX;
    __syncthreads();
    LAS bf16_t* tl = (LAS bf16_t*)(lds + 1024);
    bf16_t* Wb = (bf16_t*)(p.ws + WS_W);
    float vv[16]; bf16_t* cdst = nullptr; int cK = 0, ck0 = 0, cr0 = 0;
#define CONV_DECODE(t, src, dst, K, Ns, kind, k0, r0) { int nrt, lt; \
        if (t < 2816) { const int j = t / 704; lt = t % 704; src = p.ffn_w_in + (size_t)j * 1024 * 5632; dst = Wb + W_FFN_IN + (size_t)j * 5632 * 1024; K = 1024; Ns = 5632; nrt = 88; kind = 1; } \
        else if (t < 4224) { const int j = (t - 2816) / 352; lt = (t - 2816) % 352; src = p.ffn_w_out + (size_t)j * 2816 * 1024; dst = Wb + W_FFN_OUT + (size_t)j * 1024 * 2816; K = 2816; Ns = 1024; nrt = 16; kind = 0; } \
        else if (t < 4704) { lt = t - 4224; src = p.mix_w_in; dst = Wb + W_MIXIN; K = 1024; Ns = 3600; nrt = 60; kind = 2; } \
        else if (t < 4832) { lt = t - 4704; src = p.mix_w_out; dst = Wb + W_MIXOUT; K = 1024; Ns = 1024; nrt = 16; kind = 0; } \
        else if (t < 5344) { lt = t - 4832; src = p.sg_w_in; dst = Wb + W_SGIN; K = 1024; Ns = 4096; nrt = 64; kind = 0; } \
        else { lt = t - 5344; src = p.sg_w_out; dst = Wb + W_SGOUT; K = 2048; Ns = 1024; nrt = 16; kind = 0; } \
        k0 = (lt / nrt) * 128; r0 = (lt % nrt) * 64; }
#define CONV_LOAD(t) { const float* src; bf16_t* dst; int K, Ns, kind, k0, r0; CONV_DECODE(t, src, dst, K, Ns, kind, k0, r0) \
        const int rr = r0 + (tid & 63); int sc = rr; \
        if (kind == 1) { const int pn = rr >> 8, cl = rr & 255; sc = 128 * pn + 32 * ((cl >> 5) & 3) + 8 * ((cl >> 2) & 3) + 4 * ((cl >> 4) & 1) + (cl & 3) + (cl >> 7) * DFF; } \
        else { const int rho = rr & 31; sc = (rr & ~31) + 8 * ((rho & 15) >> 2) + 4 * (rho >> 4) + (rho & 3); if (kind == 2 && sc >= 3600) sc = -1; } \
        _Pragma("unroll") for (int it = 0; it < 16; ++it) { const int kk = it * 8 + (tid >> 6); vv[it] = (sc >= 0) ? src[(size_t)(k0 + kk) * Ns + sc] : 0.f; } \
        cdst = dst; cK = K; ck0 = k0; cr0 = r0; }
    const int nv = min(v_hi, layer ? 2880 : 2720);
#define CONV_REMAP(v) (layer ? (((v) < 1408) ? (v) + 1408 : ((v) < 2112) ? (v) - 1408 + 3520 : (v) - 2112 + 4832) : (((v) < 1408) ? (v) : ((v) < 2112) ? (v) - 1408 + 2816 : (v) - 2112 + 4224))
    int v = v_lo + wid;
    if (v < nv) { const int t = CONV_REMAP(v); CONV_LOAD(t) }
    while (v < nv) {
        __syncthreads();
        { const int rl = tid & 63;
#pragma unroll
          for (int it = 0; it < 16; ++it) { const int kk = it * 8 + (tid >> 6); tl[rl * 136 + kk] = f2bf(vv[it]); } }
        bf16_t* odst = cdst; const int oK = cK, ok0 = ck0, or0 = cr0; const bool otile = (oK == 2816);
        __syncthreads();
        v += nwg;
        if (v < nv) { const int t = CONV_REMAP(v); CONV_LOAD(t) }
#pragma unroll
        for (int h2 = 0; h2 < 2; ++h2) { const int idx = tid + h2 * 512, rl = idx >> 4, kc = (idx & 15) * 8; const u32x4 v = *(const LAS u32x4*)(tl + rl * 136 + kc); const int rr = or0 + rl, kk = ok0 + kc;
            const size_t off = otile ? (((size_t)((rr >> 8) * (2816 / 64) + (kk >> 6)) * 2 + ((rr >> 7) & 1)) * 8192 + (rr & 127) * 64 + (kk & 63)) : ((size_t)rr * oK + kk);
            *(u32x4*)(odst + off) = v; }
    }
#undef CONV_LOAD
#undef CONV_REMAP
#undef CONV_DECODE
}

__device__ void ph_norm(const P& p, const float* xlat, const float* xctx, int row_lo, int nrows, int wg0, int nwg, const float* g, const float* modl, int sub, bf16_t* H) {
    const int lane = TIDX & 63, wv = TIDX >> 6;
    if ((int)blockIdx.x < wg0) return;
    const int stride = nwg * 16;
    int row = row_lo + (((int)blockIdx.x - wg0) * 8 + wv) * 2;
    f32x4 v[2][4], nx[2][4], gg[4], s0[4]; int cur_mb = -1;
#define NORM_LOAD(dst, r_) { const bool ic_ = (r_) >= T; const float* xr_ = ic_ ? xctx + (size_t)((r_) - T) * D : xlat + (size_t)(r_) * D; \
        _Pragma("unroll") for (int rr = 0; rr < 2; ++rr) _Pragma("unroll") for (int i = 0; i < 4; ++i) dst[rr][i] = *(const f32x4*)(xr_ + rr * D + 8 * (lane + 64 * (i >> 1)) + 4 * (i & 1)); }
    if (row < nrows) NORM_LOAD(nx, row)
    while (row < nrows) {
#pragma unroll
        for (int rr = 0; rr < 2; ++rr)
#pragma unroll
            for (int i = 0; i < 4; ++i) v[rr][i] = nx[rr][i];
        const int nrow = row + stride;
        if (nrow < nrows) NORM_LOAD(nx, nrow)
        const int mb = (row >= T) ? 2 : (row >> 14);
        if (mb != cur_mb) { const float* sh = modl + mb * 9216 + (sub * 3) * 1024; const float* scp = sh + 1024;
#pragma unroll
            for (int i = 0; i < 4; ++i) { const int k = 8 * (lane + 64 * (i >> 1)) + 4 * (i & 1); gg[i] = *(const f32x4*)(g + k) * (*(const f32x4*)(scp + k) + 1.0f); s0[i] = *(const f32x4*)(sh + k); }
            cur_mb = mb; }
        float ss0 = 0.f, ss1 = 0.f;
#pragma unroll
        for (int i = 0; i < 4; ++i) { ss0 += v[0][i][0] * v[0][i][0] + v[0][i][1] * v[0][i][1] + v[0][i][2] * v[0][i][2] + v[0][i][3] * v[0][i][3];
            ss1 += v[1][i][0] * v[1][i][0] + v[1][i][1] * v[1][i][1] + v[1][i][2] * v[1][i][2] + v[1][i][3] * v[1][i][3]; }
#pragma unroll
        for (int o = 32; o >= 1; o >>= 1) { ss0 += __shfl_xor(ss0, o); ss1 += __shfl_xor(ss1, o); }
        const float rstd0 = rsqrtf(ss0 * (1.0f / D) + 1e-6f), rstd1 = rsqrtf(ss1 * (1.0f / D) + 1e-6f);
#pragma unroll
        for (int h2 = 0; h2 < 2; ++h2) { const int k = 8 * (lane + 64 * h2);
#pragma unroll
            for (int rr = 0; rr < 2; ++rr) { const float rs = rr ? rstd1 : rstd0;
                const f32x4 ya = v[rr][2 * h2] * rs * gg[2 * h2] + s0[2 * h2], yb = v[rr][2 * h2 + 1] * rs * gg[2 * h2 + 1] + s0[2 * h2 + 1];
                u32x4 w; w[0] = cvt_pk_bf16(ya[0], ya[1]); w[1] = cvt_pk_bf16(ya[2], ya[3]); w[2] = cvt_pk_bf16(yb[0], yb[1]); w[3] = cvt_pk_bf16(yb[2], yb[3]);
                *(u32x4*)(H + (size_t)(row + rr) * D + k) = w; } }
        row = nrow;
    }
#undef NORM_LOAD
}
__device__ void ph_final_norm(const P& p) {
    const int lane = TIDX & 63, wv = TIDX >> 6;
    const int stride = gridDim.x * 16;
    int row = (blockIdx.x * 8 + wv) * 2;
    f32x4 v[2][4], nx[2][4], gg[4];
#pragma unroll
    for (int i = 0; i < 4; ++i) gg[i] = *(const f32x4*)(p.final_g + 4 * (lane + 64 * i));
#define FN_LOAD(dst, r_) { const float* xr_ = p.out + (size_t)(r_) * D; \
        _Pragma("unroll") for (int rr = 0; rr < 2; ++rr) _Pragma("unroll") for (int i = 0; i < 4; ++i) dst[rr][i] = *(const f32x4*)(xr_ + rr * D + 4 * (lane + 64 * i)); }
    if (row < T) FN_LOAD(nx, row)
    while (row < T) {
#pragma unroll
        for (int rr = 0; rr < 2; ++rr)
#pragma unroll
            for (int i = 0; i < 4; ++i) v[rr][i] = nx[rr][i];
        const int nrow = row + stride;
        if (nrow < T) FN_LOAD(nx, nrow)
        float ss0 = 0.f, ss1 = 0.f;
#pragma unroll
        for (int i = 0; i < 4; ++i) { ss0 += v[0][i][0] * v[0][i][0] + v[0][i][1] * v[0][i][1] + v[0][i][2] * v[0][i][2] + v[0][i][3] * v[0][i][3];
            ss1 += v[1][i][0] * v[1][i][0] + v[1][i][1] * v[1][i][1] + v[1][i][2] * v[1][i][2] + v[1][i][3] * v[1][i][3]; }
#pragma unroll
        for (int o = 32; o >= 1; o >>= 1) { ss0 += __shfl_xor(ss0, o); ss1 += __shfl_xor(ss1, o); }
        const float rstd0 = rsqrtf(ss0 * (1.0f / D) + 1e-6f), rstd1 = rsqrtf(ss1 * (1.0f / D) + 1e-6f);
        float* xr = p.out + (size_t)row * D;
#pragma unroll
        for (int i = 0; i < 4; ++i) { const int k = 4 * (lane + 64 * i); *(f32x4*)(xr + k) = v[0][i] * rstd0 * gg[i]; *(f32x4*)(xr + D + k) = v[1][i] * rstd1 * gg[i]; }
        row = nrow;
    }
#undef FN_LOAD
}

__device__ void ph_na_naive(const P& p) {
    const bf16_t* R = (const bf16_t*)(p.ws + WS_R);
    const bf16_t* QA = R; const bf16_t* KA = R + (size_t)TP * 512; const bf16_t* VA = R + (size_t)2 * TP * 512;
    bf16_t* Y = (bf16_t*)(p.ws + WS_H);
    for (int u = blockIdx.x; u < 512; u += gridDim.x) {
        const int head = u & 7, token = (u >> 3) * 512 + TIDX, b = token >> 14, n = token & (NSEQ - 1), gi = n >> 6, gj = n & 63;
        const int r0 = min(max(gi - 4, 0), 248), c0 = min(max(gj - 8, 0), 48);
        float q[64], acc[64];
        { const u32x4* qp = (const u32x4*)(QA + (size_t)token * 512 + head * 64);
#pragma unroll
          for (int i = 0; i < 8; ++i) { const u32x4 w = qp[i];
#pragma unroll
              for (int e = 0; e < 4; ++e) { q[i * 8 + 2 * e] = bflo(w[e]) * 0.125f; q[i * 8 + 2 * e + 1] = bfhi(w[e]) * 0.125f; } } }
#pragma unroll
        for (int d = 0; d < 64; ++d) acc[d] = 0.f;
        float m = -1e30f, l = 0.f;
        const float* rp = p.na_rpb + head * 465;
#pragma unroll 1
        for (int kidx = 0; kidx < 384; ++kidx) {
            int krow; float bias = 0.f;
            if (kidx < 128) { const int a = kidx >> 4, kk = kidx & 15; krow = (b << 14) + (r0 + a) * 64 + c0 + kk; bias = rp[(r0 + a - gi + 7) * 31 + (c0 + kk - gj + 15)]; }
            else krow = T + b * 256 + (kidx - 128);
            const u32x4* kp = (const u32x4*)(KA + (size_t)krow * 512 + head * 64);
            float s = 0.f;
#pragma unroll
            for (int i = 0; i < 8; ++i) { const u32x4 w = kp[i];
#pragma unroll
                for (int e = 0; e < 4; ++e) { s += q[i * 8 + 2 * e] * bflo(w[e]); s += q[i * 8 + 2 * e + 1] * bfhi(w[e]); } }
            s += bias;
            const float mn = fmaxf(m, s), sc = __expf(m - mn), pw = __expf(s - mn);
            l = l * sc + pw; m = mn;
            const u32x4* vp = (const u32x4*)(VA + (size_t)krow * 512 + head * 64);
#pragma unroll
            for (int i = 0; i < 8; ++i) { const u32x4 w = vp[i];
#pragma unroll
                for (int e = 0; e < 4; ++e) { acc[i * 8 + 2 * e] = acc[i * 8 + 2 * e] * sc + pw * bflo(w[e]); acc[i * 8 + 2 * e + 1] = acc[i * 8 + 2 * e + 1] * sc + pw * bfhi(w[e]); } }
        }
        const float il = 1.0f / l;
        u32x4* yp = (u32x4*)(Y + (size_t)token * 1024 + head * 64);
#pragma unroll
        for (int i = 0; i < 8; ++i) { u32x4 w;
#pragma unroll
            for (int e = 0; e < 4; ++e) w[e] = cvt_pk_bf16(acc[i * 8 + 2 * e] * il, acc[i * 8 + 2 * e + 1] * il);
            yp[i] = w; }
    }
}

__device__ __forceinline__ int ml_chunk_row0(int b, int d, int j) {
    if (j < 2) { const int oc = d ? 1 - j : j; return T + b * 256 + oc * 128; }
    const int oc = d ? 129 - j : j - 2; return (b << 14) + oc * 128;
}
__device__ __forceinline__ void ml_load_tile(LAS unsigned char* dst, const bf16_t* src, const LAS float* rowscale) {
    for (int i = TIDX; i < 128 * 16; i += NTHR) { const int r = i >> 4, ch = i & 15;
        u32x4 w = *(const u32x4*)(src + (size_t)r * 512 + ch * 8);
        if (rowscale) { const float a = rowscale[r];
#pragma unroll
            for (int e = 0; e < 4; ++e) w[e] = cvt_pk_bf16(bflo(w[e]) * a, bfhi(w[e]) * a); }
        *(LAS u32x4*)(dst + r * PITCH + ch * 16) = w; }
}

__device__ void ph_mlA_naive(const P& p, LAS unsigned char* lds) {
    const bf16_t* R = (const bf16_t*)(p.ws + WS_R);
    const bf16_t* KB = R + (size_t)4 * TP * 512; const bf16_t* VB = R + (size_t)5 * TP * 512; const float* Gt = (const float*)(R + (size_t)7 * TP * 512);
    bf16_t* CL = (bf16_t*)(p.ws + WS_CL); float* VEC = (float*)(p.ws + WS_VEC); float* NL = (float*)(p.ws + WS_NL);
    LAS unsigned char* Kt = lds; LAS unsigned char* Vt = lds + 128 * PITCH; LAS float* av = (LAS float*)(lds + 2 * 128 * PITCH);
    const int tid = TIDX, lane = tid & 63;
    for (int slot = blockIdx.x; slot < NSLOT; slot += gridDim.x) {
        const int j = slot % 130, bhd = slot / 130, d = bhd & 1, h = (bhd >> 1) & 3, b = bhd >> 3;
        const int row0 = ml_chunk_row0(b, d, j);
        __syncthreads();
        if (tid < 64) {
            const int p0 = 2 * lane, p1 = 2 * lane + 1, t0 = d ? 127 - p0 : p0, t1 = d ? 127 - p1 : p1;
            const int gofs = (h * 2 + d) * 2;
            const float i0 = Gt[(size_t)(row0 + t0) * 16 + gofs], f0 = Gt[(size_t)(row0 + t0) * 16 + gofs + 1];
            const float i1 = Gt[(size_t)(row0 + t1) * 16 + gofs], f1 = Gt[(size_t)(row0 + t1) * 16 + gofs + 1];
            float s = f0 + f1;
#pragma unroll
            for (int o = 1; o < 64; o <<= 1) { const float t = __shfl_up(s, o); if (lane >= o) s += t; }
            const float b1 = s, b0 = s - f1, z0 = i0 - b0, z1 = i1 - b1;
            float cmx = fmaxf(z0, z1);
#pragma unroll
            for (int o = 1; o < 64; o <<= 1) { const float t = __shfl_up(cmx, o); if (lane >= o) cmx = fmaxf(cmx, t); }
            float prev = __shfl_up(cmx, 1); if (lane == 0) prev = -1e30f;
            const float cm0 = fmaxf(prev, z0), cm1 = cmx;
            const float btot = __shfl(b1, 63), cml = __shfl(cm1, 63);
            float* vz = VEC + (size_t)slot * 512;
            vz[t0] = z0; vz[t1] = z1; vz[128 + t0] = b0; vz[128 + t1] = b1; vz[256 + t0] = cm0; vz[256 + t1] = cm1;
            if (lane == 0) { vz[384] = btot; vz[385] = btot + cml; }
            av[t0] = __expf(z0 - cml); av[t1] = __expf(z1 - cml);
        }
        __syncthreads();
        ml_load_tile(Kt, KB + (size_t)row0 * 512 + h * 128, nullptr);
        ml_load_tile(Vt, VB + (size_t)row0 * 512 + h * 128, av);
        __syncthreads();
        {
            const int v = tid >> 2, kq = tid & 3;
            float acc[32];
#pragma unroll
            for (int i = 0; i < 32; ++i) acc[i] = 0.f;
#pragma unroll 1
            for (int s = 0; s < 128; ++s) {
                const float avv = bf2f(*(const LAS bf16_t*)(Vt + s * PITCH + v * 2));
#pragma unroll
                for (int c = 0; c < 4; ++c) { const u32x4 w = *(const LAS u32x4*)(Kt + s * PITCH + kq * 64 + c * 16);
#pragma unroll
                    for (int e = 0; e < 4; ++e) { acc[c * 8 + 2 * e] += avv * bflo(w[e]); acc[c * 8 + 2 * e + 1] += avv * bfhi(w[e]); } }
            }
            bf16_t* cp = CL + (size_t)slot * 16384 + v * 128 + kq * 32;
#pragma unroll
            for (int c = 0; c < 4; ++c) { u32x4 w;
#pragma unroll
                for (int e = 0; e < 4; ++e) w[e] = cvt_pk_bf16(acc[c * 8 + 2 * e], acc[c * 8 + 2 * e + 1]);
                *(u32x4*)(cp + c * 8) = w; }
            if (tid < 128) { float sacc = 0.f; for (int s = 0; s < 128; ++s) sacc += av[s] * bf2f(*(const LAS bf16_t*)(Kt + s * PITCH + tid * 2)); NL[(size_t)slot * 128 + tid] = sacc; }
        }
    }
}

__device__ void ph_mlB(const P& p, LAS unsigned char* lds) {
    unsigned* CL = (unsigned*)(p.ws + WS_CL); float* VEC = (float*)(p.ws + WS_VEC); float* NL = (float*)(p.ws + WS_NL);
    LAS float* sb = (LAS float*)lds;
    const int tid = TIDX;
    for (int w = blockIdx.x; w < 16 * 16; w += gridDim.x) {
        const int stream = w >> 4, e2 = (w & 15) * 512 + tid;
        __syncthreads();
        if (tid < 130) { const float* vz = VEC + (size_t)(stream * 130 + tid) * 512 + 384; sb[2 * tid] = vz[0]; sb[2 * tid + 1] = vz[1]; }
        __syncthreads();
        float m = 0.f, c0 = 0.f, c1 = 0.f, n0 = 0.f, n1 = 0.f;
        const bool do_n = (w & 15) == 0 && tid < 64;
        unsigned* cp = CL + (size_t)stream * 130 * 8192 + e2;
        float* np = NL + (size_t)stream * 130 * 128 + 2 * tid;
        unsigned cl[13], cn[13]; f32x2 nlv[13], nnv[13];
#pragma unroll
        for (int jj = 0; jj < 13; ++jj) cn[jj] = cp[(size_t)jj * 8192];
        if (do_n) {
#pragma unroll
            for (int jj = 0; jj < 13; ++jj) nnv[jj] = *(const f32x2*)(np + (size_t)jj * 128);
        }
        for (int j0 = 0; j0 < 130; j0 += 13) {
#pragma unroll
            for (int jj = 0; jj < 13; ++jj) { cl[jj] = cn[jj]; nlv[jj] = nnv[jj]; }
            if (j0 + 13 < 130) {
#pragma unroll
                for (int jj = 0; jj < 13; ++jj) cn[jj] = cp[(size_t)(j0 + 13 + jj) * 8192];
                if (do_n) {
#pragma unroll
                    for (int jj = 0; jj < 13; ++jj) nnv[jj] = *(const f32x2*)(np + (size_t)(j0 + 13 + jj) * 128);
                }
            }
#pragma unroll
            for (int jj = 0; jj < 13; ++jj) {
                const int j = j0 + jj;
                const float btot = sb[2 * j], mloc = sb[2 * j + 1];
                cp[(size_t)j * 8192] = cvt_pk_bf16(c0, c1);
                const float mn = fmaxf(btot + m, mloc), ap = __expf(btot + m - mn), al = __expf(mloc - mn);
                if (do_n) { *(f32x2*)(np + (size_t)j * 128) = (f32x2){n0, n1}; n0 = ap * n0 + al * nlv[jj][0]; n1 = ap * n1 + al * nlv[jj][1]; }
                if ((w & 15) == 0 && tid == 0) VEC[(size_t)(stream * 130 + j) * 512 + 386] = m;
                c0 = ap * c0 + al * bflo(cl[jj]); c1 = ap * c1 + al * bfhi(cl[jj]); m = mn;
            }
        }
    }
}

__device__ void ph_mlC_naive(const P& p, LAS unsigned char* lds) {
    const bf16_t* R = (const bf16_t*)(p.ws + WS_R);
    const bf16_t* QB = R + (size_t)3 * TP * 512; const bf16_t* KB = R + (size_t)4 * TP * 512; const bf16_t* VB = R + (size_t)5 * TP * 512; const bf16_t* OB = R + (size_t)6 * TP * 512;
    const bf16_t* CL = (const bf16_t*)(p.ws + WS_CL); const float* VEC = (const float*)(p.ws + WS_VEC); const float* NL = (const float*)(p.ws + WS_NL);
    bf16_t* Y = (bf16_t*)(p.ws + WS_H);
    LAS unsigned char* Qt = lds; LAS unsigned char* Kt = lds + 128 * PITCH; LAS unsigned char* Vt = lds + 2 * 128 * PITCH; LAS unsigned char* Ct = lds + 3 * 128 * PITCH;
    LAS float* vz = (LAS float*)(lds + 4 * 128 * PITCH); LAS float* vb = vz + 128; LAS float* vcm = vb + 128; LAS float* vn = vcm + 128;
    const int tid = TIDX, t = tid >> 2, vq = tid & 3;
    for (int u = blockIdx.x; u < 1024; u += gridDim.x) {
        const int oc = u & 127, h = (u >> 7) & 3, b = u >> 9;
        const int row0 = (b << 14) + oc * 128;
        float hsum[32];
#pragma unroll
        for (int i = 0; i < 32; ++i) hsum[i] = 0.f;
        for (int d = 0; d < 2; ++d) {
            const int j = d ? 129 - oc : oc + 2, slot = ((b * 4 + h) * 2 + d) * 130 + j;
            __syncthreads();
            ml_load_tile(Qt, QB + (size_t)row0 * 512 + h * 128, nullptr);
            ml_load_tile(Kt, KB + (size_t)row0 * 512 + h * 128, nullptr);
            ml_load_tile(Vt, VB + (size_t)row0 * 512 + h * 128, nullptr);
            for (int i = tid; i < 128 * 16; i += NTHR) { const int r = i >> 4, ch = i & 15; *(LAS u32x4*)(Ct + r * PITCH + ch * 16) = *(const u32x4*)(CL + (size_t)slot * 16384 + r * 128 + ch * 8); }
            if (tid < 128) { const float* vp = VEC + (size_t)slot * 512; vz[tid] = vp[tid]; vb[tid] = vp[128 + tid]; vcm[tid] = vp[256 + tid]; vn[tid] = NL[(size_t)slot * 128 + tid]; }
            const float mprev = VEC[(size_t)slot * 512 + 386];
            __syncthreads();
            const float ut = -fmaxf(mprev, vcm[t]), winter = __expf(mprev + ut), flo = __expf(ut - vb[t]);
            float sc[32];
#pragma unroll
            for (int i = 0; i < 32; ++i) sc[i] = 0.f;
            float nq = 0.f;
#pragma unroll 1
            for (int kc = 0; kc < 16; ++kc) {
                const u32x4 qw = *(const LAS u32x4*)(Qt + t * PITCH + kc * 16);
                float qf[8];
#pragma unroll
                for (int e = 0; e < 4; ++e) { qf[2 * e] = bflo(qw[e]); qf[2 * e + 1] = bfhi(qw[e]); }
                if ((kc >> 2) == vq) {
#pragma unroll
                    for (int e = 0; e < 8; ++e) nq += qf[e] * vn[kc * 8 + e]; }
#pragma unroll
                for (int si = 0; si < 32; ++si) { const u32x4 kw = *(const LAS u32x4*)(Kt + (32 * vq + si) * PITCH + kc * 16);
#pragma unroll
                    for (int e = 0; e < 4; ++e) { sc[si] += qf[2 * e] * bflo(kw[e]); sc[si] += qf[2 * e + 1] * bfhi(kw[e]); }
                    asm volatile("" ::: "memory"); }
            }
            float rs = 0.f;
            int tt = t, s_base = 32 * vq; asm volatile("" : "+v"(tt), "+v"(s_base));
#pragma unroll
            for (int si = 0; si < 32; ++si) { const int s = s_base + si; const bool ok = d ? (s >= tt) : (s <= tt);
                const float w = ok ? __expf(ut + vz[s]) : 0.f; sc[si] *= w; rs += sc[si]; }
            rs += __shfl_xor(rs, 1); rs += __shfl_xor(rs, 2);
            nq += __shfl_xor(nq, 1); nq += __shfl_xor(nq, 2);
            __syncthreads();
#pragma unroll
            for (int c = 0; c < 4; ++c) { u32x4 w;
#pragma unroll
                for (int e = 0; e < 4; ++e) w[e] = cvt_pk_bf16(sc[c * 8 + 2 * e], sc[c * 8 + 2 * e + 1]);
                *(LAS u32x4*)(Kt + t * PITCH + vq * 64 + c * 16) = w; }
            __syncthreads();
            const float den = winter * nq + rs, dd = 1.0f / fmaxf(fabsf(den), flo);
#pragma unroll
            for (int hv = 0; hv < 2; ++hv) {
                float num[16];
#pragma unroll
                for (int i = 0; i < 16; ++i) num[i] = 0.f;
#pragma unroll 1
                for (int kc = 0; kc < 16; ++kc) {
                    const u32x4 qw = *(const LAS u32x4*)(Qt + t * PITCH + kc * 16);
                    float qf[8];
#pragma unroll
                    for (int e = 0; e < 4; ++e) { qf[2 * e] = bflo(qw[e]); qf[2 * e + 1] = bfhi(qw[e]); }
#pragma unroll
                    for (int vi = 0; vi < 16; ++vi) { const u32x4 cw = *(const LAS u32x4*)(Ct + (32 * vq + 16 * hv + vi) * PITCH + kc * 16);
#pragma unroll
                        for (int e = 0; e < 4; ++e) { num[vi] += qf[2 * e] * bflo(cw[e]); num[vi] += qf[2 * e + 1] * bfhi(cw[e]); }
                        asm volatile("" ::: "memory"); }
                }
#pragma unroll
                for (int i = 0; i < 16; ++i) num[i] *= winter;
#pragma unroll 1
                for (int s8 = 0; s8 < 16; ++s8) {
                    const u32x4 pw = *(const LAS u32x4*)(Kt + t * PITCH + s8 * 16);
                    float pf[8];
#pragma unroll
                    for (int e = 0; e < 4; ++e) { pf[2 * e] = bflo(pw[e]); pf[2 * e + 1] = bfhi(pw[e]); }
#pragma unroll
                    for (int ss = 0; ss < 8; ++ss) {
#pragma unroll
                        for (int c = 0; c < 2; ++c) { const u32x4 vw = *(const LAS u32x4*)(Vt + (s8 * 8 + ss) * PITCH + vq * 64 + hv * 32 + c * 16);
#pragma unroll
                            for (int e = 0; e < 4; ++e) { num[c * 8 + 2 * e] += pf[ss] * bflo(vw[e]); num[c * 8 + 2 * e + 1] += pf[ss] * bfhi(vw[e]); } }
                        asm volatile("" ::: "memory"); }
                }
#pragma unroll
                for (int i = 0; i < 16; ++i) hsum[hv * 16 + i] += num[i] * dd;
            }
        }
        float ss = 0.f;
#pragma unroll
        for (int i = 0; i < 32; ++i) ss += hsum[i] * hsum[i];
        ss += __shfl_xor(ss, 1); ss += __shfl_xor(ss, 2);
        const float rstd = rsqrtf(ss * (1.0f / 128.0f) + 1e-6f);
        const int row = row0 + t;
        const bf16_t* op = OB + (size_t)row * 512 + h * 128 + vq * 32; const float* hg = p.ml_head_g + h * 128 + vq * 32;
        bf16_t* yp = Y + (size_t)row * 1024 + 512 + h * 128 + vq * 32;
#pragma unroll
        for (int c = 0; c < 4; ++c) { const u32x4 ow = *(const u32x4*)(op + c * 8); u32x4 w;
#pragma unroll
            for (int e = 0; e < 4; ++e) { const int i0 = c * 8 + 2 * e;
                const float y0 = hsum[i0] * rstd * hg[i0] * sigmoid_f(bflo(ow[e])), y1 = hsum[i0 + 1] * rstd * hg[i0 + 1] * sigmoid_f(bfhi(ow[e]));
                w[e] = cvt_pk_bf16(y0, y1); }
            *(u32x4*)(yp + c * 8) = w; }
    }
}

__device__ void ph_sg_stats(const P& p) {
    const bf16_t* V = (const bf16_t*)(p.ws + WS_R) + (size_t)T * 2048; float* ST = (float*)(p.ws + WS_ST);
    const int lane = TIDX & 63, wv = TIDX >> 6;
    for (int row = blockIdx.x * 8 + wv; row < T; row += gridDim.x * 8) {
        float vals[32]; float s = 0.f;
#pragma unroll
        for (int i = 0; i < 4; ++i) { const u32x4 w = *(const u32x4*)(V + (size_t)row * 2048 + 8 * (lane + 64 * i));
#pragma unroll
            for (int e = 0; e < 4; ++e) { vals[i * 8 + 2 * e] = bflo(w[e]); vals[i * 8 + 2 * e + 1] = bfhi(w[e]); s += vals[i * 8 + 2 * e] + vals[i * 8 + 2 * e + 1]; } }
#pragma unroll
        for (int o = 32; o >= 1; o >>= 1) s += __shfl_xor(s, o);
        const float mu = s * (1.0f / 2048.0f); float q = 0.f;
#pragma unroll
        for (int i = 0; i < 32; ++i) { const float dlt = vals[i] - mu; q += dlt * dlt; }
#pragma unroll
        for (int o = 32; o >= 1; o >>= 1) q += __shfl_xor(q, o);
        if (lane == 0) { ST[2 * row] = mu; ST[2 * row + 1] = rsqrtf(q * (1.0f / 2048.0f) + 1e-6f); }
    }
}
__device__ void ph_sg_naive(const P& p, LAS unsigned char* lds) {
    bf16_t* U = (bf16_t*)(p.ws + WS_R); const bf16_t* V = U + (size_t)T * 2048; const float* ST = (const float*)(p.ws + WS_ST);
    constexpr int VP = 528;
    LAS unsigned char* Vn = lds; LAS unsigned char* Wt = lds + 128 * VP;
    const int tid = TIDX, t = tid >> 2, dq = tid & 3;
    for (int u = blockIdx.x; u < 2048; u += gridDim.x) {
        const int g = u & 7, ch = u >> 3, row0 = ch * 128;
        __syncthreads();
        for (int i = tid; i < 128 * 32; i += NTHR) { const int r = i >> 5, c8 = i & 31; const int cbase = g * 256 + c8 * 8;
            const u32x4 w = *(const u32x4*)(V + (size_t)(row0 + r) * 2048 + cbase); const float mu = ST[2 * (row0 + r)], rs = ST[2 * (row0 + r) + 1];
            const f32x4 g0 = *(const f32x4*)(p.sg_ln_g + cbase), g1 = *(const f32x4*)(p.sg_ln_g + cbase + 4), b0 = *(const f32x4*)(p.sg_ln_b + cbase), b1 = *(const f32x4*)(p.sg_ln_b + cbase + 4);
            u32x4 o;
            o[0] = cvt_pk_bf16((bflo(w[0]) - mu) * rs * g0[0] + b0[0], (bfhi(w[0]) - mu) * rs * g0[1] + b0[1]);
            o[1] = cvt_pk_bf16((bflo(w[1]) - mu) * rs * g0[2] + b0[2], (bfhi(w[1]) - mu) * rs * g0[3] + b0[3]);
            o[2] = cvt_pk_bf16((bflo(w[2]) - mu) * rs * g1[0] + b1[0], (bfhi(w[2]) - mu) * rs * g1[1] + b1[1]);
            o[3] = cvt_pk_bf16((bflo(w[3]) - mu) * rs * g1[2] + b1[2], (bfhi(w[3]) - mu) * rs * g1[3] + b1[3]);
            *(LAS u32x4*)(Vn + r * VP + c8 * 16) = o; }
        for (int i = tid; i < 128 * 32; i += NTHR) { const int r = i >> 5, c4 = i & 31; const f32x4 w = *(const f32x4*)(p.sg_w_s + (size_t)g * 16384 + r * 128 + c4 * 4);
            u32x2 o; o.x = cvt_pk_bf16(w[0], w[1]); o.y = cvt_pk_bf16(w[2], w[3]); *(LAS u32x2*)(Wt + r * PITCH + c4 * 8) = o; }
        __syncthreads();
        float acc[64];
#pragma unroll
        for (int i = 0; i < 64; ++i) acc[i] = 0.f;
#pragma unroll 1
        for (int s8 = 0; s8 < 16; ++s8) {
            const u32x4 ww = *(const LAS u32x4*)(Wt + t * PITCH + s8 * 16);
            float wf[8];
#pragma unroll
            for (int e = 0; e < 4; ++e) { wf[2 * e] = bflo(ww[e]); wf[2 * e + 1] = bfhi(ww[e]); }
#pragma unroll
            for (int ss = 0; ss < 8; ++ss) {
#pragma unroll
                for (int c = 0; c < 8; ++c) { const u32x4 vw = *(const LAS u32x4*)(Vn + (s8 * 8 + ss) * VP + dq * 128 + c * 16);
#pragma unroll
                    for (int e = 0; e < 4; ++e) { acc[c * 8 + 2 * e] += wf[ss] * bflo(vw[e]); acc[c * 8 + 2 * e + 1] += wf[ss] * bfhi(vw[e]); }
                    if ((c & 3) == 3) asm volatile("" ::: "memory"); } }
        }
        const float bs = p.sg_b_s[g * 128 + t];
        bf16_t* up = U + (size_t)(row0 + t) * 2048 + g * 256 + dq * 64;
#pragma unroll
        for (int c = 0; c < 8; ++c) { const u32x4 uw = *(const u32x4*)(up + c * 8); u32x4 o;
#pragma unroll
            for (int e = 0; e < 4; ++e) o[e] = cvt_pk_bf16(bflo(uw[e]) * (acc[c * 8 + 2 * e] + bs), bfhi(uw[e]) * (acc[c * 8 + 2 * e + 1] + bs));
            *(u32x4*)(up + c * 8) = o; }
    }
}

typedef short s16x4 __attribute__((ext_vector_type(4)));
__device__ __forceinline__ s16x4 ds_tr(LAS unsigned char* a) { return __builtin_amdgcn_ds_read_tr16_b64_v4i16((LAS s16x4*)a); }
__device__ __forceinline__ bf16x8 cat8(s16x4 lo, s16x4 hi) { return __builtin_shufflevector(lo, hi, 0, 1, 2, 3, 4, 5, 6, 7); }
__device__ __forceinline__ f32x4 mfma16(bf16x8 a, bf16x8 b, f32x4 c) { return __builtin_amdgcn_mfma_f32_16x16x32_bf16(a, b, c, 0, 0, 0); }
__device__ __forceinline__ bf16x8 pk8(f32x4 a, f32x4 b) { u32x4 w; w[0] = cvt_pk_bf16(a[0], a[1]); w[1] = cvt_pk_bf16(a[2], a[3]); w[2] = cvt_pk_bf16(b[0], b[1]); w[3] = cvt_pk_bf16(b[2], b[3]); return __builtin_bit_cast(bf16x8, w); }
constexpr int TPI = 304;
__device__ __forceinline__ void ml_load_tile2(LAS unsigned char* dst, const bf16_t* src, int srcstride, const LAS float* rowscale, int tid) {
    for (int i = tid; i < 128 * 16; i += NTHR) { const int r = i >> 4, ch = i & 15;
        u32x4 w = *(const u32x4*)(src + (size_t)r * srcstride + ch * 8);
        if (rowscale) { const float a = rowscale[r];
#pragma unroll
            for (int e = 0; e < 4; ++e) w[e] = cvt_pk_bf16(bflo(w[e]) * a, bfhi(w[e]) * a); }
        *(LAS u32x4*)(dst + r * TPI + ch * 16) = w; }
}

__device__ void ph_na(const P& p, LAS unsigned char* lds) {
    const bf16_t* R = (const bf16_t*)(p.ws + WS_R);
    const bf16_t* QA = R; const bf16_t* KA = R + (size_t)TP * 512; const bf16_t* VA = R + (size_t)2 * TP * 512;
    bf16_t* Y = (bf16_t*)(p.ws + WS_H);
    constexpr int VP = 144;
    LAS unsigned char* Vl = lds; LAS unsigned char* Vc = lds + 512 * VP;
    LAS float* comb = (LAS float*)(lds + 768 * VP); LAS float* rpbs = comb + 4 * 18 * 64;
    const int tid = TIDX, lane = tid & 63, w = __builtin_amdgcn_readfirstlane(tid >> 6), c = lane & 15, g = lane >> 4, qb = w & 3, half = w >> 2;
    const int qq = (lane & 15) >> 2, pp = lane & 3;
    const int per = (4096 + gridDim.x - 1) / gridDim.x;
    const int u_lo = blockIdx.x * per, u_hi = min(u_lo + per, 4096);
    int last_bh = -1;
    const int cstart = (qb == 0) ? 0 : (qb == 1) ? 8 : (qb == 2) ? 24 : 32;
    u32x4 vnew = {0u, 0u, 0u, 0u}; int pf_row = -1; bf16x8 qn[2] = {};
    int crm[2][4];
    { const int qcol = 16 * qb + c, c0 = min(max(qcol - 8, 0), 48);
#pragma unroll
      for (int chh = 0; chh < 2; ++chh)
#pragma unroll
          for (int j = 0; j < 4; ++j) { const int col = cstart + 16 * chh + 4 * g + j; crm[chh][j] = ((col >= c0) && (col < c0 + 16)) ? (col - qcol + 15) : 31; } }
    for (int u = u_lo; u < u_hi; ++u) {
        const int gi = u & 255, bh = u >> 8, head = bh & 7, b = bh >> 3;
        const int r0 = min(max(gi - 4, 0), 248);
        const int token = (b << 14) + gi * 64 + 16 * qb + c;
        bf16x8 qf[2];
        if (bh != last_bh) {
            for (int i = tid; i < 256 * 8; i += NTHR) { const int key = i >> 3, ch = i & 7;
                *(LAS u32x4*)(Vc + key * VP + ch * 16) = *(const u32x4*)(VA + (size_t)(T + b * 256 + key) * 512 + head * 64 + ch * 8); }
            if (tid < 480) { const int rr = tid >> 5, cc = tid & 31; rpbs[tid] = (cc < 31) ? p.na_rpb[head * 465 + rr * 31 + cc] * 1.4426950408889634f : -1e30f; }
            for (int i = tid; i < 512 * 8; i += NTHR) { const int key = i >> 3, ch = i & 7, row = r0 + (key >> 6);
                *(LAS u32x4*)(Vl + ((row & 7) * 64 + (key & 63)) * VP + ch * 16) = *(const u32x4*)(VA + (size_t)((b << 14) + row * 64 + (key & 63)) * 512 + head * 64 + ch * 8); }
            qf[0] = *(const bf16x8*)(QA + (size_t)token * 512 + head * 64 + 8 * g); qf[1] = *(const bf16x8*)(QA + (size_t)token * 512 + head * 64 + 32 + 8 * g);
            last_bh = bh;
        } else {
            if (pf_row >= 0) *(LAS u32x4*)(Vl + ((pf_row & 7) * 64 + (tid >> 3)) * VP + (tid & 7) * 16) = vnew;
            qf[0] = qn[0]; qf[1] = qn[1];
        }
        __syncthreads();
        pf_row = -1;
        if (u + 1 < u_hi && ((u + 1) >> 8) == bh) {
            const int gin = gi + 1, r0n = min(max(gin - 4, 0), 248);
            if (r0n != r0) { pf_row = r0n + 7; vnew = *(const u32x4*)(VA + (size_t)((b << 14) + pf_row * 64 + (tid >> 3)) * 512 + head * 64 + (tid & 7) * 8); }
            const size_t tn = (size_t)((b << 14) + gin * 64 + 16 * qb + c) * 512 + head * 64 + 8 * g;
            qn[0] = *(const bf16x8*)(QA + tn); qn[1] = *(const bf16x8*)(QA + tn + 32);
        }
        f32x4 sc[16];
        const LAS float* rrow = rpbs + (r0 - gi + 7) * 32;
#pragma unroll
        for (int kt = 0; kt < 16; ++kt) {
            const int a = kt >> 1, chh = kt & 1;
            const int krow = half ? (T + b * 256 + 16 * kt + c) : ((b << 14) + (r0 + a) * 64 + cstart + 16 * chh + c);
            const bf16_t* kp = KA + (size_t)krow * 512 + head * 64 + 8 * g;
            const bf16x8 A0 = *(const bf16x8*)kp, A1 = *(const bf16x8*)(kp + 32);
            f32x4 acc = {0.f, 0.f, 0.f, 0.f};
            acc = mfma16(A0, qf[0], acc); acc = mfma16(A1, qf[1], acc);
            if (half == 0) {
#pragma unroll
                for (int j = 0; j < 4; ++j) acc[j] = acc[j] * 0.18033688011112042f + rrow[a * 32 + crm[chh][j]];
            } else acc = acc * 0.18033688011112042f;
            sc[kt] = acc;
        }
        float m = -1e30f;
#pragma unroll
        for (int kt = 0; kt < 16; ++kt) m = fmaxf(m, fmaxf(fmaxf(sc[kt][0], sc[kt][1]), fmaxf(sc[kt][2], sc[kt][3])));
        m = fmaxf(m, __shfl_xor(m, 16)); m = fmaxf(m, __shfl_xor(m, 32));
        float l = 0.f;
#pragma unroll
        for (int kt = 0; kt < 16; ++kt) {
#pragma unroll
            for (int j = 0; j < 4; ++j) { const float e = __builtin_amdgcn_exp2f(sc[kt][j] - m); sc[kt][j] = e; l += e; } }
        l += __shfl_xor(l, 16); l += __shfl_xor(l, 32);
        f32x4 o[4];
#pragma unroll
        for (int dt = 0; dt < 4; ++dt) o[dt] = (f32x4){0.f, 0.f, 0.f, 0.f};
#pragma unroll
        for (int kp = 0; kp < 8; ++kp) {
            const bf16x8 pf = pk8(sc[2 * kp], sc[2 * kp + 1]);
            LAS unsigned char* vb = half ? (Vc + (32 * kp + 4 * g + qq) * VP + 8 * pp) : (Vl + ((((r0 + kp) & 7) * 64) + cstart + 4 * g + qq) * VP + 8 * pp);
#pragma unroll
            for (int dt = 0; dt < 4; ++dt) { const s16x4 lo = ds_tr(vb + dt * 32), hi = ds_tr(vb + 16 * VP + dt * 32); o[dt] = mfma16(cat8(lo, hi), pf, o[dt]); }
        }
        if (half == 1) { LAS float* cb = comb + qb * 18 * 64 + lane; cb[0] = m; cb[64] = l;
#pragma unroll
            for (int dt = 0; dt < 4; ++dt)
#pragma unroll
                for (int j = 0; j < 4; ++j) cb[(2 + 4 * dt + j) * 64] = o[dt][j]; }
        __syncthreads();
        if (half == 0) { const LAS float* cb = comb + qb * 18 * 64 + lane; const float m1 = cb[0], l1 = cb[64];
            const float M = fmaxf(m, m1), e0 = __builtin_amdgcn_exp2f(m - M), e1 = __builtin_amdgcn_exp2f(m1 - M), il = 1.0f / (l * e0 + l1 * e1);
            bf16_t* yp = Y + (size_t)token * 1024 + head * 64 + 4 * g;
#pragma unroll
            for (int dt = 0; dt < 4; ++dt) { f32x4 r;
#pragma unroll
                for (int j = 0; j < 4; ++j) r[j] = (o[dt][j] * e0 + cb[(2 + 4 * dt + j) * 64] * e1) * il;
                u32x2 wv; wv.x = cvt_pk_bf16(r[0], r[1]); wv.y = cvt_pk_bf16(r[2], r[3]); *(u32x2*)(yp + 16 * dt) = wv; } }
    }
}

__device__ void ph_na2(const P& p, LAS unsigned char* lds) {
    const bf16_t* R = (const bf16_t*)(p.ws + WS_R);
    const bf16_t* QA = R; const bf16_t* KA = R + (size_t)TP * 512; const bf16_t* VA = R + (size_t)2 * TP * 512;
    bf16_t* Y = (bf16_t*)(p.ws + WS_H);
    constexpr int VP = 144, RING = 11;
    LAS unsigned char* Vl = lds; LAS unsigned char* Vc = lds + RING * 64 * VP; LAS float* rpbs = (LAS float*)(lds + (RING * 64 + 256) * VP);
    const int tid = TIDX, lane = tid & 63, w = __builtin_amdgcn_readfirstlane(tid >> 6), c = lane & 15, g = lane >> 4, qb = w & 3, ur = w >> 2;
    const int qq = (lane & 15) >> 2, pp = lane & 3;
    const int per = (4096 + gridDim.x - 1) / gridDim.x;
    const int u_lo = blockIdx.x * per, u_hi = min(u_lo + per, 4096);
    int last_bh = -1, have_hi = -1;
    const int cstart = (qb == 0) ? 0 : (qb == 1) ? 8 : (qb == 2) ? 24 : 32;
    u32x4 vnew0 = {0u, 0u, 0u, 0u}, vnew1 = vnew0; int pf_n = 0; bf16x8 qn[2] = {};
    int crm[2][4];
    { const int qcol = 16 * qb + c, c0 = min(max(qcol - 8, 0), 48);
#pragma unroll
      for (int chh = 0; chh < 2; ++chh)
#pragma unroll
          for (int j = 0; j < 4; ++j) { const int col = cstart + 16 * chh + 4 * g + j; crm[chh][j] = ((col >= c0) && (col < c0 + 16)) ? (col - qcol + 15) : 31; } }
    for (int u0 = u_lo; u0 < u_hi; u0 += 2) {
        const int bh = u0 >> 8, head = bh & 7, b = bh >> 3, gi0 = u0 & 255;
        const int r0a = min(max(gi0 - 4, 0), 248), r0b = min(max(gi0 - 3, 0), 248);
        const int gi = gi0 + ur, r0 = ur ? r0b : r0a;
        const bool valid = (u0 + ur) < u_hi;
        const int token = (b << 14) + gi * 64 + 16 * qb + c;
        bf16x8 qf[2];
        if (bh != last_bh) {
            __syncthreads();
            { u32x4 tv[4];
#pragma unroll
              for (int k = 0; k < 4; ++k) { const int i = tid + k * NTHR, key = i >> 3, ch = i & 7; tv[k] = *(const u32x4*)(VA + (size_t)(T + b * 256 + key) * 512 + head * 64 + ch * 8); }
#pragma unroll
              for (int k = 0; k < 4; ++k) { const int i = tid + k * NTHR, key = i >> 3, ch = i & 7; *(LAS u32x4*)(Vc + key * VP + ch * 16) = tv[k]; } }
            if (tid < 480) { const int rr = tid >> 5, cc = tid & 31; rpbs[tid] = (cc < 31) ? p.na_rpb[head * 465 + rr * 31 + cc] * 1.4426950408889634f : -1e30f; }
            { u32x4 tv[9];
#pragma unroll
              for (int k = 0; k < 9; ++k) { const int i = tid + k * NTHR, key = i >> 3, ch = i & 7, row = min(r0a + (key >> 6), r0b + 7);
                  tv[k] = *(const u32x4*)(VA + (size_t)((b << 14) + row * 64 + (key & 63)) * 512 + head * 64 + ch * 8); }
#pragma unroll
              for (int k = 0; k < 9; ++k) { const int i = tid + k * NTHR, key = i >> 3, ch = i & 7, row = r0a + (key >> 6);
                  if (row <= r0b + 7) *(LAS u32x4*)(Vl + ((row % RING) * 64 + (key & 63)) * VP + ch * 16) = tv[k]; } }
            qf[0] = *(const bf16x8*)(QA + (size_t)token * 512 + head * 64 + 8 * g); qf[1] = *(const bf16x8*)(QA + (size_t)token * 512 + head * 64 + 32 + 8 * g);
            last_bh = bh; have_hi = r0b + 7;
        } else {
            if (pf_n > 0) *(LAS u32x4*)(Vl + (((have_hi + 1) % RING) * 64 + (tid >> 3)) * VP + (tid & 7) * 16) = vnew0;
            if (pf_n > 1) *(LAS u32x4*)(Vl + (((have_hi + 2) % RING) * 64 + (tid >> 3)) * VP + (tid & 7) * 16) = vnew1;
            have_hi += pf_n;
            qf[0] = qn[0]; qf[1] = qn[1];
        }
        __syncthreads();
        pf_n = 0;
        if (u0 + 2 < u_hi && ((u0 + 2) >> 8) == bh) {
            const int need_hi = min(max(gi0 - 1, 0), 248) + 7;
            pf_n = need_hi - have_hi;
            if (pf_n > 0) vnew0 = *(const u32x4*)(VA + (size_t)((b << 14) + (have_hi + 1) * 64 + (tid >> 3)) * 512 + head * 64 + (tid & 7) * 8);
            if (pf_n > 1) vnew1 = *(const u32x4*)(VA + (size_t)((b << 14) + (have_hi + 2) * 64 + (tid >> 3)) * 512 + head * 64 + (tid & 7) * 8);
            const size_t tn = (size_t)((b << 14) + (gi + 2) * 64 + 16 * qb + c) * 512 + head * 64 + 8 * g;
            qn[0] = *(const bf16x8*)(QA + tn); qn[1] = *(const bf16x8*)(QA + tn + 32);
        }
        if (valid) {
            const LAS float* rrow = rpbs + (r0 - gi + 7) * 32;
            const bf16_t* kl = KA + (size_t)((b << 14) + r0 * 64 + cstart + c) * 512 + head * 64 + 8 * g;
            const bf16_t* kc = KA + (size_t)(T + b * 256 + c) * 512 + head * 64 + 8 * g;
            float M = -1e30f, L = 0.f;
            f32x4 o[4];
#pragma unroll
            for (int dt = 0; dt < 4; ++dt) o[dt] = (f32x4){0.f, 0.f, 0.f, 0.f};
#pragma unroll 1
            for (int hf = 0; hf < 2; ++hf) {
                f32x4 sc[16];
#pragma unroll
                for (int kt = 0; kt < 16; ++kt) {
                    const int a = kt >> 1, chh = kt & 1;
                    const bf16_t* kp = hf ? kc : kl;
                    if (hf) kc += 16 * 512; else kl += (chh ? 48 : 16) * 512;
                    const bf16x8 A0 = *(const bf16x8*)kp, A1 = *(const bf16x8*)(kp + 32);
                    f32x4 acc = {0.f, 0.f, 0.f, 0.f};
                    acc = mfma16(A0, qf[0], acc); acc = mfma16(A1, qf[1], acc);
                    if (hf == 0) {
#pragma unroll
                        for (int j = 0; j < 4; ++j) acc[j] = acc[j] * 0.18033688011112042f + rrow[a * 32 + crm[chh][j]];
                    } else acc = acc * 0.18033688011112042f;
                    sc[kt] = acc;
                    if ((kt & 7) == 7) asm volatile("" : "+v"(kl), "+v"(kc) :: "memory");
                }
                float m = -1e30f;
#pragma unroll
                for (int kt = 0; kt < 16; ++kt) m = fmaxf(m, fmaxf(fmaxf(sc[kt][0], sc[kt][1]), fmaxf(sc[kt][2], sc[kt][3])));
                m = fmaxf(m, __shfl_xor(m, 16)); m = fmaxf(m, __shfl_xor(m, 32));
                const float mn = fmaxf(M, m), es = __builtin_amdgcn_exp2f(M - mn);
                float l = 0.f;
#pragma unroll
                for (int kt = 0; kt < 16; ++kt) {
#pragma unroll
                    for (int j = 0; j < 4; ++j) { const float e = __builtin_amdgcn_exp2f(sc[kt][j] - mn); sc[kt][j] = e; l += e; } }
                l += __shfl_xor(l, 16); l += __shfl_xor(l, 32);
                L = L * es + l; M = mn;
#pragma unroll
                for (int dt = 0; dt < 4; ++dt) o[dt] = o[dt] * es;
#pragma unroll
                for (int kp = 0; kp < 8; ++kp) {
                    const bf16x8 pf = pk8(sc[2 * kp], sc[2 * kp + 1]);
                    LAS unsigned char* vb = hf ? (Vc + (32 * kp + 4 * g + qq) * VP + 8 * pp) : (Vl + ((((r0 + kp) % RING) * 64) + cstart + 4 * g + qq) * VP + 8 * pp);
#pragma unroll
                    for (int dt = 0; dt < 4; ++dt) { const s16x4 lo = ds_tr(vb + dt * 32), hi = ds_tr(vb + 16 * VP + dt * 32); o[dt] = mfma16(cat8(lo, hi), pf, o[dt]); }
                    if (kp & 1) asm volatile("" ::: "memory");
                }
            }
            const float il = 1.0f / L;
            bf16_t* yp = Y + (size_t)token * 1024 + head * 64 + 4 * g;
#pragma unroll
            for (int dt = 0; dt < 4; ++dt) { u32x2 wv; wv.x = cvt_pk_bf16(o[dt][0] * il, o[dt][1] * il); wv.y = cvt_pk_bf16(o[dt][2] * il, o[dt][3] * il); *(u32x2*)(yp + 16 * dt) = wv; }
        }
    }
}

__device__ void ph_mlA(const P& p, LAS unsigned char* lds) {
    const bf16_t* R = (const bf16_t*)(p.ws + WS_R);
    const bf16_t* KB = R + (size_t)4 * TP * 512; const bf16_t* VB = R + (size_t)5 * TP * 512; const float* Gt = (const float*)(R + (size_t)7 * TP * 512);
    bf16_t* CL = (bf16_t*)(p.ws + WS_CL); float* VEC = (float*)(p.ws + WS_VEC); float* NL = (float*)(p.ws + WS_NL);
    LAS unsigned char* Kt = lds; LAS unsigned char* Vt = lds + 128 * TPI; LAS float* av = (LAS float*)(lds + 2 * 128 * TPI);
    const int tid = TIDX, lane = tid & 63, w = __builtin_amdgcn_readfirstlane(tid >> 6), c = lane & 15, g = lane >> 4, qq = (lane & 15) >> 2, pp = lane & 3;
    const int ch = tid & 15, rb = tid >> 4;
    u32x4 kr[4], vr[4]; float gi0 = 0.f, gf0 = 0.f, gi1 = 0.f, gf1 = 0.f;
#define MLA_PREFETCH(sl) { const int j_ = (sl) % 130, bhd_ = (sl) / 130, d_ = bhd_ & 1, h_ = (bhd_ >> 1) & 3, b_ = bhd_ >> 3; const int row0_ = ml_chunk_row0(b_, d_, j_); \
        _Pragma("unroll") for (int k = 0; k < 4; ++k) { const size_t o_ = (size_t)(row0_ + rb + 32 * k) * 512 + h_ * 128 + ch * 8; kr[k] = *(const u32x4*)(KB + o_); vr[k] = *(const u32x4*)(VB + o_); } \
        if (w == 0) { const int p0 = 2 * lane, t0 = d_ ? 127 - p0 : p0, t1 = d_ ? 126 - p0 : p0 + 1; const int gofs = (h_ * 2 + d_) * 2; \
            gi0 = Gt[(size_t)(row0_ + t0) * 16 + gofs]; gf0 = Gt[(size_t)(row0_ + t0) * 16 + gofs + 1]; gi1 = Gt[(size_t)(row0_ + t1) * 16 + gofs]; gf1 = Gt[(size_t)(row0_ + t1) * 16 + gofs + 1]; } }
    int slot = blockIdx.x;
    if (slot < NSLOT) MLA_PREFETCH(slot)
    while (slot < NSLOT) {
        const int d = (slot / 130) & 1;
        __syncthreads();
        if (w == 0) {
            const int p0 = 2 * lane, p1 = 2 * lane + 1, t0 = d ? 127 - p0 : p0, t1 = d ? 127 - p1 : p1;
            const float i0 = gi0, f0 = gf0, i1 = gi1, f1 = gf1;
            float s = f0 + f1;
#pragma unroll
            for (int o = 1; o < 64; o <<= 1) { const float t = __shfl_up(s, o); if (lane >= o) s += t; }
            const float b1 = s, b0 = s - f1, z0 = i0 - b0, z1 = i1 - b1;
            float cmx = fmaxf(z0, z1);
#pragma unroll
            for (int o = 1; o < 64; o <<= 1) { const float t = __shfl_up(cmx, o); if (lane >= o) cmx = fmaxf(cmx, t); }
            float prev = __shfl_up(cmx, 1); if (lane == 0) prev = -1e30f;
            const float cm0 = fmaxf(prev, z0), cm1 = cmx;
            const float btot = __shfl(b1, 63), cml = __shfl(cm1, 63);
            float* vz = VEC + (size_t)slot * 512;
            vz[t0] = z0; vz[t1] = z1; vz[128 + t0] = b0; vz[128 + t1] = b1; vz[256 + t0] = cm0; vz[256 + t1] = cm1;
            if (lane == 0) { vz[384] = btot; vz[385] = btot + cml; }
            av[t0] = __expf(z0 - cml); av[t1] = __expf(z1 - cml);
        }
#pragma unroll
        for (int k = 0; k < 4; ++k) *(LAS u32x4*)(Kt + (rb + 32 * k) * TPI + ch * 16) = kr[k];
        __syncthreads();
#pragma unroll
        for (int k = 0; k < 4; ++k) { const float a = av[rb + 32 * k]; u32x4 wv = vr[k];
#pragma unroll
            for (int e = 0; e < 4; ++e) wv[e] = cvt_pk_bf16(bflo(wv[e]) * a, bfhi(wv[e]) * a);
            *(LAS u32x4*)(Vt + (rb + 32 * k) * TPI + ch * 16) = wv; }
        const int nslot = slot + gridDim.x;
        if (nslot < NSLOT) MLA_PREFETCH(nslot)
        __syncthreads();
        bf16x8 bv[4], af[4];
#pragma unroll
        for (int ks = 0; ks < 4; ++ks) { LAS unsigned char* a = Vt + (32 * ks + 8 * g + qq) * TPI + (16 * w + 4 * pp) * 2; bv[ks] = cat8(ds_tr(a), ds_tr(a + 4 * TPI));
            const f32x4 a0 = *(const LAS f32x4*)(av + 32 * ks + 8 * g), a1 = *(const LAS f32x4*)(av + 32 * ks + 8 * g + 4); af[ks] = pk8(a0, a1); }
        bf16_t* cp = CL + (size_t)slot * 16384 + (16 * w + c) * 128 + 4 * g;
#pragma unroll
        for (int kt = 0; kt < 8; ++kt) { f32x4 acc = {0.f, 0.f, 0.f, 0.f}, nacc = {0.f, 0.f, 0.f, 0.f};
#pragma unroll
            for (int ks = 0; ks < 4; ++ks) { LAS unsigned char* a = Kt + (32 * ks + 8 * g + qq) * TPI + (16 * kt + 4 * pp) * 2; const bf16x8 kf = cat8(ds_tr(a), ds_tr(a + 4 * TPI));
                acc = mfma16(kf, bv[ks], acc);
                if (kt == w) nacc = mfma16(kf, af[ks], nacc); }
            u32x2 wv; wv.x = cvt_pk_bf16(acc[0], acc[1]); wv.y = cvt_pk_bf16(acc[2], acc[3]); *(u32x2*)(cp + 16 * kt) = wv;
            if (kt == w && c == 0) *(f32x4*)(NL + (size_t)slot * 128 + 16 * kt + 4 * g) = nacc; }
        slot = nslot;
    }
#undef MLA_PREFETCH
}

__device__ void ph_mlC(const P& p, LAS unsigned char* lds) {
    const bf16_t* R = (const bf16_t*)(p.ws + WS_R);
    const bf16_t* QB = R + (size_t)3 * TP * 512; const bf16_t* KB = R + (size_t)4 * TP * 512; const bf16_t* VB = R + (size_t)5 * TP * 512; const bf16_t* OB = R + (size_t)6 * TP * 512;
    const bf16_t* CL = (const bf16_t*)(p.ws + WS_CL); const float* VEC = (const float*)(p.ws + WS_VEC); const float* NL = (const float*)(p.ws + WS_NL);
    bf16_t* Y = (bf16_t*)(p.ws + WS_H);
    LAS unsigned char* Kt = lds; LAS unsigned char* Vt = lds + 128 * TPI; LAS unsigned char* Ct = lds + 2 * 128 * TPI;
    LAS float* vz = (LAS float*)(lds + 3 * 128 * TPI); LAS float* vb = vz + 128; LAS float* vcm = vb + 128; LAS float* vn = vcm + 128;
    const int tid = TIDX, lane = tid & 63, w = __builtin_amdgcn_readfirstlane(tid >> 6), c = lane & 15, g = lane >> 4, qq = (lane & 15) >> 2, pp = lane & 3;
    const int t = 16 * w + c;
    for (int u = blockIdx.x; u < 1024; u += gridDim.x) {
        const int oc = u & 127, h = (u >> 7) & 3, b = u >> 9;
        const int row0 = (b << 14) + oc * 128;
        __syncthreads();
        {
            const int ch = tid & 15, rb = tid >> 4; u32x4 kr[4], vr[4];
#pragma unroll
            for (int k = 0; k < 4; ++k) { const size_t o = (size_t)(row0 + rb + 32 * k) * 512 + h * 128 + ch * 8; kr[k] = *(const u32x4*)(KB + o); vr[k] = *(const u32x4*)(VB + o); }
#pragma unroll
            for (int k = 0; k < 4; ++k) { *(LAS u32x4*)(Kt + (rb + 32 * k) * TPI + ch * 16) = kr[k]; *(LAS u32x4*)(Vt + (rb + 32 * k) * TPI + ch * 16) = vr[k]; }
        }
        bf16x8 qf[4];
#pragma unroll
        for (int ks = 0; ks < 4; ++ks) qf[ks] = *(const bf16x8*)(QB + (size_t)(row0 + t) * 512 + h * 128 + 32 * ks + 8 * g);
        f32x4 hsum[8];
#pragma unroll
        for (int vt = 0; vt < 8; ++vt) hsum[vt] = (f32x4){0.f, 0.f, 0.f, 0.f};
#pragma unroll 1
        for (int d = 0; d < 2; ++d) {
            const int j = d ? 129 - oc : oc + 2, slot = ((b * 4 + h) * 2 + d) * 130 + j;
            if (d == 1) __syncthreads();
            ml_load_tile2(Ct, CL + (size_t)slot * 16384, 128, nullptr, tid);
            if (tid < 128) { const float* vp = VEC + (size_t)slot * 512; vz[tid] = vp[tid]; vb[tid] = vp[128 + tid]; vcm[tid] = vp[256 + tid]; vn[tid] = NL[(size_t)slot * 128 + tid]; }
            const float mprev = VEC[(size_t)slot * 512 + 386];
            __syncthreads();
            const float ut = -fmaxf(mprev, vcm[t]), winter = __expf(mprev + ut), flo = __expf(ut - vb[t]);
            float nq = 0.f;
#pragma unroll
            for (int ks = 0; ks < 4; ++ks) { const u32x4 qw = __builtin_bit_cast(u32x4, qf[ks]); const f32x4 n0 = *(const LAS f32x4*)(vn + 32 * ks + 8 * g), n1 = *(const LAS f32x4*)(vn + 32 * ks + 8 * g + 4);
                nq += bflo(qw[0]) * n0[0] + bfhi(qw[0]) * n0[1] + bflo(qw[1]) * n0[2] + bfhi(qw[1]) * n0[3] + bflo(qw[2]) * n1[0] + bfhi(qw[2]) * n1[1] + bflo(qw[3]) * n1[2] + bfhi(qw[3]) * n1[3]; }
            nq += __shfl_xor(nq, 16); nq += __shfl_xor(nq, 32);
            f32x4 hacc[8];
#pragma unroll
            for (int vt = 0; vt < 8; ++vt) { f32x4 acc = {0.f, 0.f, 0.f, 0.f};
#pragma unroll
                for (int ks = 0; ks < 4; ++ks) acc = mfma16(*(const LAS bf16x8*)(Ct + (16 * vt + c) * TPI + (32 * ks + 8 * g) * 2), qf[ks], acc);
                hacc[vt] = acc * winter; }
            float rs = 0.f;
            bf16x8 pf[4];
#pragma unroll
            for (int kp = 0; kp < 4; ++kp) {
                f32x4 sa[2];
#pragma unroll
                for (int hh = 0; hh < 2; ++hh) { const int st = 2 * kp + hh; const bool active = d ? (st >= w) : (st <= w);
                    f32x4 acc = {0.f, 0.f, 0.f, 0.f};
                    if (active) {
#pragma unroll
                        for (int ks = 0; ks < 4; ++ks) acc = mfma16(*(const LAS bf16x8*)(Kt + (16 * st + c) * TPI + (32 * ks + 8 * g) * 2), qf[ks], acc);
                        const f32x4 zz = *(const LAS f32x4*)(vz + 16 * st + 4 * g);
#pragma unroll
                        for (int jj = 0; jj < 4; ++jj) { const int s = 16 * st + 4 * g + jj; const bool ok = d ? (s >= t) : (s <= t);
                            const float wgt = ok ? __expf(ut + zz[jj]) : 0.f; acc[jj] *= wgt; rs += acc[jj]; }
                    }
                    sa[hh] = acc; }
                pf[kp] = pk8(sa[0], sa[1]);
            }
            rs += __shfl_xor(rs, 16); rs += __shfl_xor(rs, 32);
#pragma unroll
            for (int kp = 0; kp < 4; ++kp) { const bool active = d ? (2 * kp + 1 >= w) : (2 * kp <= w);
                if (active) { LAS unsigned char* vbp = Vt + (32 * kp + 4 * g + qq) * TPI + 8 * pp;
#pragma unroll
                    for (int vt = 0; vt < 8; ++vt) { const s16x4 lo = ds_tr(vbp + vt * 32), hi = ds_tr(vbp + 16 * TPI + vt * 32); hacc[vt] = mfma16(cat8(lo, hi), pf[kp], hacc[vt]); } } }
            const float den = winter * nq + rs, dd = 1.0f / fmaxf(fabsf(den), flo);
#pragma unroll
            for (int vt = 0; vt < 8; ++vt) hsum[vt] += hacc[vt] * dd;
        }
        float ss = 0.f;
#pragma unroll
        for (int vt = 0; vt < 8; ++vt) ss += hsum[vt][0] * hsum[vt][0] + hsum[vt][1] * hsum[vt][1] + hsum[vt][2] * hsum[vt][2] + hsum[vt][3] * hsum[vt][3];
        ss += __shfl_xor(ss, 16); ss += __shfl_xor(ss, 32);
        const float rstd = rsqrtf(ss * (1.0f / 128.0f) + 1e-6f);
        const int row = row0 + t;
        u32x2 owv[8]; f32x4 hgv[8];
#pragma unroll
        for (int vt = 0; vt < 8; ++vt) { const int v0 = 16 * vt + 4 * g; owv[vt] = *(const u32x2*)(OB + (size_t)row * 512 + h * 128 + v0); hgv[vt] = *(const f32x4*)(p.ml_head_g + h * 128 + v0); }
#pragma unroll
        for (int vt = 0; vt < 8; ++vt) { const int v0 = 16 * vt + 4 * g;
            const u32x2 ow = owv[vt]; const f32x4 hg = hgv[vt];
            const float y0 = hsum[vt][0] * rstd * hg[0] * sigmoid_f(bflo(ow.x)), y1 = hsum[vt][1] * rstd * hg[1] * sigmoid_f(bfhi(ow.x));
            const float y2 = hsum[vt][2] * rstd * hg[2] * sigmoid_f(bflo(ow.y)), y3 = hsum[vt][3] * rstd * hg[3] * sigmoid_f(bfhi(ow.y));
            u32x2 wv; wv.x = cvt_pk_bf16(y0, y1); wv.y = cvt_pk_bf16(y2, y3); *(u32x2*)(Y + (size_t)row * 1024 + 512 + h * 128 + v0) = wv; }
    }
}

__device__ void ph_sg(const P& p, LAS unsigned char* lds) {
    bf16_t* U = (bf16_t*)(p.ws + WS_R); const bf16_t* V = U + (size_t)T * 2048; const float* ST = (const float*)(p.ws + WS_ST);
    constexpr int VP = 560;
    LAS unsigned char* Vn = lds; LAS unsigned char* Wt = lds + 128 * VP;
    const int tid = TIDX, lane = tid & 63, w = __builtin_amdgcn_readfirstlane(tid >> 6), c = lane & 15, g = lane >> 4, qq = (lane & 15) >> 2, pp = lane & 3;
    const int c8 = tid & 31, rb = tid >> 5;
    int last_gg = -1;
    f32x4 g0, g1, b0, b1; bf16x8 bw[4]; float bs = 0.f;
    u32x4 vr[8]; f32x2 st[8];
#define SG_PREFETCH(uu) { const int gg_ = (uu) & 7, row0_ = ((uu) >> 3) * 128; \
        _Pragma("unroll") for (int k = 0; k < 8; ++k) { const int r = rb + 16 * k; vr[k] = *(const u32x4*)(V + (size_t)(row0_ + r) * 2048 + gg_ * 256 + c8 * 8); st[k] = *(const f32x2*)(ST + 2 * (row0_ + r)); } }
    int u = blockIdx.x;
    if (u < 2048) SG_PREFETCH(u)
    while (u < 2048) {
        const int gg = u & 7, ch = u >> 3, row0 = ch * 128;
        if (gg != last_gg) { const int cbase = gg * 256 + c8 * 8;
            g0 = *(const f32x4*)(p.sg_ln_g + cbase); g1 = *(const f32x4*)(p.sg_ln_g + cbase + 4); b0 = *(const f32x4*)(p.sg_ln_b + cbase); b1 = *(const f32x4*)(p.sg_ln_b + cbase + 4); }
        __syncthreads();
#pragma unroll
        for (int k = 0; k < 8; ++k) { const int r = rb + 16 * k; const u32x4 wv = vr[k]; const float mu = st[k][0] * (1.0f / 2048.0f), rs = rsqrtf(fmaxf(st[k][1] * (1.0f / 2048.0f) - mu * mu, 0.f) + 1e-6f);
            u32x4 o;
            o[0] = cvt_pk_bf16((bflo(wv[0]) - mu) * rs * g0[0] + b0[0], (bfhi(wv[0]) - mu) * rs * g0[1] + b0[1]);
            o[1] = cvt_pk_bf16((bflo(wv[1]) - mu) * rs * g0[2] + b0[2], (bfhi(wv[1]) - mu) * rs * g0[3] + b0[3]);
            o[2] = cvt_pk_bf16((bflo(wv[2]) - mu) * rs * g1[0] + b1[0], (bfhi(wv[2]) - mu) * rs * g1[1] + b1[1]);
            o[3] = cvt_pk_bf16((bflo(wv[3]) - mu) * rs * g1[2] + b1[2], (bfhi(wv[3]) - mu) * rs * g1[3] + b1[3]);
            *(LAS u32x4*)(Vn + r * VP + c8 * 16) = o; }
        if (gg != last_gg) {
            for (int i = tid; i < 128 * 32; i += NTHR) { const int r = i >> 5, c4 = i & 31; const f32x4 wv = *(const f32x4*)(p.sg_w_s + (size_t)gg * 16384 + r * 128 + c4 * 4);
                u32x2 o; o.x = cvt_pk_bf16(wv[0], wv[1]); o.y = cvt_pk_bf16(wv[2], wv[3]); *(LAS u32x2*)(Wt + r * TPI + c4 * 8) = o; } }
        __syncthreads();
        const int tt = 16 * w + c;
        if (gg != last_gg) {
#pragma unroll
            for (int ks = 0; ks < 4; ++ks) bw[ks] = *(const LAS bf16x8*)(Wt + (16 * w + c) * TPI + (32 * ks + 8 * g) * 2);
            bs = p.sg_b_s[gg * 128 + tt]; last_gg = gg; }
        bf16_t* up = U + (size_t)(row0 + tt) * 2048 + gg * 256 + 8 * g;
        u32x4 uw[8];
#pragma unroll
        for (int q = 0; q < 8; ++q) uw[q] = *(const u32x4*)(up + 32 * q);
        const int un = u + gridDim.x;
        if (un < 2048) SG_PREFETCH(un)
#pragma unroll
        for (int q = 0; q < 8; ++q) { u32x4 o;
#pragma unroll
            for (int hd = 0; hd < 2; ++hd) { f32x4 acc = {0.f, 0.f, 0.f, 0.f};
#pragma unroll
                for (int ks = 0; ks < 4; ++ks) { LAS unsigned char* a = Vn + (32 * ks + 8 * g + qq) * VP + (32 * q + 8 * pp + 4 * hd) * 2; acc = mfma16(cat8(ds_tr(a), ds_tr(a + 4 * VP)), bw[ks], acc); }
                o[2 * hd] = cvt_pk_bf16(bflo(uw[q][2 * hd]) * (acc[0] + bs), bfhi(uw[q][2 * hd]) * (acc[1] + bs));
                o[2 * hd + 1] = cvt_pk_bf16(bflo(uw[q][2 * hd + 1]) * (acc[2] + bs), bfhi(uw[q][2 * hd + 1]) * (acc[3] + bs)); }
            *(u32x4*)(up + 32 * q) = o; }
        u = un;
    }
#undef SG_PREFETCH
}

#define XB_TMO      128
#define XB_XCNT(j)  (256  + 64 * (j))
#define XB_XSUB(j)  (1280 + 64 * (j))
#define XB_XGEN(j)  (2304 + 64 * (j))
#define XB_TOP      3328
#define XB_TOPGEN   3392
#define XCD_BAR_WORDS 3456
#define XB_SPIN_CAP (1u << 18)

__device__ __forceinline__ unsigned xb_ld(unsigned* p)              { return __hip_atomic_load(p, __ATOMIC_RELAXED, __HIP_MEMORY_SCOPE_AGENT); }
__device__ __forceinline__ unsigned xb_add(unsigned* p, unsigned v) { return __hip_atomic_fetch_add(p, v, __ATOMIC_RELAXED, __HIP_MEMORY_SCOPE_AGENT); }
__device__ __forceinline__ unsigned xb_xcc_id() { return (unsigned)__builtin_amdgcn_s_getreg((3 << 11) | 20) & 0xFu; }
#define XB_SPIN(cond, bar) do { unsigned _sp = 0; while (cond) { __builtin_amdgcn_s_sleep(1); \
    if ((++_sp & 255u) == 0u) { if (xb_ld(&(bar)[XB_TMO])) break; if (_sp > XB_SPIN_CAP) { atomicAdd(&(bar)[XB_TMO], 1u); break; } } } } while (0)

struct XcdBarrier {
    unsigned* bar; unsigned x;
    volatile LAS unsigned* st;
};

__device__ __forceinline__ XcdBarrier xcd_barrier_post(unsigned* bar, volatile LAS unsigned* st) {
    XcdBarrier b; b.bar = bar; b.x = xb_xcc_id(); b.st = st;
    if (threadIdx.x == 0) (void)xb_add(&bar[XB_XCNT(b.x)], 1u);
    return b;
}
__device__ __forceinline__ void xcd_barrier_complete(unsigned* bar, unsigned x, unsigned& nloc, unsigned& nx) {
    const unsigned G = gridDim.x * gridDim.y * gridDim.z;
    unsigned sum, cnt, mine, sp = 0u;
    for (;;) {
        sum = 0u; cnt = 0u; mine = 0u;
#pragma unroll
        for (unsigned j = 0; j < 16; ++j) { const unsigned c = xb_ld(&bar[XB_XCNT(j)]); sum += c; cnt += (c > 0u) ? 1u : 0u; mine = (j == x) ? c : mine; }
        if (sum == G) break;
        __builtin_amdgcn_s_sleep(1);
        if ((++sp & 255u) == 0u) { if (xb_ld(&bar[XB_TMO])) break; if (sp > XB_SPIN_CAP) { atomicAdd(&bar[XB_TMO], 1u); break; } }
    }
    nloc = mine > 0u ? mine : 1u; nx = cnt > 0u ? cnt : 1u;
}

__device__ __forceinline__ void xcd_barrier(const XcdBarrier& b) {
    asm volatile("s_waitcnt vmcnt(0)" ::: "memory");
    __syncthreads();
    if (threadIdx.x == 0) {
        unsigned* bar = b.bar;
        __builtin_amdgcn_s_waitcnt(0);
        unsigned nloc = b.st[0], nx = b.st[1];
        if (nloc == 0u) { xcd_barrier_complete(bar, b.x, nloc, nx); b.st[0] = nloc; b.st[1] = nx; }
        const unsigned old = xb_add(&bar[XB_XSUB(b.x)], 1u);
        const unsigned gen = old / nloc;
        if (old + 1u == (gen + 1u) * nloc) {
            __builtin_amdgcn_fence(__ATOMIC_RELEASE, "agent");
            asm volatile("s_waitcnt vmcnt(0)" ::: "memory");
            const unsigned og = xb_add(&bar[XB_TOP], 1u);
            const unsigned tg = og / nx;
            if (og + 1u == (tg + 1u) * nx) xb_add(&bar[XB_TOPGEN], 1u);
            else XB_SPIN(xb_ld(&bar[XB_TOPGEN]) == tg, bar);
            __builtin_amdgcn_fence(__ATOMIC_ACQUIRE, "agent");
            xb_add(&bar[XB_XGEN(b.x)], 1u);
            asm volatile("s_waitcnt vmcnt(0)" ::: "memory");
        } else {
            XB_SPIN(xb_ld(&bar[XB_XGEN(b.x)]) == gen, bar);
            __builtin_amdgcn_fence(__ATOMIC_ACQUIRE, "agent");
            asm volatile("s_waitcnt vmcnt(0)" ::: "memory");
        }
    }
    __syncthreads();
}


constexpr int NPHASE = 25;
constexpr int CONV_L1_EARLY = 1144;
#ifndef PH_EN
#define PH_EN 0xFFFFFFFFu
#endif
#define EN(k) (((PH_EN) >> (k)) & 1u)
__device__ __forceinline__ void run_phase(const P& p, int ph_in, bool second, LAS unsigned char* lds) {
    const int G = gridDim.x, c = blockIdx.x;
    const bool ctx_units = (ph_in == 4) && !second && (c < 8);
    const int ph = ctx_units ? 3 : ph_in;
    unsigned char* ws = p.ws;
    const float* mod = (const float*)(ws + WS_MOD);
    bf16_t* Wb = (bf16_t*)(ws + WS_W); bf16_t* R = (bf16_t*)(ws + WS_R); bf16_t* H = (bf16_t*)(ws + WS_H); float* XC = (float*)(ws + WS_XC);
    pg8::StaticOrder S;
    if (!((PH_EN >> ph_in) & 1u)) return;
    switch (ph) {
    case 0: if (EN(0)) { ph_prep(p, lds); ph_convert(p, lds, 0, c, G, 0, 2720); ph_convert(p, lds, 1, c, G, 0, CONV_L1_EARLY); } break;
    case 1: case 4: case 10: case 13: case 16: case 21: if (EN(1)) {
        const int l = ph >= 13, sub = (ph == 1 || ph == 13) ? 0 : ((ph == 4 || ph == 16) ? 1 : 2);
        const float* xl = (ph == 1) ? p.x : p.out; const float* xc = (ph == 1) ? p.ctx : XC;
        if (ph == 1) ph_norm(p, xl, xc, 0, TP, 0, G, p.norm_g + (l * 3 + sub) * 1024, mod + (size_t)l * 3 * 9216, sub, H);
        else if (ph == 4 && !second) { ph_norm(p, xl, xc, 0, T, 8, G - 8, p.norm_g + (l * 3 + sub) * 1024, mod + (size_t)l * 3 * 9216, sub, H);
            ph_convert(p, lds, 1, c - 8, G - 8, CONV_L1_EARLY, 2880); }
        else if (ph == 4) ph_norm(p, xl, xc, T, TP, 0, G, p.norm_g + (l * 3 + sub) * 1024, mod + (size_t)l * 3 * 9216, sub, H);
        else ph_norm(p, xl, xc, 0, T, 0, G, p.norm_g + (l * 3 + sub) * 1024, mod + (size_t)l * 3 * 9216, sub, H); } break;
    case 2: case 11: case 14: case 22: if (EN(2)) {
        const int l = ph >= 13, s = (ph == 11 || ph == 22), M = (ph == 2) ? TP : T;
        pg8::Gemm g{H, Wb + W_FFN_IN + (size_t)(l * 2 + s) * 5632 * 1024, M, 5632, 1024, 0, 0}; S.init(M, 5632, G, c); EpiSwiglu E{R}; pg8::gemm_phase(lds, g, S, E); } break;
    case 3: case 12: case 15: case 23: case 9: case 20: if (EN(3)) {
        const int l = ph >= 13; pg8::Gemm g; float coef; int sub;
        if (ph == 9) { g = pg8::Gemm{H, Wb + W_MIXOUT, T, 1024, 1024, 0, 0}; coef = 1.0f; sub = 1; }
        else if (ph == 20) { g = pg8::Gemm{R, Wb + W_SGOUT, T, 1024, 2048, 0, 0}; coef = 1.0f; sub = 1; }
        else { const int s = (ph == 12 || ph == 23); g = pg8::Gemm{R, Wb + W_FFN_OUT + (size_t)(l * 2 + s) * 1024 * 2816, ctx_units ? TP : T, 1024, 2816, 1, 1}; coef = 0.5f; sub = s ? 2 : 0; }
        S.init(g.M, 1024, G, c);
        if (ctx_units) { S.fpm = T / 256 + (c >> 2); S.fpn = c & 3; }
        S.rev = REV_PANELS;
        EpiResid E{(ph == 3) ? p.x : p.out, (ph == 3) ? p.ctx : XC, p.out, XC, mod + (size_t)l * 3 * 9216 + (sub * 3 + 2) * 1024, coef}; pg8::gemm_phase(lds, g, S, E); } break;
    case 5: if (EN(5)) { pg8::Gemm g{H, Wb + W_MIXIN, TP, 3840, 1024, 0, 0}; S.init(TP, 3840, G, c);
        EpiProj E{R, (float*)(R + (size_t)7 * TP * 512), (const float2*)(ws + WS_ROPE), p.ml_gate_b}; pg8::gemm_phase(lds, g, S, E); } break;
    case 6:
#if NAIVE_NA
        if (EN(6)) ph_na_naive(p);
#else
        if (EN(6)) ph_na2(p, lds);
#endif
        __syncthreads();
#if NAIVE_MLA
        if (EN(26)) ph_mlA_naive(p, lds);
#else
        if (EN(26)) ph_mlA(p, lds);
#endif
        break;
    case 7: if (EN(7)) ph_mlB(p, lds); break;
    case 8:
#if NAIVE_MLC
        if (EN(8)) ph_mlC_naive(p, lds);
#else
        if (EN(8)) ph_mlC(p, lds);
#endif
        break;
    case 17: if (EN(17)) { pg8::Gemm g{H, Wb + W_SGIN, T, 4096, 1024, 0, 0}; S.init(T, 4096, G, c); EpiGeluUV E{R, (float*)(ws + WS_ST)}; pg8::gemm_phase(lds, g, S, E); } break;
    case 18: if (EN(18)) ph_sg_stats(p); break;
    case 19:
#if NAIVE_SG
        if (EN(19)) ph_sg_naive(p, lds);
#else
        if (EN(19)) ph_sg(p, lds);
#endif
        break;
    case 24: if (EN(24)) ph_final_norm(p); break;
    }
}

__global__ void __launch_bounds__(NTHR, 2) fwd_kernel(P p) {
    extern __shared__ __attribute__((aligned(16))) unsigned char lds_raw[];
    LAS unsigned char* lds = (LAS unsigned char*)lds_raw;
#if MULTI_LAUNCH
    run_phase(p, p.ph_lo, false, lds);
#else
    cg::grid_group grid = cg::this_grid();
    volatile LAS unsigned* bar_st = (volatile LAS unsigned*)(lds + (LDS_BYTES - 16));
    if (threadIdx.x < 4) bar_st[threadIdx.x] = 0u;
    __syncthreads();
    (void)xcd_barrier_post((unsigned*)(p.ws + WS_BAR), bar_st);
    for (int it = 2 * p.ph_lo; it < 2 * p.ph_hi; ++it) {
        const int ph = it >> 1;
        if (ph == 18) continue;
        if ((it & 1) && ph != 4 && !((DBL_MASK >> ph) & 1u)) continue;
        if (it > 2 * p.ph_lo) {
            if (it == 2 * p.ph_lo + 2) grid.sync();
            else { XcdBarrier xb; xb.bar = (unsigned*)(p.ws + WS_BAR); xb.x = xb_xcc_id(); xb.st = bar_st; xcd_barrier(xb); }
        }
        run_phase(p, ph, (it & 1) != 0, lds);
    }
#endif
}

extern "C" void kernel_launch(void* const* d_in, const int* in_sizes, int n_in, void* d_out, int out_size, void* d_ws, size_t ws_size, hipStream_t stream) {
    static int grid = 0;
    if (grid == 0) {
        if (ws_size < WS_END) { fprintf(stderr, "kernel_launch: workspace too small: %zu < %zu\n", ws_size, (size_t)WS_END); grid = -1; return; }
        int dev = 0, cus = 0, per_cu = 0;
        (void)hipGetDevice(&dev); (void)hipDeviceGetAttribute(&cus, hipDeviceAttributeMultiprocessorCount, dev);
        if (hipFuncSetAttribute((const void*)fwd_kernel, hipFuncAttributeMaxDynamicSharedMemorySize, LDS_BYTES) != hipSuccess) { fprintf(stderr, "kernel_launch: hipFuncSetAttribute failed\n"); grid = -1; return; }
        if (hipOccupancyMaxActiveBlocksPerMultiprocessor(&per_cu, (const void*)fwd_kernel, NTHR, LDS_BYTES) != hipSuccess || per_cu < 1) { fprintf(stderr, "kernel_launch: occupancy query gave %d\n", per_cu); per_cu = 1; }
        (void)hipGetLastError();
        grid = cus * 1;
    }
    if (grid < 0) return;
    (void)hipMemsetAsync((char*)d_ws + WS_MOD, 0, WS_ZERO_END, stream);
    P p{};
    const float** pp = (const float**)&p;
    for (int i = 0; i < 21; ++i) pp[i] = (const float*)d_in[i];
    p.out = (float*)d_out; p.ws = (unsigned char*)d_ws;
#if MULTI_LAUNCH
    for (int ph = 0; ph < NPHASE; ++ph) { p.ph_lo = ph; p.ph_hi = ph + 1; hipLaunchKernelGGL(fwd_kernel, dim3(grid), dim3(NTHR), LDS_BYTES, stream, p); }
#else
    p.ph_lo = 0; p.ph_hi = NPHASE;
    void* args[] = {&p};
    hipError_t e = hipLaunchCooperativeKernel((const void*)fwd_kernel, dim3(grid), dim3(NTHR), args, LDS_BYTES, stream);
    if (e != hipSuccess) fprintf(stderr, "cooperative launch failed: %s (grid %d)\n", hipGetErrorString(e), grid);
#endif
}
```

```cpp
#include <hip/hip_runtime.h>
#include <hip/hip_cooperative_groups.h>
#include <cstdio>
namespace cg = cooperative_groups;

#ifndef NAIVE_NA
#define NAIVE_NA 0
#endif
#ifndef NAIVE_MLA
#define NAIVE_MLA 0
#endif
#ifndef NAIVE_MLC
#define NAIVE_MLC 0
#endif
#ifndef NAIVE_SG
#define NAIVE_SG 0
#endif
#ifndef DBL_MASK
#define DBL_MASK 0u
#endif
#ifndef REV_PANELS
#define REV_PANELS 1
#endif
#ifndef MULTI_LAUNCH
#define MULTI_LAUNCH 0
#endif

#define LAS __attribute__((address_space(3)))
typedef unsigned short bf16_t;
typedef short bf16x8 __attribute__((ext_vector_type(8)));
typedef float f32x4 __attribute__((ext_vector_type(4)));
typedef float f32x2 __attribute__((ext_vector_type(2)));
typedef unsigned u32x4 __attribute__((ext_vector_type(4)));
typedef unsigned u32x2 __attribute__((ext_vector_type(2)));

constexpr int T = 32768, TC = 512, TP = T + TC, D = 1024, DFF = 2816, NSEQ = 16384;
constexpr int NTHR = 512;
constexpr int LDS_BYTES = 147456;
constexpr int NSLOT = 2 * 4 * 2 * 130;
constexpr int PITCH = 272;

constexpr size_t WS_MOD = 0;
constexpr size_t WS_BAR = 229376;
constexpr size_t WS_ST = 243712;
constexpr size_t WS_ZERO_END = WS_ST + (size_t)T * 8;
constexpr size_t WS_ROPE = WS_ZERO_END + 256;
constexpr size_t WS_W = WS_ROPE + 65536;
constexpr size_t W_FFN_IN = 0, W_FFN_OUT = W_FFN_IN + 4ull * 5632 * 1024, W_MIXIN = W_FFN_OUT + 4ull * 1024 * 2816,
                 W_MIXOUT = W_MIXIN + 3840ull * 1024, W_SGIN = W_MIXOUT + 1024ull * 1024, W_SGOUT = W_SGIN + 4096ull * 1024,
                 W_END = W_SGOUT + 1024ull * 2048;
constexpr size_t WS_R = WS_W + W_END * 2;
constexpr size_t WS_H = WS_R + 268435456ull;
constexpr size_t WS_CL = WS_H + (size_t)TP * 1024 * 2;
constexpr size_t WS_XC = WS_CL + (size_t)NSLOT * 32768;
constexpr size_t WS_VEC = WS_XC + (size_t)TC * 1024 * 4;
constexpr size_t WS_NL = WS_VEC + (size_t)NSLOT * 2048;
constexpr size_t WS_END = WS_NL + (size_t)NSLOT * 512;

struct P {
    const float *x, *c, *ctx, *c_ctx, *w_mod, *b_mod, *norm_g, *ffn_w_in, *ffn_w_out, *mix_w_in, *na_rpb, *ml_gate_b, *ml_head_g,
        *mix_w_out, *sg_w_in, *sg_ln_g, *sg_ln_b, *sg_w_s, *sg_b_s, *sg_w_out, *final_g;
    float* out; unsigned char* ws; int ph_lo, ph_hi;
};

__device__ __forceinline__ int opaque_tid() { int t = threadIdx.x; asm volatile("" : "+v"(t)); return t; }
#define TIDX (opaque_tid())
__device__ __forceinline__ float bf2f(bf16_t v) { return __uint_as_float(((unsigned)v) << 16); }
__device__ __forceinline__ float bflo(unsigned u) { return __uint_as_float(u << 16); }
__device__ __forceinline__ float bfhi(unsigned u) { return __uint_as_float(u & 0xffff0000u); }
typedef __bf16 bf16v2_t __attribute__((ext_vector_type(2)));
__device__ __forceinline__ unsigned cvt_pk_bf16(float lo, float hi) { const f32x2 v = {lo, hi}; return __builtin_bit_cast(unsigned, __builtin_convertvector(v, bf16v2_t)); }
__device__ __forceinline__ bf16_t f2bf(float f) { return (bf16_t)(cvt_pk_bf16(f, 0.f) & 0xffffu); }
__device__ __forceinline__ float fexp(float v) { return __builtin_amdgcn_exp2f(v * 1.4426950408889634f); }
__device__ __forceinline__ float silu_f(float v) { return v * __builtin_amdgcn_rcpf(1.0f + fexp(-v)); }
__device__ __forceinline__ float sigmoid_f(float v) { return __builtin_amdgcn_rcpf(1.0f + fexp(-v)); }
__device__ __forceinline__ float gelu_tanh(float v) { const float e = __builtin_amdgcn_exp2f(v * (-0.10294324f * (v * v) - 2.3022082f)); return v * __builtin_amdgcn_rcpf(1.0f + e); }
__device__ __forceinline__ float log_sigmoid_f(float v) { return fminf(v, 0.f) - log1pf(__expf(-fabsf(v))); }

namespace pg8 {
constexpr int BM = 256, BK = 64, HALF = 128, HTB = HALF * BK * 2, STAGE_BYTES = 8 * HTB, NXCD = 8, WGM = 8;
__device__ __forceinline__ int lds_byte(int r, int c) { const int st = (r >> 4) * 2 + (c >> 5), rr = r & 15, cc = c & 31, ob = rr * 64 + cc * 2; return st * 1024 + (ob ^ (((ob >> 9) & 1) << 5)); }
__device__ __forceinline__ void stage_rc(int b, int& R, int& C) { const int st = b / 1024, sb = b % 1024, swz = sb ^ (((sb >> 9) & 1) << 5); R = (st >> 1) * 16 + swz / 64; C = (st & 1) * 32 + (swz % 64) / 2; }
struct Unit { int pm, pn; };
struct Gemm { const bf16_t* A; const bf16_t* Bt; int M, N, K; int tiledA, tiledB; };
struct StaticOrder {
    int nM, nN, nwg, G, c, fpm, fpn, rev;
    __device__ void init(int M, int N, int G_, int c_) { nM = M / BM; nN = N / BM; nwg = nM * nN; G = G_; c = c_; fpm = -1; fpn = 0; rev = 0; }
    __device__ bool next(int i, Unit& u) const {
        if (fpm >= 0) { if (i > 0) return false; u.pm = fpm; u.pn = fpn; return true; }
        const long L = (long)i * G + c; if (L >= nwg) return false;
        int wgid = (int)L; { const int q = nwg / NXCD, r = nwg % NXCD, xcd = wgid % NXCD, off = wgid / NXCD; wgid = (xcd < r ? xcd * (q + 1) : r * (q + 1) + (xcd - r) * q) + off; }
        const int nig = WGM * nN, gid = wgid / nig, fm = gid * WGM, gsz = (nM - fm) < WGM ? (nM - fm) : WGM;
        u.pm = fm + ((wgid % nig) % gsz); u.pn = (wgid % nig) / gsz; if (rev) u.pm = nM - 1 - u.pm; return true;
    }
};

#ifndef PG8_SP2
#define PG8_SP2 true
#endif
#ifndef PG8_ALIGN
#define PG8_ALIGN true
#endif
template <class Epi, bool ALIGN_EPI = PG8_ALIGN, bool SP2 = PG8_SP2>
__device__ __forceinline__ void gemm_phase(LAS unsigned char* lds, const Gemm g, const StaticOrder& S, const Epi& E) {
    const int tid = TIDX, wid = __builtin_amdgcn_readfirstlane(tid >> 6), lane = tid & 63, wr = wid >> 2, wc = wid & 3, fr = lane & 15, fq = lane >> 4;
    const int K = g.K, nt = K / BK;
    unsigned voffA[2], voffB[2];
#pragma unroll
    for (int i = 0; i < 2; ++i) { int R, C; stage_rc(tid * 16 + i * 8192, R, C); voffA[i] = (unsigned)(R * (g.tiledA ? BK : K) + C) * 2u; voffB[i] = (unsigned)(R * (g.tiledB ? BK : K) + C) * 2u; }
    const size_t kstepA = g.tiledA ? (size_t)(2 * HTB) : (size_t)(BK * 2), kstepB = g.tiledB ? (size_t)(2 * HTB) : (size_t)(BK * 2);
    const size_t hstepA = g.tiledA ? (size_t)HTB : (size_t)HALF * K * 2, hstepB = g.tiledB ? (size_t)HTB : (size_t)HALF * K * 2;
    const size_t tstepA = (size_t)BM * K * 2, tstepB = (size_t)BM * K * 2;
    const unsigned ldsw = (unsigned)wid * 1024u;
    const int aoff = lds_byte(wr * 64 + fr, fq * 8), boff = lds_byte(wc * 32 + fr, fq * 8);
#define PG8_SA(b, h) (((b) * 2 + (h)) * HTB)
#define PG8_SB(b, h) ((4 + (b) * 2 + (h)) * HTB)
#define PG8_STAGE(bufoff, gbase, voff) do { _Pragma("unroll") for (int _i = 0; _i < 2; ++_i) \
        __builtin_amdgcn_global_load_lds((const unsigned*)((const char*)(gbase) + (voff)[_i]), (LAS unsigned*)(lds + (bufoff) + ldsw + _i * 8192), 16, 0, 0); } while (0)
#define PG8_LDA(dst, b, h) do { _Pragma("unroll") for (int m = 0; m < 4; ++m) _Pragma("unroll") for (int k = 0; k < 2; ++k) dst[m][k] = *(const LAS bf16x8*)(lds + PG8_SA(b, h) + aoff + m * 2048 + k * 1024); } while (0)
#define PG8_LDB(dst, b, h) do { _Pragma("unroll") for (int n = 0; n < 2; ++n) _Pragma("unroll") for (int k = 0; k < 2; ++k) dst[n][k] = *(const LAS bf16x8*)(lds + PG8_SB(b, h) + boff + n * 2048 + k * 1024); } while (0)
#define PG8_MMA(ai, bj, At, Bt) do { __builtin_amdgcn_s_setprio(1); _Pragma("unroll") for (int m = 0; m < 4; ++m) _Pragma("unroll") for (int n = 0; n < 2; ++n) _Pragma("unroll") for (int k = 0; k < 2; ++k) \
        acc[ai][bj][m][n] = __builtin_amdgcn_mfma_f32_16x16x32_bf16(Bt[n][k], At[m][k], acc[ai][bj][m][n], 0, 0, 0); __builtin_amdgcn_s_setprio(0); } while (0)
#define PG8_WAIT_V(n) asm volatile("s_waitcnt vmcnt(" #n ")" ::: "memory")
#define PG8_WAIT_L(n) asm volatile("s_waitcnt lgkmcnt(" #n ")" ::: "memory")
#define PG8_BAR __builtin_amdgcn_s_barrier()
#define PG8_SCHED __builtin_amdgcn_sched_barrier(0)
    Unit cur, nxt; int ui = 0;
    if (!S.next(0, cur)) return;
    f32x4 acc[2][2][4][2];
#pragma unroll
    for (int a = 0; a < 2; ++a)
#pragma unroll
        for (int b = 0; b < 2; ++b)
#pragma unroll
            for (int m = 0; m < 4; ++m)
#pragma unroll
                for (int n = 0; n < 2; ++n) acc[a][b][m][n] = (f32x4){0.f, 0.f, 0.f, 0.f};
    bf16x8 At[4][2], B0[2][2], B1[2][2];
    const char* cA = (const char*)g.A + (size_t)cur.pm * tstepA; const char* cB = (const char*)g.Bt + (size_t)cur.pn * tstepB;
    if constexpr (SP2) {
        PG8_STAGE(PG8_SB(0, 0), cB, voffB); PG8_STAGE(PG8_SB(0, 1), cB + hstepB, voffB); PG8_STAGE(PG8_SA(0, 0), cA, voffA); PG8_STAGE(PG8_SA(0, 1), cA + hstepA, voffA);
        if (wr == 1) PG8_BAR;
        PG8_WAIT_V(2); PG8_BAR;
        PG8_STAGE(PG8_SB(1, 0), cB + kstepB, voffB); PG8_STAGE(PG8_SA(1, 0), cA + kstepA, voffA); PG8_STAGE(PG8_SB(1, 1), cB + hstepB + kstepB, voffB);
        PG8_WAIT_V(6); PG8_BAR;
    } else {
        PG8_STAGE(PG8_SB(0, 0), cB, voffB); PG8_STAGE(PG8_SA(0, 0), cA, voffA); PG8_STAGE(PG8_SB(0, 1), cB + hstepB, voffB); PG8_STAGE(PG8_SA(0, 1), cA + hstepA, voffA);
        if (wr == 1) PG8_BAR;
        PG8_WAIT_V(4); PG8_BAR;
        PG8_STAGE(PG8_SB(1, 0), cB + kstepB, voffB); PG8_STAGE(PG8_SA(1, 0), cA + kstepA, voffA); PG8_STAGE(PG8_SB(1, 1), cB + hstepB + kstepB, voffB);
        PG8_WAIT_V(6); PG8_BAR;
    }
    for (;;) {
        const bool has_next = S.next(ui + 1, nxt);
        const char* nA = has_next ? (const char*)g.A + (size_t)nxt.pm * tstepA : cA; const char* nB = has_next ? (const char*)g.Bt + (size_t)nxt.pn * tstepB : cB;
        for (int t = 0; t < nt; t += 2) {
            const bool last = (t == nt - 2);
            const char* a1 = cA + (size_t)(t + 1) * kstepA;
            const char* a2 = last ? nA : cA + (size_t)(t + 2) * kstepA; const char* b2 = last ? nB : cB + (size_t)(t + 2) * kstepB;
            const char* a3 = a2 + kstepA; const char* b3 = b2 + kstepB;
            if constexpr (SP2) {
            PG8_LDB(B0, 0, 0); PG8_LDB(B1, 0, 1); PG8_SCHED; PG8_LDA(At, 0, 0); PG8_STAGE(PG8_SA(1, 1), a1 + hstepA, voffA);
            PG8_WAIT_V(8); PG8_WAIT_L(0); PG8_BAR; PG8_MMA(0, 0, At, B0); PG8_MMA(0, 1, At, B1); PG8_BAR; PG8_SCHED;
            PG8_LDA(At, 0, 1); PG8_STAGE(PG8_SB(0, 0), b2, voffB); PG8_STAGE(PG8_SB(0, 1), b2 + hstepB, voffB); PG8_STAGE(PG8_SA(0, 0), a2, voffA);
            PG8_WAIT_V(8); PG8_WAIT_L(0); PG8_BAR; PG8_MMA(1, 0, At, B0); PG8_MMA(1, 1, At, B1); PG8_BAR; PG8_SCHED;
            PG8_LDB(B0, 1, 0); PG8_LDB(B1, 1, 1); PG8_SCHED; PG8_LDA(At, 1, 0); PG8_STAGE(PG8_SA(0, 1), a2 + hstepA, voffA);
            PG8_WAIT_V(8); PG8_WAIT_L(0); PG8_BAR; PG8_MMA(0, 0, At, B0); PG8_MMA(0, 1, At, B1); PG8_BAR; PG8_SCHED;
            PG8_LDA(At, 1, 1); PG8_STAGE(PG8_SB(1, 0), b3, voffB); PG8_STAGE(PG8_SB(1, 1), b3 + hstepB, voffB); PG8_STAGE(PG8_SA(1, 0), a3, voffA);
            PG8_WAIT_V(8); PG8_WAIT_L(0); PG8_BAR; PG8_MMA(1, 0, At, B0); PG8_MMA(1, 1, At, B1); PG8_BAR; PG8_SCHED;
            } else {
            PG8_LDB(B0, 0, 0); PG8_SCHED; PG8_LDA(At, 0, 0); PG8_STAGE(PG8_SA(1, 1), a1 + hstepA, voffA);
            PG8_WAIT_L(8); PG8_BAR; PG8_WAIT_L(0); PG8_MMA(0, 0, At, B0); PG8_BAR; PG8_SCHED;
            PG8_LDB(B1, 0, 1); PG8_STAGE(PG8_SB(0, 0), b2, voffB);
            PG8_BAR; PG8_WAIT_L(0); PG8_MMA(0, 1, At, B1); PG8_BAR;
            PG8_LDA(At, 0, 1); PG8_STAGE(PG8_SA(0, 0), a2, voffA);
            PG8_BAR; PG8_WAIT_L(0); PG8_MMA(1, 0, At, B0); PG8_BAR; PG8_SCHED;
            PG8_STAGE(PG8_SB(0, 1), b2 + hstepB, voffB);
            PG8_WAIT_V(6); PG8_BAR; PG8_MMA(1, 1, At, B1); PG8_BAR;
            PG8_LDB(B0, 1, 0); PG8_SCHED; PG8_LDA(At, 1, 0); PG8_STAGE(PG8_SA(0, 1), a2 + hstepA, voffA);
            PG8_WAIT_L(8); PG8_BAR; PG8_WAIT_L(0); PG8_MMA(0, 0, At, B0); PG8_BAR; PG8_SCHED;
            PG8_LDB(B1, 1, 1); PG8_STAGE(PG8_SB(1, 0), b3, voffB);
            PG8_BAR; PG8_WAIT_L(0); PG8_MMA(0, 1, At, B1); PG8_BAR;
            PG8_LDA(At, 1, 1); PG8_STAGE(PG8_SA(1, 0), a3, voffA);
            PG8_BAR; PG8_WAIT_L(0); PG8_MMA(1, 0, At, B0); PG8_BAR; PG8_SCHED;
            PG8_STAGE(PG8_SB(1, 1), b3 + hstepB, voffB);
            PG8_WAIT_V(6); PG8_BAR; PG8_MMA(1, 1, At, B1); PG8_BAR;
            }
        }
        if constexpr (ALIGN_EPI) { if (wr == 0) PG8_BAR; }
        E(acc, cur, wr, wc, fr, fq);
        if (!has_next) break;
#pragma unroll
        for (int a = 0; a < 2; ++a)
#pragma unroll
            for (int b = 0; b < 2; ++b)
#pragma unroll
                for (int m = 0; m < 4; ++m)
#pragma unroll
                    for (int n = 0; n < 2; ++n) acc[a][b][m][n] = (f32x4){0.f, 0.f, 0.f, 0.f};
        cur = nxt; cA = nA; cB = nB; ++ui;
        if constexpr (ALIGN_EPI) { if (wr == 1) PG8_BAR; }
    }
    PG8_WAIT_V(0);
    if constexpr (!ALIGN_EPI) { if (wr == 0) PG8_BAR; }
    PG8_BAR;
#undef PG8_SA
#undef PG8_SB
#undef PG8_STAGE
#undef PG8_LDA
#undef PG8_LDB
#undef PG8_MMA
#undef PG8_WAIT_V
#undef PG8_WAIT_L
#undef PG8_BAR
#undef PG8_SCHED
}
}

struct EpiSwiglu {
    bf16_t* hid;
    __device__ __forceinline__ void operator()(const f32x4 (&acc)[2][2][4][2], const pg8::Unit& u, int wr, int wc, int fr, int fq) const {
        const int row0 = u.pm * 256 + wr * 64 + fr, hc0 = u.pn * 128 + wc * 32 + 8 * fq;
#pragma unroll
        for (int ai = 0; ai < 2; ++ai)
#pragma unroll
            for (int m = 0; m < 4; ++m) { u32x4 w;
#pragma unroll
                for (int n = 0; n < 2; ++n) { const f32x4 a = acc[ai][0][m][n], b = acc[ai][1][m][n];
                    w[2 * n] = cvt_pk_bf16(silu_f(a[0]) * b[0], silu_f(a[1]) * b[1]); w[2 * n + 1] = cvt_pk_bf16(silu_f(a[2]) * b[2], silu_f(a[3]) * b[3]); }
                const int row = row0 + ai * 128 + m * 16;
                *(u32x4*)(hid + ((size_t)((row >> 8) * (DFF / 64) + (hc0 >> 6)) * 2 + ((row >> 7) & 1)) * 8192 + (row & 127) * 64 + (hc0 & 63)) = w; }
    }
};
struct EpiResid {
    const float* xin_lat; const float* xin_ctx; float* xout_lat; float* xout_ctx; const float* gate; float coef;
    __device__ __forceinline__ void operator()(const f32x4 (&acc)[2][2][4][2], const pg8::Unit& u, int wr, int wc, int fr, int fq) const {
        const int row0 = u.pm * 256 + wr * 64 + fr, col0 = u.pn * 256 + wc * 32 + 8 * fq;
        const bool isctx = u.pm >= T / 256; const int mb = isctx ? 2 : (u.pm >> 6);
        const float* xi = isctx ? xin_ctx - (size_t)T * D : xin_lat; float* xo = isctx ? xout_ctx - (size_t)T * D : xout_lat;
        const float* gp = gate + mb * 9216 + col0;
        f32x4 gv[2][2];
#pragma unroll
        for (int bj = 0; bj < 2; ++bj)
#pragma unroll
            for (int n = 0; n < 2; ++n) gv[bj][n] = *(const f32x4*)(gp + bj * 128 + n * 4) * coef;
#pragma unroll
        for (int ai = 0; ai < 2; ++ai) {
            f32x4 xv[4][2][2];
#pragma unroll
            for (int m = 0; m < 4; ++m)
#pragma unroll
                for (int bj = 0; bj < 2; ++bj)
#pragma unroll
                    for (int n = 0; n < 2; ++n) xv[m][bj][n] = *(const f32x4*)(xi + (size_t)(row0 + ai * 128 + m * 16) * D + col0 + bj * 128 + n * 4);
#pragma unroll
            for (int m = 0; m < 4; ++m)
#pragma unroll
                for (int bj = 0; bj < 2; ++bj)
#pragma unroll
                    for (int n = 0; n < 2; ++n) *(f32x4*)(xo + (size_t)(row0 + ai * 128 + m * 16) * D + col0 + bj * 128 + n * 4) = xv[m][bj][n] + gv[bj][n] * acc[ai][bj][m][n];
        }
    }
};
struct EpiProj {
    bf16_t* base; float* G; const float2* rope; const float* gate_b;
    __device__ __forceinline__ void operator()(const f32x4 (&acc)[2][2][4][2], const pg8::Unit& u, int wr, int wc, int fr, int fq) const {
        const int row0 = u.pm * 256 + wr * 64 + fr;
        if (u.pn == 14) {
            if (wc == 0 && fq < 2) {
#pragma unroll
                for (int nn = 0; nn < 2; ++nn) { const int head = 2 * fq + nn; const f32x4 gb = *(const f32x4*)(gate_b + 4 * head);
#pragma unroll
                    for (int ai = 0; ai < 2; ++ai)
#pragma unroll
                        for (int m = 0; m < 4; ++m) { const int row = row0 + ai * 128 + m * 16; f32x4 v = acc[ai][0][m][nn] + gb;
                            v[1] = log_sigmoid_f(v[1]); v[3] = log_sigmoid_f(v[3]);
                            *(f32x4*)(G + (size_t)row * 16 + 4 * head) = v; } }
            }
            return;
        }
        const int kind = u.pn >> 1; bf16_t* dst = base + (size_t)kind * TP * 512;
        const int cc0 = (u.pn & 1) * 256 + wc * 32 + 8 * fq;
        const bool rope_k = (kind == 3 || kind == 4) && (u.pm < T / 256);
        const float sc = (kind == 4) ? 0.08838834764831845f : 1.0f;
#pragma unroll
        for (int ai = 0; ai < 2; ++ai) {
            float2 csA[4][2][2], csB[4][2][2];
            if (rope_k) {
#pragma unroll
                for (int m = 0; m < 4; ++m) { const int row = row0 + ai * 128 + m * 16; const int n = row & (NSEQ - 1), gi = n >> 6, gj = n & 63;
#pragma unroll
                    for (int bj = 0; bj < 2; ++bj)
#pragma unroll
                        for (int nn = 0; nn < 2; ++nn) { const int cc = cc0 + bj * 128 + nn * 4; const int pr = (cc & 127) >> 1; const int pos = (pr < 32) ? gi : gj; const int fi = pr & 31;
                            csA[m][bj][nn] = rope[pos * 32 + fi]; csB[m][bj][nn] = rope[pos * 32 + fi + 1]; } }
            }
#pragma unroll
            for (int m = 0; m < 4; ++m) { const int row = row0 + ai * 128 + m * 16;
#pragma unroll
                for (int bj = 0; bj < 2; ++bj) { u32x4 w;
#pragma unroll
                    for (int nn = 0; nn < 2; ++nn) { f32x4 v = acc[ai][bj][m][nn];
                        if (rope_k) { const float2 cs0 = csA[m][bj][nn], cs1 = csB[m][bj][nn];
                            const float a0 = v[0] * cs0.x - v[1] * cs0.y, a1 = v[0] * cs0.y + v[1] * cs0.x, a2 = v[2] * cs1.x - v[3] * cs1.y, a3 = v[2] * cs1.y + v[3] * cs1.x;
                            v = (f32x4){a0, a1, a2, a3}; }
                        v = v * sc;
                        w[2 * nn] = cvt_pk_bf16(v[0], v[1]); w[2 * nn + 1] = cvt_pk_bf16(v[2], v[3]); }
                    *(u32x4*)(dst + (size_t)row * 512 + cc0 + bj * 128) = w; } }
        }
    }
};
struct EpiGeluUV {
    bf16_t* base; float* st;
    __device__ __forceinline__ void operator()(const f32x4 (&acc)[2][2][4][2], const pg8::Unit& u, int wr, int wc, int fr, int fq) const {
        const int row0 = u.pm * 256 + wr * 64 + fr; bf16_t* dst = base + (size_t)(u.pn >> 3) * T * 2048; const int cc0 = (u.pn & 7) * 256 + wc * 32 + 8 * fq;
        const bool isv = u.pn >= 8;
#define GU_ROW(ai, m) { bf16_t* rowp = dst + (size_t)(row0 + (ai) * 128 + (m) * 16) * 2048 + cc0; float s1 = 0.f, s2 = 0.f; \
            _Pragma("unroll") for (int bj = 0; bj < 2; ++bj) { u32x4 w; \
                _Pragma("unroll") for (int n = 0; n < 2; ++n) { const f32x4 v = acc[ai][bj][m][n]; const float g0 = gelu_tanh(v[0]), g1 = gelu_tanh(v[1]), g2 = gelu_tanh(v[2]), g3 = gelu_tanh(v[3]); \
                    s1 += (g0 + g1) + (g2 + g3); s2 += (g0 * g0 + g1 * g1) + (g2 * g2 + g3 * g3); \
                    w[2 * n] = cvt_pk_bf16(g0, g1); w[2 * n + 1] = cvt_pk_bf16(g2, g3); } \
                *(u32x4*)(rowp + bj * 128) = w; } \
            if (isv) { s1 += __shfl_xor(s1, 16); s1 += __shfl_xor(s1, 32); s2 += __shfl_xor(s2, 16); s2 += __shfl_xor(s2, 32); \
                if (fq == 0) { atomicAdd(st + 2 * (row0 + (ai) * 128 + (m) * 16), s1); atomicAdd(st + 2 * (row0 + (ai) * 128 + (m) * 16) + 1, s2); } } }
        GU_ROW(0, 0) GU_ROW(0, 1) GU_ROW(0, 2) GU_ROW(0, 3) GU_ROW(1, 0) GU_ROW(1, 1) GU_ROW(1, 2) GU_ROW(1, 3)
#undef GU_ROW
    }
};

__device__ void ph_prep(const P& p, LAS unsigned char* lds) {
    const int tid = TIDX, G = gridDim.x, bid = blockIdx.x;
    float* mod = (float*)(p.ws + WS_MOD);
    for (int idx = bid * NTHR + tid; idx < 256 * 32; idx += G * NTHR) {
        const int pos = idx >> 5, fi = idx & 31;
        const float inv = exp2f(-(float)fi * (13.287712379549449f / 32.0f));
        const float ang = (float)pos * inv;
        const double a = (double)ang; const double kq = rint(a * 0.6366197723675814); const double r = a - kq * 1.5707963267948966;
        const float rf = (float)r, r2 = rf * rf; const int q = ((int)kq) & 3;
        const float s = rf + rf * r2 * (-1.6666654611e-1f + r2 * (8.3321608736e-3f + r2 * (-1.9515295891e-4f)));
        const float c = 1.0f - 0.5f * r2 + r2 * r2 * (4.166664568298827e-2f + r2 * (-1.388731625493765e-3f + r2 * 2.443315711809948e-5f));
        float co, si;
        if (q == 0) { co = c; si = s; } else if (q == 1) { co = -s; si = c; } else if (q == 2) { co = -c; si = -s; } else { co = s; si = -c; }
        ((float2*)(p.ws + WS_ROPE))[idx] = make_float2(co, si);
    }
    LAS float* sv = (LAS float*)lds;
    for (int item = bid; item < 288; item += G) {
        const int l = item / 144, rem = item % 144, ks = rem / 9, cgp = rem % 9;
        __syncthreads();
        if (tid < 192) { const int mb = tid >> 6, kk = tid & 63, k = ks * 64 + kk; const float cv = (mb < 2) ? p.c[mb * 1024 + k] : p.c_ctx[k]; sv[mb * 64 + kk] = silu_f(cv); }
        __syncthreads();
        const int half = tid >> 8, cq = tid & 255, col = cgp * 1024 + cq * 4;
        f32x4 a0 = {0, 0, 0, 0}, a1 = a0, a2 = a0;
        const float* wp = p.w_mod + ((size_t)(l * 1024 + ks * 64 + half * 32)) * 9216 + col;
#pragma unroll 16
        for (int kk = 0; kk < 32; ++kk) { const f32x4 w = *(const f32x4*)(wp + (size_t)kk * 9216); const int si = half * 32 + kk;
            a0 += w * sv[si]; a1 += w * sv[64 + si]; a2 += w * sv[128 + si]; }
        if (ks == 0 && half == 0) { const f32x4 bb = *(const f32x4*)(p.b_mod + l * 9216 + col); a0 += bb; a1 += bb; a2 += bb; }
        float* m0 = mod + (size_t)(l * 3) * 9216 + col;
#pragma unroll
        for (int j = 0; j < 4; ++j) { atomicAdd(m0 + j, a0[j]); atomicAdd(m0 + 9216 + j, a1[j]); atomicAdd(m0 + 2 * 9216 + j, a2[j]); }
    }
}

__device__ void ph_convert(const P& p, LAS unsigned char* lds, int layer, int wid, int nwg, int v_lo, int v_hi) {
    const int tid = TIDX;
    __syncthreads();
    LAS bf16_t* tl = (LAS bf16_t*)(lds + 1024);
    bf16_t* Wb = (bf16_t*)(p.ws + WS_W);
    float vv[16]; bf16_t* cdst = nullptr; int cK = 0, ck0 = 0, cr0 = 0;
#define CONV_DECODE(t, src, dst, K, Ns, kind, k0, r0) { int nrt, lt; \
        if (t < 2816) { const int j = t / 704; lt = t % 704; src = p.ffn_w_in + (size_t)j * 1024 * 5632; dst = Wb + W_FFN_IN + (size_t)j * 5632 * 1024; K = 1024; Ns = 5632; nrt = 88; kind = 1; } \
        else if (t < 4224) { const int j = (t - 2816) / 352; lt = (t - 2816) % 352; src = p.ffn_w_out + (size_t)j * 2816 * 1024; dst = Wb + W_FFN_OUT + (size_t)j * 1024 * 2816; K = 2816; Ns = 1024; nrt = 16; kind = 0; } \
        else if (t < 4704) { lt = t - 4224; src = p.mix_w_in; dst = Wb + W_MIXIN; K = 1024; Ns = 3600; nrt = 60; kind = 2; } \
        else if (t < 4832) { lt = t - 4704; src = p.mix_w_out; dst = Wb + W_MIXOUT; K = 1024; Ns = 1024; nrt = 16; kind = 0; } \
        else if (t < 5344) { lt = t - 4832; src = p.sg_w_in; dst = Wb + W_SGIN; K = 1024; Ns = 4096; nrt = 64; kind = 0; } \
        else { lt = t - 5344; src = p.sg_w_out; dst = Wb + W_SGOUT; K = 2048; Ns = 1024; nrt = 16; kind = 0; } \
        k0 = (lt / nrt) * 128; r0 = (lt % nrt) * 64; }
#define CONV_LOAD(t) { const float* src; bf16_t* dst; int K, Ns, kind, k0, r0; CONV_DECODE(t, src, dst, K, Ns, kind, k0, r0) \
        const int rr = r0 + (tid & 63); int sc = rr; \
        if (kind == 1) { const int pn = rr >> 8, cl = rr & 255; sc = 128 * pn + 32 * ((cl >> 5) & 3) + 8 * ((cl >> 2) & 3) + 4 * ((cl >> 4) & 1) + (cl & 3) + (cl >> 7) * DFF; } \
        else { const int rho = rr & 31; sc = (rr & ~31) + 8 * ((rho & 15) >> 2) + 4 * (rho >> 4) + (rho & 3); if (kind == 2 && sc >= 3600) sc = -1; } \
        _Pragma("unroll") for (int it = 0; it < 16; ++it) { const int kk = it * 8 + (tid >> 6); vv[it] = (sc >= 0) ? src[(size_t)(k0 + kk) * Ns + sc] : 0.f; } \
        cdst = dst; cK = K; ck0 = k0; cr0 = r0; }
    const int nv = min(v_hi, layer ? 2880 : 2720);
#define CONV_REMAP(v) (layer ? (((v) < 1408) ? (v) + 1408 : ((v) < 2112) ? (v) - 1408 + 3520 : (v) - 2112 + 4832) : (((v) < 1408) ? (v) : ((v) < 2112) ? (v) - 1408 + 2816 : (v) - 2112 + 4224))
    int v = v_lo + wid;
    if (v < nv) { const int t = CONV_REMAP(v); CONV_LOAD(t) }
    while (v < nv) {
        __syncthreads();
        { const int rl = tid & 63;
#pragma unroll
          for (int it = 0; it < 16; ++it) { const int kk = it * 8 + (tid >> 6); tl[rl * 136 + kk] = f2bf(vv[it]); } }
        bf16_t* odst = cdst; const int oK = cK, ok0 = ck0, or0 = cr0; const bool otile = (oK == 2816);
        __syncthreads();
        v += nwg;
        if (v < nv) { const int t = CONV_REMAP(v); CONV_LOAD(t) }
#pragma unroll
        for (int h2 = 0; h2 < 2; ++h2) { const int idx = tid + h2 * 512, rl = idx >> 4, kc = (idx & 15) * 8; const u32x4 v = *(const LAS u32x4*)(tl + rl * 136 + kc); const int rr = or0 + rl, kk = ok0 + kc;
            const size_t off = otile ? (((size_t)((rr >> 8) * (2816 / 64) + (kk >> 6)) * 2 + ((rr >> 7) & 1)) * 8192 + (rr & 127) * 64 + (kk & 63)) : ((size_t)rr * oK + kk);
            *(u32x4*)(odst + off) = v; }
    }
#undef CONV_LOAD
#undef CONV_REMAP
#undef CONV_DECODE
}

__device__ void ph_norm(const P& p, const float* xlat, const float* xctx, int row_lo, int nrows, int wg0, int nwg, const float* g, const float* modl, int sub, bf16_t* H) {
    const int lane = TIDX & 63, wv = TIDX >> 6;
    if ((int)blockIdx.x < wg0) return;
    const int stride = nwg * 16;
    int row = row_lo + (((int)blockIdx.x - wg0) * 8 + wv) * 2;
    f32x4 v[2][4], nx[2][4], gg[4], s0[4]; int cur_mb = -1;
#define NORM_LOAD(dst, r_) { const bool ic_ = (r_) >= T; const float* xr_ = ic_ ? xctx + (size_t)((r_) - T) * D : xlat + (size_t)(r_) * D; \
        _Pragma("unroll") for (int rr = 0; rr < 2; ++rr) _Pragma("unroll") for (int i = 0; i < 4; ++i) dst[rr][i] = *(const f32x4*)(xr_ + rr * D + 8 * (lane + 64 * (i >> 1)) + 4 * (i & 1)); }
    if (row < nrows) NORM_LOAD(nx, row)
    while (row < nrows) {
#pragma unroll
        for (int rr = 0; rr < 2; ++rr)
#pragma unroll
            for (int i = 0; i < 4; ++i) v[rr][i] = nx[rr][i];
        const int nrow = row + stride;
        if (nrow < nrows) NORM_LOAD(nx, nrow)
        const int mb = (row >= T) ? 2 : (row >> 14);
        if (mb != cur_mb) { const float* sh = modl + mb * 9216 + (sub * 3) * 1024; const float* scp = sh + 1024;
#pragma unroll
            for (int i = 0; i < 4; ++i) { const int k = 8 * (lane + 64 * (i >> 1)) + 4 * (i & 1); gg[i] = *(const f32x4*)(g + k) * (*(const f32x4*)(scp + k) + 1.0f); s0[i] = *(const f32x4*)(sh + k); }
            cur_mb = mb; }
        float ss0 = 0.f, ss1 = 0.f;
#pragma unroll
        for (int i = 0; i < 4; ++i) { ss0 += v[0][i][0] * v[0][i][0] + v[0][i][1] * v[0][i][1] + v[0][i][2] * v[0][i][2] + v[0][i][3] * v[0][i][3];
            ss1 += v[1][i][0] * v[1][i][0] + v[1][i][1] * v[1][i][1] + v[1][i][2] * v[1][i][2] + v[1][i][3] * v[1][i][3]; }
#pragma unroll
        for (int o = 32; o >= 1; o >>= 1) { ss0 += __shfl_xor(ss0, o); ss1 += __shfl_xor(ss1, o); }
        const float rstd0 = rsqrtf(ss0 * (1.0f / D) + 1e-6f), rstd1 = rsqrtf(ss1 * (1.0f / D) + 1e-6f);
#pragma unroll
        for (int h2 = 0; h2 < 2; ++h2) { const int k = 8 * (lane + 64 * h2);
#pragma unroll
            for (int rr = 0; rr < 2; ++rr) { const float rs = rr ? rstd1 : rstd0;
                const f32x4 ya = v[rr][2 * h2] * rs * gg[2 * h2] + s0[2 * h2], yb = v[rr][2 * h2 + 1] * rs * gg[2 * h2 + 1] + s0[2 * h2 + 1];
                u32x4 w; w[0] = cvt_pk_bf16(ya[0], ya[1]); w[1] = cvt_pk_bf16(ya[2], ya[3]); w[2] = cvt_pk_bf16(yb[0], yb[1]); w[3] = cvt_pk_bf16(yb[2], yb[3]);
                *(u32x4*)(H + (size_t)(row + rr) * D + k) = w; } }
        row = nrow;
    }
#undef NORM_LOAD
}
__device__ void ph_final_norm(const P& p) {
    const int lane = TIDX & 63, wv = TIDX >> 6;
    const int stride = gridDim.x * 16;
    int row = (blockIdx.x * 8 + wv) * 2;
    f32x4 v[2][4], nx[2][4], gg[4];
#pragma unroll
    for (int i = 0; i < 4; ++i) gg[i] = *(const f32x4*)(p.final_g + 4 * (lane + 64 * i));
#define FN_LOAD(dst, r_) { const float* xr_ = p.out + (size_t)(r_) * D; \
        _Pragma("unroll") for (int rr = 0; rr < 2; ++rr) _Pragma("unroll") for (int i = 0; i < 4; ++i) dst[rr][i] = *(const f32x4*)(xr_ + rr * D + 4 * (lane + 64 * i)); }
    if (row < T) FN_LOAD(nx, row)
    while (row < T) {
#pragma unroll
        for (int rr = 0; rr < 2; ++rr)
#pragma unroll
            for (int i = 0; i < 4; ++i) v[rr][i] = nx[rr][i];
        const int nrow = row + stride;
        if (nrow < T) FN_LOAD(nx, nrow)
        float ss0 = 0.f, ss1 = 0.f;
#pragma unroll
        for (int i = 0; i < 4; ++i) { ss0 += v[0][i][0] * v[0][i][0] + v[0][i][1] * v[0][i][1] + v[0][i][2] * v[0][i][2] + v[0][i][3] * v[0][i][3];
            ss1 += v[1][i][0] * v[1][i][0] + v[1][i][1] * v[1][i][1] + v[1][i][2] * v[1][i][2] + v[1][i][3] * v[1][i][3]; }
#pragma unroll
        for (int o = 32; o >= 1; o >>= 1) { ss0 += __shfl_xor(ss0, o); ss1 += __shfl_xor(ss1, o); }
        const float rstd0 = rsqrtf(ss0 * (1.0f / D) + 1e-6f), rstd1 = rsqrtf(ss1 * (1.0f / D) + 1e-6f);
        float* xr = p.out + (size_t)row * D;
#pragma unroll
        for (int i = 0; i < 4; ++i) { const int k = 4 * (lane + 64 * i); *(f32x4*)(xr + k) = v[0][i] * rstd0 * gg[i]; *(f32x4*)(xr + D + k) = v[1][i] * rstd1 * gg[i]; }
        row = nrow;
    }
#undef FN_LOAD
}

__device__ void ph_na_naive(const P& p) {
    const bf16_t* R = (const bf16_t*)(p.ws + WS_R);
    const bf16_t* QA = R; const bf16_t* KA = R + (size_t)TP * 512; const bf16_t* VA = R + (size_t)2 * TP * 512;
    bf16_t* Y = (bf16_t*)(p.ws + WS_H);
    for (int u = blockIdx.x; u < 512; u += gridDim.x) {
        const int head = u & 7, token = (u >> 3) * 512 + TIDX, b = token >> 14, n = token & (NSEQ - 1), gi = n >> 6, gj = n & 63;
        const int r0 = min(max(gi - 4, 0), 248), c0 = min(max(gj - 8, 0), 48);
        float q[64], acc[64];
        { const u32x4* qp = (const u32x4*)(QA + (size_t)token * 512 + head * 64);
#pragma unroll
          for (int i = 0; i < 8; ++i) { const u32x4 w = qp[i];
#pragma unroll
              for (int e = 0; e < 4; ++e) { q[i * 8 + 2 * e] = bflo(w[e]) * 0.125f; q[i * 8 + 2 * e + 1] = bfhi(w[e]) * 0.125f; } } }
#pragma unroll
        for (int d = 0; d < 64; ++d) acc[d] = 0.f;
        float m = -1e30f, l = 0.f;
        const float* rp = p.na_rpb + head * 465;
#pragma unroll 1
        for (int kidx = 0; kidx < 384; ++kidx) {
            int krow; float bias = 0.f;
            if (kidx < 128) { const int a = kidx >> 4, kk = kidx & 15; krow = (b << 14) + (r0 + a) * 64 + c0 + kk; bias = rp[(r0 + a - gi + 7) * 31 + (c0 + kk - gj + 15)]; }
            else krow = T + b * 256 + (kidx - 128);
            const u32x4* kp = (const u32x4*)(KA + (size_t)krow * 512 + head * 64);
            float s = 0.f;
#pragma unroll
            for (int i = 0; i < 8; ++i) { const u32x4 w = kp[i];
#pragma unroll
                for (int e = 0; e < 4; ++e) { s += q[i * 8 + 2 * e] * bflo(w[e]); s += q[i * 8 + 2 * e + 1] * bfhi(w[e]); } }
            s += bias;
            const float mn = fmaxf(m, s), sc = __expf(m - mn), pw = __expf(s - mn);
            l = l * sc + pw; m = mn;
            const u32x4* vp = (const u32x4*)(VA + (size_t)krow * 512 + head * 64);
#pragma unroll
            for (int i = 0; i < 8; ++i) { const u32x4 w = vp[i];
#pragma unroll
                for (int e = 0; e < 4; ++e) { acc[i * 8 + 2 * e] = acc[i * 8 + 2 * e] * sc + pw * bflo(w[e]); acc[i * 8 + 2 * e + 1] = acc[i * 8 + 2 * e + 1] * sc + pw * bfhi(w[e]); } }
        }
        const float il = 1.0f / l;
        u32x4* yp = (u32x4*)(Y + (size_t)token * 1024 + head * 64);
#pragma unroll
        for (int i = 0; i < 8; ++i) { u32x4 w;
#pragma unroll
            for (int e = 0; e < 4; ++e) w[e] = cvt_pk_bf16(acc[i * 8 + 2 * e] * il, acc[i * 8 + 2 * e + 1] * il);
            yp[i] = w; }
    }
}

__device__ __forceinline__ int ml_chunk_row0(int b, int d, int j) {
    if (j < 2) { const int oc = d ? 1 - j : j; return T + b * 256 + oc * 128; }
    const int oc = d ? 129 - j : j - 2; return (b << 14) + oc * 128;
}
__device__ __forceinline__ void ml_load_tile(LAS unsigned char* dst, const bf16_t* src, const LAS float* rowscale) {
    for (int i = TIDX; i < 128 * 16; i += NTHR) { const int r = i >> 4, ch = i & 15;
        u32x4 w = *(const u32x4*)(src + (size_t)r * 512 + ch * 8);
        if (rowscale) { const float a = rowscale[r];
#pragma unroll
            for (int e = 0; e < 4; ++e) w[e] = cvt_pk_bf16(bflo(w[e]) * a, bfhi(w[e]) * a); }
        *(LAS u32x4*)(dst + r * PITCH + ch * 16) = w; }
}

__device__ void ph_mlA_naive(const P& p, LAS unsigned char* lds) {
    const bf16_t* R = (const bf16_t*)(p.ws + WS_R);
    const bf16_t* KB = R + (size_t)4 * TP * 512; const bf16_t* VB = R + (size_t)5 * TP * 512; const float* Gt = (const float*)(R + (size_t)7 * TP * 512);
    bf16_t* CL = (bf16_t*)(p.ws + WS_CL); float* VEC = (float*)(p.ws + WS_VEC); float* NL = (float*)(p.ws + WS_NL);
    LAS unsigned char* Kt = lds; LAS unsigned char* Vt = lds + 128 * PITCH; LAS float* av = (LAS float*)(lds + 2 * 128 * PITCH);
    const int tid = TIDX, lane = tid & 63;
    for (int slot = blockIdx.x; slot < NSLOT; slot += gridDim.x) {
        const int j = slot % 130, bhd = slot / 130, d = bhd & 1, h = (bhd >> 1) & 3, b = bhd >> 3;
        const int row0 = ml_chunk_row0(b, d, j);
        __syncthreads();
        if (tid < 64) {
            const int p0 = 2 * lane, p1 = 2 * lane + 1, t0 = d ? 127 - p0 : p0, t1 = d ? 127 - p1 : p1;
            const int gofs = (h * 2 + d) * 2;
            const float i0 = Gt[(size_t)(row0 + t0) * 16 + gofs], f0 = Gt[(size_t)(row0 + t0) * 16 + gofs + 1];
            const float i1 = Gt[(size_t)(row0 + t1) * 16 + gofs], f1 = Gt[(size_t)(row0 + t1) * 16 + gofs + 1];
            float s = f0 + f1;
#pragma unroll
            for (int o = 1; o < 64; o <<= 1) { const float t = __shfl_up(s, o); if (lane >= o) s += t; }
            const float b1 = s, b0 = s - f1, z0 = i0 - b0, z1 = i1 - b1;
            float cmx = fmaxf(z0, z1);
#pragma unroll
            for (int o = 1; o < 64; o <<= 1) { const float t = __shfl_up(cmx, o); if (lane >= o) cmx = fmaxf(cmx, t); }
            float prev = __shfl_up(cmx, 1); if (lane == 0) prev = -1e30f;
            const float cm0 = fmaxf(prev, z0), cm1 = cmx;
            const float btot = __shfl(b1, 63), cml = __shfl(cm1, 63);
            float* vz = VEC + (size_t)slot * 512;
            vz[t0] = z0; vz[t1] = z1; vz[128 + t0] = b0; vz[128 + t1] = b1; vz[256 + t0] = cm0; vz[256 + t1] = cm1;
            if (lane == 0) { vz[384] = btot; vz[385] = btot + cml; }
            av[t0] = __expf(z0 - cml); av[t1] = __expf(z1 - cml);
        }
        __syncthreads();
        ml_load_tile(Kt, KB + (size_t)row0 * 512 + h * 128, nullptr);
        ml_load_tile(Vt, VB + (size_t)row0 * 512 + h * 128, av);
        __syncthreads();
        {
            const int v = tid >> 2, kq = tid & 3;
            float acc[32];
#pragma unroll
            for (int i = 0; i < 32; ++i) acc[i] = 0.f;
#pragma unroll 1
            for (int s = 0; s < 128; ++s) {
                const float avv = bf2f(*(const LAS bf16_t*)(Vt + s * PITCH + v * 2));
#pragma unroll
                for (int c = 0; c < 4; ++c) { const u32x4 w = *(const LAS u32x4*)(Kt + s * PITCH + kq * 64 + c * 16);
#pragma unroll
                    for (int e = 0; e < 4; ++e) { acc[c * 8 + 2 * e] += avv * bflo(w[e]); acc[c * 8 + 2 * e + 1] += avv * bfhi(w[e]); } }
            }
            bf16_t* cp = CL + (size_t)slot * 16384 + v * 128 + kq * 32;
#pragma unroll
            for (int c = 0; c < 4; ++c) { u32x4 w;
#pragma unroll
                for (int e = 0; e < 4; ++e) w[e] = cvt_pk_bf16(acc[c * 8 + 2 * e], acc[c * 8 + 2 * e + 1]);
                *(u32x4*)(cp + c * 8) = w; }
            if (tid < 128) { float sacc = 0.f; for (int s = 0; s < 128; ++s) sacc += av[s] * bf2f(*(const LAS bf16_t*)(Kt + s * PITCH + tid * 2)); NL[(size_t)slot * 128 + tid] = sacc; }
        }
    }
}

__device__ void ph_mlB(const P& p, LAS unsigned char* lds) {
    unsigned* CL = (unsigned*)(p.ws + WS_CL); float* VEC = (float*)(p.ws + WS_VEC); float* NL = (float*)(p.ws + WS_NL);
    LAS float* sb = (LAS float*)lds;
    const int tid = TIDX;
    for (int w = blockIdx.x; w < 16 * 16; w += gridDim.x) {
        const int stream = w >> 4, e2 = (w & 15) * 512 + tid;
        __syncthreads();
        if (tid < 130) { const float* vz = VEC + (size_t)(stream * 130 + tid) * 512 + 384; sb[2 * tid] = vz[0]; sb[2 * tid + 1] = vz[1]; }
        __syncthreads();
        float m = 0.f, c0 = 0.f, c1 = 0.f, n0 = 0.f, n1 = 0.f;
        const bool do_n = (w & 15) == 0 && tid < 64;
        unsigned* cp = CL + (size_t)stream * 130 * 8192 + e2;
        float* np = NL + (size_t)stream * 130 * 128 + 2 * tid;
        unsigned cl[13], cn[13]; f32x2 nlv[13], nnv[13];
#pragma unroll
        for (int jj = 0; jj < 13; ++jj) cn[jj] = cp[(size_t)jj * 8192];
        if (do_n) {
#pragma unroll
            for (int jj = 0; jj < 13; ++jj) nnv[jj] = *(const f32x2*)(np + (size_t)jj * 128);
        }
        for (int j0 = 0; j0 < 130; j0 += 13) {
#pragma unroll
            for (int jj = 0; jj < 13; ++jj) { cl[jj] = cn[jj]; nlv[jj] = nnv[jj]; }
            if (j0 + 13 < 130) {
#pragma unroll
                for (int jj = 0; jj < 13; ++jj) cn[jj] = cp[(size_t)(j0 + 13 + jj) * 8192];
                if (do_n) {
#pragma unroll
                    for (int jj = 0; jj < 13; ++jj) nnv[jj] = *(const f32x2*)(np + (size_t)(j0 + 13 + jj) * 128);
                }
            }
#pragma unroll
            for (int jj = 0; jj < 13; ++jj) {
                const int j = j0 + jj;
                const float btot = sb[2 * j], mloc = sb[2 * j + 1];
                cp[(size_t)j * 8192] = cvt_pk_bf16(c0, c1);
                const float mn = fmaxf(btot + m, mloc), ap = __expf(btot + m - mn), al = __expf(mloc - mn);
                if (do_n) { *(f32x2*)(np + (size_t)j * 128) = (f32x2){n0, n1}; n0 = ap * n0 + al * nlv[jj][0]; n1 = ap * n1 + al * nlv[jj][1]; }
                if ((w & 15) == 0 && tid == 0) VEC[(size_t)(stream * 130 + j) * 512 + 386] = m;
                c0 = ap * c0 + al * bflo(cl[jj]); c1 = ap * c1 + al * bfhi(cl[jj]); m = mn;
            }
        }
    }
}

__device__ void ph_mlC_naive(const P& p, LAS unsigned char* lds) {
    const bf16_t* R = (const bf16_t*)(p.ws + WS_R);
    const bf16_t* QB = R + (size_t)3 * TP * 512; const bf16_t* KB = R + (size_t)4 * TP * 512; const bf16_t* VB = R + (size_t)5 * TP * 512; const bf16_t* OB = R + (size_t)6 * TP * 512;
    const bf16_t* CL = (const bf16_t*)(p.ws + WS_CL); const float* VEC = (const float*)(p.ws + WS_VEC); const float* NL = (const float*)(p.ws + WS_NL);
    bf16_t* Y = (bf16_t*)(p.ws + WS_H);
    LAS unsigned char* Qt = lds; LAS unsigned char* Kt = lds + 128 * PITCH; LAS unsigned char* Vt = lds + 2 * 128 * PITCH; LAS unsigned char* Ct = lds + 3 * 128 * PITCH;
    LAS float* vz = (LAS float*)(lds + 4 * 128 * PITCH); LAS float* vb = vz + 128; LAS float* vcm = vb + 128; LAS float* vn = vcm + 128;
    const int tid = TIDX, t = tid >> 2, vq = tid & 3;
    for (int u = blockIdx.x; u < 1024; u += gridDim.x) {
        const int oc = u & 127, h = (u >> 7) & 3, b = u >> 9;
        const int row0 = (b << 14) + oc * 128;
        float hsum[32];
#pragma unroll
        for (int i = 0; i < 32; ++i) hsum[i] = 0.f;
        for (int d = 0; d < 2; ++d) {
            const int j = d ? 129 - oc : oc + 2, slot = ((b * 4 + h) * 2 + d) * 130 + j;
            __syncthreads();
            ml_load_tile(Qt, QB + (size_t)row0 * 512 + h * 128, nullptr);
            ml_load_tile(Kt, KB + (size_t)row0 * 512 + h * 128, nullptr);
            ml_load_tile(Vt, VB + (size_t)row0 * 512 + h * 128, nullptr);
            for (int i = tid; i < 128 * 16; i += NTHR) { const int r = i >> 4, ch = i & 15; *(LAS u32x4*)(Ct + r * PITCH + ch * 16) = *(const u32x4*)(CL + (size_t)slot * 16384 + r * 128 + ch * 8); }
            if (tid < 128) { const float* vp = VEC + (size_t)slot * 512; vz[tid] = vp[tid]; vb[tid] = vp[128 + tid]; vcm[tid] = vp[256 + tid]; vn[tid] = NL[(size_t)slot * 128 + tid]; }
            const float mprev = VEC[(size_t)slot * 512 + 386];
            __syncthreads();
            const float ut = -fmaxf(mprev, vcm[t]), winter = __expf(mprev + ut), flo = __expf(ut - vb[t]);
            float sc[32];
#pragma unroll
            for (int i = 0; i < 32; ++i) sc[i] = 0.f;
            float nq = 0.f;
#pragma unroll 1
            for (int kc = 0; kc < 16; ++kc) {
                const u32x4 qw = *(const LAS u32x4*)(Qt + t * PITCH + kc * 16);
                float qf[8];
#pragma unroll
                for (int e = 0; e < 4; ++e) { qf[2 * e] = bflo(qw[e]); qf[2 * e + 1] = bfhi(qw[e]); }
                if ((kc >> 2) == vq) {
#pragma unroll
                    for (int e = 0; e < 8; ++e) nq += qf[e] * vn[kc * 8 + e]; }
#pragma unroll
                for (int si = 0; si < 32; ++si) { const u32x4 kw = *(const LAS u32x4*)(Kt + (32 * vq + si) * PITCH + kc * 16);
#pragma unroll
                    for (int e = 0; e < 4; ++e) { sc[si] += qf[2 * e] * bflo(kw[e]); sc[si] += qf[2 * e + 1] * bfhi(kw[e]); }
                    asm volatile("" ::: "memory"); }
            }
            float rs = 0.f;
            int tt = t, s_base = 32 * vq; asm volatile("" : "+v"(tt), "+v"(s_base));
#pragma unroll
            for (int si = 0; si < 32; ++si) { const int s = s_base + si; const bool ok = d ? (s >= tt) : (s <= tt);
                const float w = ok ? __expf(ut + vz[s]) : 0.f; sc[si] *= w; rs += sc[si]; }
            rs += __shfl_xor(rs, 1); rs += __shfl_xor(rs, 2);
            nq += __shfl_xor(nq, 1); nq += __shfl_xor(nq, 2);
            __syncthreads();
#pragma unroll
            for (int c = 0; c < 4; ++c) { u32x4 w;
#pragma unroll
                for (int e = 0; e < 4; ++e) w[e] = cvt_pk_bf16(sc[c * 8 + 2 * e], sc[c * 8 + 2 * e + 1]);
                *(LAS u32x4*)(Kt + t * PITCH + vq * 64 + c * 16) = w; }
            __syncthreads();
            const float den = winter * nq + rs, dd = 1.0f / fmaxf(fabsf(den), flo);
#pragma unroll
            for (int hv = 0; hv < 2; ++hv) {
                float num[16];
#pragma unroll
                for (int i = 0; i < 16; ++i) num[i] = 0.f;
#pragma unroll 1
                for (int kc = 0; kc < 16; ++kc) {
                    const u32x4 qw = *(const LAS u32x4*)(Qt + t * PITCH + kc * 16);
                    float qf[8];
#pragma unroll
                    for (int e = 0; e < 4; ++e) { qf[2 * e] = bflo(qw[e]); qf[2 * e + 1] = bfhi(qw[e]); }
#pragma unroll
                    for (int vi = 0; vi < 16; ++vi) { const u32x4 cw = *(const LAS u32x4*)(Ct + (32 * vq + 16 * hv + vi) * PITCH + kc * 16);
#pragma unroll
                        for (int e = 0; e < 4; ++e) { num[vi] += qf[2 * e] * bflo(cw[e]); num[vi] += qf[2 * e + 1] * bfhi(cw[e]); }
                        asm volatile("" ::: "memory"); }
                }
#pragma unroll
                for (int i = 0; i < 16; ++i) num[i] *= winter;
#pragma unroll 1
                for (int s8 = 0; s8 < 16; ++s8) {
                    const u32x4 pw = *(const LAS u32x4*)(Kt + t * PITCH + s8 * 16);
                    float pf[8];
#pragma unroll
                    for (int e = 0; e < 4; ++e) { pf[2 * e] = bflo(pw[e]); pf[2 * e + 1] = bfhi(pw[e]); }
#pragma unroll
                    for (int ss = 0; ss < 8; ++ss) {
#pragma unroll
                        for (int c = 0; c < 2; ++c) { const u32x4 vw = *(const LAS u32x4*)(Vt + (s8 * 8 + ss) * PITCH + vq * 64 + hv * 32 + c * 16);
#pragma unroll
                            for (int e = 0; e < 4; ++e) { num[c * 8 + 2 * e] += pf[ss] * bflo(vw[e]); num[c * 8 + 2 * e + 1] += pf[ss] * bfhi(vw[e]); } }
                        asm volatile("" ::: "memory"); }
                }
#pragma unroll
                for (int i = 0; i < 16; ++i) hsum[hv * 16 + i] += num[i] * dd;
            }
        }
        float ss = 0.f;
#pragma unroll
        for (int i = 0; i < 32; ++i) ss += hsum[i] * hsum[i];
        ss += __shfl_xor(ss, 1); ss += __shfl_xor(ss, 2);
        const float rstd = rsqrtf(ss * (1.0f / 128.0f) + 1e-6f);
        const int row = row0 + t;
        const bf16_t* op = OB + (size_t)row * 512 + h * 128 + vq * 32; const float* hg = p.ml_head_g + h * 128 + vq * 32;
        bf16_t* yp = Y + (size_t)row * 1024 + 512 + h * 128 + vq * 32;
#pragma unroll
        for (int c = 0; c < 4; ++c) { const u32x4 ow = *(const u32x4*)(op + c * 8); u32x4 w;
#pragma unroll
            for (int e = 0; e < 4; ++e) { const int i0 = c * 8 + 2 * e;
                const float y0 = hsum[i0] * rstd * hg[i0] * sigmoid_f(bflo(ow[e])), y1 = hsum[i0 + 1] * rstd * hg[i0 + 1] * sigmoid_f(bfhi(ow[e]));
                w[e] = cvt_pk_bf16(y0, y1); }
            *(u32x4*)(yp + c * 8) = w; }
    }
}

__device__ void ph_sg_stats(const P& p) {
    const bf16_t* V = (const bf16_t*)(p.ws + WS_R) + (size_t)T * 2048; float* ST = (float*)(p.ws + WS_ST);
    const int lane = TIDX & 63, wv = TIDX >> 6;
    for (int row = blockIdx.x * 8 + wv; row < T; row += gridDim.x * 8) {
        float vals[32]; float s = 0.f;
#pragma unroll
        for (int i = 0; i < 4; ++i) { const u32x4 w = *(const u32x4*)(V + (size_t)row * 2048 + 8 * (lane + 64 * i));
#pragma unroll
            for (int e = 0; e < 4; ++e) { vals[i * 8 + 2 * e] = bflo(w[e]); vals[i * 8 + 2 * e + 1] = bfhi(w[e]); s += vals[i * 8 + 2 * e] + vals[i * 8 + 2 * e + 1]; } }
#pragma unroll
        for (int o = 32; o >= 1; o >>= 1) s += __shfl_xor(s, o);
        const float mu = s * (1.0f / 2048.0f); float q = 0.f;
#pragma unroll
        for (int i = 0; i < 32; ++i) { const float dlt = vals[i] - mu; q += dlt * dlt; }
#pragma unroll
        for (int o = 32; o >= 1; o >>= 1) q += __shfl_xor(q, o);
        if (lane == 0) { ST[2 * row] = mu; ST[2 * row + 1] = rsqrtf(q * (1.0f / 2048.0f) + 1e-6f); }
    }
}
__device__ void ph_sg_naive(const P& p, LAS unsigned char* lds) {
    bf16_t* U = (bf16_t*)(p.ws + WS_R); const bf16_t* V = U + (size_t)T * 2048; const float* ST = (const float*)(p.ws + WS_ST);
    constexpr int VP = 528;
    LAS unsigned char* Vn = lds; LAS unsigned char* Wt = lds + 128 * VP;
    const int tid = TIDX, t = tid >> 2, dq = tid & 3;
    for (int u = blockIdx.x; u < 2048; u += gridDim.x) {
        const int g = u & 7, ch = u >> 3, row0 = ch * 128;
        __syncthreads();
        for (int i = tid; i < 128 * 32; i += NTHR) { const int r = i >> 5, c8 = i & 31; const int cbase = g * 256 + c8 * 8;
            const u32x4 w = *(const u32x4*)(V + (size_t)(row0 + r) * 2048 + cbase); const float mu = ST[2 * (row0 + r)], rs = ST[2 * (row0 + r) + 1];
            const f32x4 g0 = *(const f32x4*)(p.sg_ln_g + cbase), g1 = *(const f32x4*)(p.sg_ln_g + cbase + 4), b0 = *(const f32x4*)(p.sg_ln_b + cbase), b1 = *(const f32x4*)(p.sg_ln_b + cbase + 4);
            u32x4 o;
            o[0] = cvt_pk_bf16((bflo(w[0]) - mu) * rs * g0[0] + b0[0], (bfhi(w[0]) - mu) * rs * g0[1] + b0[1]);
            o[1] = cvt_pk_bf16((bflo(w[1]) - mu) * rs * g0[2] + b0[2], (bfhi(w[1]) - mu) * rs * g0[3] + b0[3]);
            o[2] = cvt_pk_bf16((bflo(w[2]) - mu) * rs * g1[0] + b1[0], (bfhi(w[2]) - mu) * rs * g1[1] + b1[1]);
            o[3] = cvt_pk_bf16((bflo(w[3]) - mu) * rs * g1[2] + b1[2], (bfhi(w[3]) - mu) * rs * g1[3] + b1[3]);
            *(LAS u32x4*)(Vn + r * VP + c8 * 16) = o; }
        for (int i = tid; i < 128 * 32; i += NTHR) { const int r = i >> 5, c4 = i & 31; const f32x4 w = *(const f32x4*)(p.sg_w_s + (size_t)g * 16384 + r * 128 + c4 * 4);
            u32x2 o; o.x = cvt_pk_bf16(w[0], w[1]); o.y = cvt_pk_bf16(w[2], w[3]); *(LAS u32x2*)(Wt + r * PITCH + c4 * 8) = o; }
        __syncthreads();
        float acc[64];
#pragma unroll
        for (int i = 0; i < 64; ++i) acc[i] = 0.f;
#pragma unroll 1
        for (int s8 = 0; s8 < 16; ++s8) {
            const u32x4 ww = *(const LAS u32x4*)(Wt + t * PITCH + s8 * 16);
            float wf[8];
#pragma unroll
            for (int e = 0; e < 4; ++e) { wf[2 * e] = bflo(ww[e]); wf[2 * e + 1] = bfhi(ww[e]); }
#pragma unroll
            for (int ss = 0; ss < 8; ++ss) {
#pragma unroll
                for (int c = 0; c < 8; ++c) { const u32x4 vw = *(const LAS u32x4*)(Vn + (s8 * 8 + ss) * VP + dq * 128 + c * 16);
#pragma unroll
                    for (int e = 0; e < 4; ++e) { acc[c * 8 + 2 * e] += wf[ss] * bflo(vw[e]); acc[c * 8 + 2 * e + 1] += wf[ss] * bfhi(vw[e]); }
                    if ((c & 3) == 3) asm volatile("" ::: "memory"); } }
        }
        const float bs = p.sg_b_s[g * 128 + t];
        bf16_t* up = U + (size_t)(row0 + t) * 2048 + g * 256 + dq * 64;
#pragma unroll
        for (int c = 0; c < 8; ++c) { const u32x4 uw = *(const u32x4*)(up + c * 8); u32x4 o;
#pragma unroll
            for (int e = 0; e < 4; ++e) o[e] = cvt_pk_bf16(bflo(uw[e]) * (acc[c * 8 + 2 * e] + bs), bfhi(uw[e]) * (acc[c * 8 + 2 * e + 1] + bs));
            *(u32x4*)(up + c * 8) = o; }
    }
}

typedef short s16x4 __attribute__((ext_vector_type(4)));
__device__ __forceinline__ s16x4 ds_tr(LAS unsigned char* a) { return __builtin_amdgcn_ds_read_tr16_b64_v4i16((LAS s16x4*)a); }
__device__ __forceinline__ bf16x8 cat8(s16x4 lo, s16x4 hi) { return __builtin_shufflevector(lo, hi, 0, 1, 2, 3, 4, 5, 6, 7); }
__device__ __forceinline__ f32x4 mfma16(bf16x8 a, bf16x8 b, f32x4 c) { return __builtin_amdgcn_mfma_f32_16x16x32_bf16(a, b, c, 0, 0, 0); }
__device__ __forceinline__ bf16x8 pk8(f32x4 a, f32x4 b) { u32x4 w; w[0] = cvt_pk_bf16(a[0], a[1]); w[1] = cvt_pk_bf16(a[2], a[3]); w[2] = cvt_pk_bf16(b[0], b[1]); w[3] = cvt_pk_bf16(b[2], b[3]); return __builtin_bit_cast(bf16x8, w); }
constexpr int TPI = 304;
__device__ __forceinline__ void ml_load_tile2(LAS unsigned char* dst, const bf16_t* src, int srcstride, const LAS float* rowscale, int tid) {
    for (int i = tid; i < 128 * 16; i += NTHR) { const int r = i >> 4, ch = i & 15;
        u32x4 w = *(const u32x4*)(src + (size_t)r * srcstride + ch * 8);
        if (rowscale) { const float a = rowscale[r];
#pragma unroll
            for (int e = 0; e < 4; ++e) w[e] = cvt_pk_bf16(bflo(w[e]) * a, bfhi(w[e]) * a); }
        *(LAS u32x4*)(dst + r * TPI + ch * 16) = w; }
}

__device__ void ph_na(const P& p, LAS unsigned char* lds) {
    const bf16_t* R = (const bf16_t*)(p.ws + WS_R);
    const bf16_t* QA = R; const bf16_t* KA = R + (size_t)TP * 512; const bf16_t* VA = R + (size_t)2 * TP * 512;
    bf16_t* Y = (bf16_t*)(p.ws + WS_H);
    constexpr int VP = 144;
    LAS unsigned char* Vl = lds; LAS unsigned char* Vc = lds + 512 * VP;
    LAS float* comb = (LAS float*)(lds + 768 * VP); LAS float* rpbs = comb + 4 * 18 * 64;
    const int tid = TIDX, lane = tid & 63, w = __builtin_amdgcn_readfirstlane(tid >> 6), c = lane & 15, g = lane >> 4, qb = w & 3, half = w >> 2;
    const int qq = (lane & 15) >> 2, pp = lane & 3;
    const int per = (4096 + gridDim.x - 1) / gridDim.x;
    const int u_lo = blockIdx.x * per, u_hi = min(u_lo + per, 4096);
    int last_bh = -1;
    const int cstart = (qb == 0) ? 0 : (qb == 1) ? 8 : (qb == 2) ? 24 : 32;
    u32x4 vnew = {0u, 0u, 0u, 0u}; int pf_row = -1; bf16x8 qn[2] = {};
    int crm[2][4];
    { const int qcol = 16 * qb + c, c0 = min(max(qcol - 8, 0), 48);
#pragma unroll
      for (int chh = 0; chh < 2; ++chh)
#pragma unroll
          for (int j = 0; j < 4; ++j) { const int col = cstart + 16 * chh + 4 * g + j; crm[chh][j] = ((col >= c0) && (col < c0 + 16)) ? (col - qcol + 15) : 31; } }
    for (int u = u_lo; u < u_hi; ++u) {
        const int gi = u & 255, bh = u >> 8, head = bh & 7, b = bh >> 3;
        const int r0 = min(max(gi - 4, 0), 248);
        const int token = (b << 14) + gi * 64 + 16 * qb + c;
        bf16x8 qf[2];
        if (bh != last_bh) {
            for (int i = tid; i < 256 * 8; i += NTHR) { const int key = i >> 3, ch = i & 7;
                *(LAS u32x4*)(Vc + key * VP + ch * 16) = *(const u32x4*)(VA + (size_t)(T + b * 256 + key) * 512 + head * 64 + ch * 8); }
            if (tid < 480) { const int rr = tid >> 5, cc = tid & 31; rpbs[tid] = (cc < 31) ? p.na_rpb[head * 465 + rr * 31 + cc] * 1.4426950408889634f : -1e30f; }
            for (int i = tid; i < 512 * 8; i += NTHR) { const int key = i >> 3, ch = i & 7, row = r0 + (key >> 6);
                *(LAS u32x4*)(Vl + ((row & 7) * 64 + (key & 63)) * VP + ch * 16) = *(const u32x4*)(VA + (size_t)((b << 14) + row * 64 + (key & 63)) * 512 + head * 64 + ch * 8); }
            qf[0] = *(const bf16x8*)(QA + (size_t)token * 512 + head * 64 + 8 * g); qf[1] = *(const bf16x8*)(QA + (size_t)token * 512 + head * 64 + 32 + 8 * g);
            last_bh = bh;
        } else {
            if (pf_row >= 0) *(LAS u32x4*)(Vl + ((pf_row & 7) * 64 + (tid >> 3)) * VP + (tid & 7) * 16) = vnew;
            qf[0] = qn[0]; qf[1] = qn[1];
        }
        __syncthreads();
        pf_row = -1;
        if (u + 1 < u_hi && ((u + 1) >> 8) == bh) {
            const int gin = gi + 1, r0n = min(max(gin - 4, 0), 248);
            if (r0n != r0) { pf_row = r0n + 7; vnew = *(const u32x4*)(VA + (size_t)((b << 14) + pf_row * 64 + (tid >> 3)) * 512 + head * 64 + (tid & 7) * 8); }
            const size_t tn = (size_t)((b << 14) + gin * 64 + 16 * qb + c) * 512 + head * 64 + 8 * g;
            qn[0] = *(const bf16x8*)(QA + tn); qn[1] = *(const bf16x8*)(QA + tn + 32);
        }
        f32x4 sc[16];
        const LAS float* rrow = rpbs + (r0 - gi + 7) * 32;
#pragma unroll
        for (int kt = 0; kt < 16; ++kt) {
            const int a = kt >> 1, chh = kt & 1;
            const int krow = half ? (T + b * 256 + 16 * kt + c) : ((b << 14) + (r0 + a) * 64 + cstart + 16 * chh + c);
            const bf16_t* kp = KA + (size_t)krow * 512 + head * 64 + 8 * g;
            const bf16x8 A0 = *(const bf16x8*)kp, A1 = *(const bf16x8*)(kp + 32);
            f32x4 acc = {0.f, 0.f, 0.f, 0.f};
            acc = mfma16(A0, qf[0], acc); acc = mfma16(A1, qf[1], acc);
            if (half == 0) {
#pragma unroll
                for (int j = 0; j < 4; ++j) acc[j] = acc[j] * 0.18033688011112042f + rrow[a * 32 + crm[chh][j]];
            } else acc = acc * 0.18033688011112042f;
            sc[kt] = acc;
        }
        float m = -1e30f;
#pragma unroll
        for (int kt = 0; kt < 16; ++kt) m = fmaxf(m, fmaxf(fmaxf(sc[kt][0], sc[kt][1]), fmaxf(sc[kt][2], sc[kt][3])));
        m = fmaxf(m, __shfl_xor(m, 16)); m = fmaxf(m, __shfl_xor(m, 32));
        float l = 0.f;
#pragma unroll
        for (int kt = 0; kt < 16; ++kt) {
#pragma unroll
            for (int j = 0; j < 4; ++j) { const float e = __builtin_amdgcn_exp2f(sc[kt][j] - m); sc[kt][j] = e; l += e; } }
        l += __shfl_xor(l, 16); l += __shfl_xor(l, 32);
        f32x4 o[4];
#pragma unroll
        for (int dt = 0; dt < 4; ++dt) o[dt] = (f32x4){0.f, 0.f, 0.f, 0.f};
#pragma unroll
        for (int kp = 0; kp < 8; ++kp) {
            const bf16x8 pf = pk8(sc[2 * kp], sc[2 * kp + 1]);
            LAS unsigned char* vb = half ? (Vc + (32 * kp + 4 * g + qq) * VP + 8 * pp) : (Vl + ((((r0 + kp) & 7) * 64) + cstart + 4 * g + qq) * VP + 8 * pp);
#pragma unroll
            for (int dt = 0; dt < 4; ++dt) { const s16x4 lo = ds_tr(vb + dt * 32), hi = ds_tr(vb + 16 * VP + dt * 32); o[dt] = mfma16(cat8(lo, hi), pf, o[dt]); }
        }
        if (half == 1) { LAS float* cb = comb + qb * 18 * 64 + lane; cb[0] = m; cb[64] = l;
#pragma unroll
            for (int dt = 0; dt < 4; ++dt)
#pragma unroll
                for (int j = 0; j < 4; ++j) cb[(2 + 4 * dt + j) * 64] = o[dt][j]; }
        __syncthreads();
        if (half == 0) { const LAS float* cb = comb + qb * 18 * 64 + lane; const float m1 = cb[0], l1 = cb[64];
            const float M = fmaxf(m, m1), e0 = __builtin_amdgcn_exp2f(m - M), e1 = __builtin_amdgcn_exp2f(m1 - M), il = 1.0f / (l * e0 + l1 * e1);
            bf16_t* yp = Y + (size_t)token * 1024 + head * 64 + 4 * g;
#pragma unroll
            for (int dt = 0; dt < 4; ++dt) { f32x4 r;
#pragma unroll
                for (int j = 0; j < 4; ++j) r[j] = (o[dt][j] * e0 + cb[(2 + 4 * dt + j) * 64] * e1) * il;
                u32x2 wv; wv.x = cvt_pk_bf16(r[0], r[1]); wv.y = cvt_pk_bf16(r[2], r[3]); *(u32x2*)(yp + 16 * dt) = wv; } }
    }
}

__device__ void ph_na2(const P& p, LAS unsigned char* lds) {
    const bf16_t* R = (const bf16_t*)(p.ws + WS_R);
    const bf16_t* QA = R; const bf16_t* KA = R + (size_t)TP * 512; const bf16_t* VA = R + (size_t)2 * TP * 512;
    bf16_t* Y = (bf16_t*)(p.ws + WS_H);
    constexpr int VP = 144, RING = 11;
    LAS unsigned char* Vl = lds; LAS unsigned char* Vc = lds + RING * 64 * VP; LAS float* rpbs = (LAS float*)(lds + (RING * 64 + 256) * VP);
    const int tid = TIDX, lane = tid & 63, w = __builtin_amdgcn_readfirstlane(tid >> 6), c = lane & 15, g = lane >> 4, qb = w & 3, ur = w >> 2;
    const int qq = (lane & 15) >> 2, pp = lane & 3;
    const int per = (4096 + gridDim.x - 1) / gridDim.x;
    const int u_lo = blockIdx.x * per, u_hi = min(u_lo + per, 4096);
    int last_bh = -1, have_hi = -1;
    const int cstart = (qb == 0) ? 0 : (qb == 1) ? 8 : (qb == 2) ? 24 : 32;
    u32x4 vnew0 = {0u, 0u, 0u, 0u}, vnew1 = vnew0; int pf_n = 0; bf16x8 qn[2] = {};
    int crm[2][4];
    { const int qcol = 16 * qb + c, c0 = min(max(qcol - 8, 0), 48);
#pragma unroll
      for (int chh = 0; chh < 2; ++chh)
#pragma unroll
          for (int j = 0; j < 4; ++j) { const int col = cstart + 16 * chh + 4 * g + j; crm[chh][j] = ((col >= c0) && (col < c0 + 16)) ? (col - qcol + 15) : 31; } }
    for (int u0 = u_lo; u0 < u_hi; u0 += 2) {
        const int bh = u0 >> 8, head = bh & 7, b = bh >> 3, gi0 = u0 & 255;
        const int r0a = min(max(gi0 - 4, 0), 248), r0b = min(max(gi0 - 3, 0), 248);
        const int gi = gi0 + ur, r0 = ur ? r0b : r0a;
        const bool valid = (u0 + ur) < u_hi;
        const int token = (b << 14) + gi * 64 + 16 * qb + c;
        bf16x8 qf[2];
        if (bh != last_bh) {
            __syncthreads();
            { u32x4 tv[4];
#pragma unroll
              for (int k = 0; k < 4; ++k) { const int i = tid + k * NTHR, key = i >> 3, ch = i & 7; tv[k] = *(const u32x4*)(VA + (size_t)(T + b * 256 + key) * 512 + head * 64 + ch * 8); }
#pragma unroll
              for (int k = 0; k < 4; ++k) { const int i = tid + k * NTHR, key = i >> 3, ch = i & 7; *(LAS u32x4*)(Vc + key * VP + ch * 16) = tv[k]; } }
            if (tid < 480) { const int rr = tid >> 5, cc = tid & 31; rpbs[tid] = (cc < 31) ? p.na_rpb[head * 465 + rr * 31 + cc] * 1.4426950408889634f : -1e30f; }
            { u32x4 tv[9];
#pragma unroll
              for (int k = 0; k < 9; ++k) { const int i = tid + k * NTHR, key = i >> 3, ch = i & 7, row = min(r0a + (key >> 6), r0b + 7);
                  tv[k] = *(const u32x4*)(VA + (size_t)((b << 14) + row * 64 + (key & 63)) * 512 + head * 64 + ch * 8); }
#pragma unroll
              for (int k = 0; k < 9; ++k) { const int i = tid + k * NTHR, key = i >> 3, ch = i & 7, row = r0a + (key >> 6);
                  if (row <= r0b + 7) *(LAS u32x4*)(Vl + ((row % RING) * 64 + (key & 63)) * VP + ch * 16) = tv[k]; } }
            qf[0] = *(const bf16x8*)(QA + (size_t)token * 512 + head * 64 + 8 * g); qf[1] = *(const bf16x8*)(QA + (size_t)token * 512 + head * 64 + 32 + 8 * g);
            last_bh = bh; have_hi = r0b + 7;
        } else {
            if (pf_n > 0) *(LAS u32x4*)(Vl + (((have_hi + 1) % RING) * 64 + (tid >> 3)) * VP + (tid & 7) * 16) = vnew0;
            if (pf_n > 1) *(LAS u32x4*)(Vl + (((have_hi + 2) % RING) * 64 + (tid >> 3)) * VP + (tid & 7) * 16) = vnew1;
            have_hi += pf_n;
            qf[0] = qn[0]; qf[1] = qn[1];
        }
        __syncthreads();
        pf_n = 0;
        if (u0 + 2 < u_hi && ((u0 + 2) >> 8) == bh) {
            const int need_hi = min(max(gi0 - 1, 0), 248) + 7;
            pf_n = need_hi - have_hi;
            if (pf_n > 0) vnew0 = *(const u32x4*)(VA + (size_t)((b << 14) + (have_hi + 1) * 64 + (tid >> 3)) * 512 + head * 64 + (tid & 7) * 8);
            if (pf_n > 1) vnew1 = *(const u32x4*)(VA + (size_t)((b << 14) + (have_hi + 2) * 64 + (tid >> 3)) * 512 + head * 64 + (tid & 7) * 8);
            const size_t tn = (size_t)((b << 14) + (gi + 2) * 64 + 16 * qb + c) * 512 + head * 64 + 8 * g;
            qn[0] = *(const bf16x8*)(QA + tn); qn[1] = *(const bf16x8*)(QA + tn + 32);
        }
        if (valid) {
            const LAS float* rrow = rpbs + (r0 - gi + 7) * 32;
            const bf16_t* kl = KA + (size_t)((b << 14) + r0 * 64 + cstart + c) * 512 + head * 64 + 8 * g;
            const bf16_t* kc = KA + (size_t)(T + b * 256 + c) * 512 + head * 64 + 8 * g;
            float M = -1e30f, L = 0.f;
            f32x4 o[4];
#pragma unroll
            for (int dt = 0; dt < 4; ++dt) o[dt] = (f32x4){0.f, 0.f, 0.f, 0.f};
#pragma unroll 1
            for (int hf = 0; hf < 2; ++hf) {
                f32x4 sc[16];
#pragma unroll
                for (int kt = 0; kt < 16; ++kt) {
                    const int a = kt >> 1, chh = kt & 1;
                    const bf16_t* kp = hf ? kc : kl;
                    if (hf) kc += 16 * 512; else kl += (chh ? 48 : 16) * 512;
                    const bf16x8 A0 = *(const bf16x8*)kp, A1 = *(const bf16x8*)(kp + 32);
                    f32x4 acc = {0.f, 0.f, 0.f, 0.f};
                    acc = mfma16(A0, qf[0], acc); acc = mfma16(A1, qf[1], acc);
                    if (hf == 0) {
#pragma unroll
                        for (int j = 0; j < 4; ++j) acc[j] = acc[j] * 0.18033688011112042f + rrow[a * 32 + crm[chh][j]];
                    } else acc = acc * 0.18033688011112042f;
                    sc[kt] = acc;
                    if ((kt & 7) == 7) asm volatile("" : "+v"(kl), "+v"(kc) :: "memory");
                }
                float m = -1e30f;
#pragma unroll
                for (int kt = 0; kt < 16; ++kt) m = fmaxf(m, fmaxf(fmaxf(sc[kt][0], sc[kt][1]), fmaxf(sc[kt][2], sc[kt][3])));
                m = fmaxf(m, __shfl_xor(m, 16)); m = fmaxf(m, __shfl_xor(m, 32));
                const float mn = fmaxf(M, m), es = __builtin_amdgcn_exp2f(M - mn);
                float l = 0.f;
#pragma unroll
                for (int kt = 0; kt < 16; ++kt) {
#pragma unroll
                    for (int j = 0; j < 4; ++j) { const float e = __builtin_amdgcn_exp2f(sc[kt][j] - mn); sc[kt][j] = e; l += e; } }
                l += __shfl_xor(l, 16); l += __shfl_xor(l, 32);
                L = L * es + l; M = mn;
#pragma unroll
                for (int dt = 0; dt < 4; ++dt) o[dt] = o[dt] * es;
#pragma unroll
                for (int kp = 0; kp < 8; ++kp) {
                    const bf16x8 pf = pk8(sc[2 * kp], sc[2 * kp + 1]);
                    LAS unsigned char* vb = hf ? (Vc + (32 * kp + 4 * g + qq) * VP + 8 * pp) : (Vl + ((((r0 + kp) % RING) * 64) + cstart + 4 * g + qq) * VP + 8 * pp);
#pragma unroll
                    for (int dt = 0; dt < 4; ++dt) { const s16x4 lo = ds_tr(vb + dt * 32), hi = ds_tr(vb + 16 * VP + dt * 32); o[dt] = mfma16(cat8(lo, hi), pf, o[dt]); }
                    if (kp & 1) asm volatile("" ::: "memory");
                }
            }
            const float il = 1.0f / L;
            bf16_t* yp = Y + (size_t)token * 1024 + head * 64 + 4 * g;
#pragma unroll
            for (int dt = 0; dt < 4; ++dt) { u32x2 wv; wv.x = cvt_pk_bf16(o[dt][0] * il, o[dt][1] * il); wv.y = cvt_pk_bf16(o[dt][2] * il, o[dt][3] * il); *(u32x2*)(yp + 16 * dt) = wv; }
        }
    }
}

__device__ void ph_mlA(const P& p, LAS unsigned char* lds) {
    const bf16_t* R = (const bf16_t*)(p.ws + WS_R);
    const bf16_t* KB = R + (size_t)4 * TP * 512; const bf16_t* VB = R + (size_t)5 * TP * 512; const float* Gt = (const float*)(R + (size_t)7 * TP * 512);
    bf16_t* CL = (bf16_t*)(p.ws + WS_CL); float* VEC = (float*)(p.ws + WS_VEC); float* NL = (float*)(p.ws + WS_NL);
    LAS unsigned char* Kt = lds; LAS unsigned char* Vt = lds + 128 * TPI; LAS float* av = (LAS float*)(lds + 2 * 128 * TPI);
    const int tid = TIDX, lane = tid & 63, w = __builtin_amdgcn_readfirstlane(tid >> 6), c = lane & 15, g = lane >> 4, qq = (lane & 15) >> 2, pp = lane & 3;
    const int ch = tid & 15, rb = tid >> 4;
    u32x4 kr[4], vr[4]; float gi0 = 0.f, gf0 = 0.f, gi1 = 0.f, gf1 = 0.f;
#define MLA_PREFETCH(sl) { const int j_ = (sl) % 130, bhd_ = (sl) / 130, d_ = bhd_ & 1, h_ = (bhd_ >> 1) & 3, b_ = bhd_ >> 3; const int row0_ = ml_chunk_row0(b_, d_, j_); \
        _Pragma("unroll") for (int k = 0; k < 4; ++k) { const size_t o_ = (size_t)(row0_ + rb + 32 * k) * 512 + h_ * 128 + ch * 8; kr[k] = *(const u32x4*)(KB + o_); vr[k] = *(const u32x4*)(VB + o_); } \
        if (w == 0) { const int p0 = 2 * lane, t0 = d_ ? 127 - p0 : p0, t1 = d_ ? 126 - p0 : p0 + 1; const int gofs = (h_ * 2 + d_) * 2; \
            gi0 = Gt[(size_t)(row0_ + t0) * 16 + gofs]; gf0 = Gt[(size_t)(row0_ + t0) * 16 + gofs + 1]; gi1 = Gt[(size_t)(row0_ + t1) * 16 + gofs]; gf1 = Gt[(size_t)(row0_ + t1) * 16 + gofs + 1]; } }
    int slot = blockIdx.x;
    if (slot < NSLOT) MLA_PREFETCH(slot)
    while (slot < NSLOT) {
        const int d = (slot / 130) & 1;
        __syncthreads();
        if (w == 0) {
            const int p0 = 2 * lane, p1 = 2 * lane + 1, t0 = d ? 127 - p0 : p0, t1 = d ? 127 - p1 : p1;
            const float i0 = gi0, f0 = gf0, i1 = gi1, f1 = gf1;
            float s = f0 + f1;
#pragma unroll
            for (int o = 1; o < 64; o <<= 1) { const float t = __shfl_up(s, o); if (lane >= o) s += t; }
            const float b1 = s, b0 = s - f1, z0 = i0 - b0, z1 = i1 - b1;
            float cmx = fmaxf(z0, z1);
#pragma unroll
            for (int o = 1; o < 64; o <<= 1) { const float t = __shfl_up(cmx, o); if (lane >= o) cmx = fmaxf(cmx, t); }
            float prev = __shfl_up(cmx, 1); if (lane == 0) prev = -1e30f;
            const float cm0 = fmaxf(prev, z0), cm1 = cmx;
            const float btot = __shfl(b1, 63), cml = __shfl(cm1, 63);
            float* vz = VEC + (size_t)slot * 512;
            vz[t0] = z0; vz[t1] = z1; vz[128 + t0] = b0; vz[128 + t1] = b1; vz[256 + t0] = cm0; vz[256 + t1] = cm1;
            if (lane == 0) { vz[384] = btot; vz[385] = btot + cml; }
            av[t0] = __expf(z0 - cml); av[t1] = __expf(z1 - cml);
        }
#pragma unroll
        for (int k = 0; k < 4; ++k) *(LAS u32x4*)(Kt + (rb + 32 * k) * TPI + ch * 16) = kr[k];
        __syncthreads();
#pragma unroll
        for (int k = 0; k < 4; ++k) { const float a = av[rb + 32 * k]; u32x4 wv = vr[k];
#pragma unroll
            for (int e = 0; e < 4; ++e) wv[e] = cvt_pk_bf16(bflo(wv[e]) * a, bfhi(wv[e]) * a);
            *(LAS u32x4*)(Vt + (rb + 32 * k) * TPI + ch * 16) = wv; }
        const int nslot = slot + gridDim.x;
        if (nslot < NSLOT) MLA_PREFETCH(nslot)
        __syncthreads();
        bf16x8 bv[4], af[4];
#pragma unroll
        for (int ks = 0; ks < 4; ++ks) { LAS unsigned char* a = Vt + (32 * ks + 8 * g + qq) * TPI + (16 * w + 4 * pp) * 2; bv[ks] = cat8(ds_tr(a), ds_tr(a + 4 * TPI));
            const f32x4 a0 = *(const LAS f32x4*)(av + 32 * ks + 8 * g), a1 = *(const LAS f32x4*)(av + 32 * ks + 8 * g + 4); af[ks] = pk8(a0, a1); }
        bf16_t* cp = CL + (size_t)slot * 16384 + (16 * w + c) * 128 + 4 * g;
#pragma unroll
        for (int kt = 0; kt < 8; ++kt) { f32x4 acc = {0.f, 0.f, 0.f, 0.f}, nacc = {0.f, 0.f, 0.f, 0.f};
#pragma unroll
            for (int ks = 0; ks < 4; ++ks) { LAS unsigned char* a = Kt + (32 * ks + 8 * g + qq) * TPI + (16 * kt + 4 * pp) * 2; const bf16x8 kf = cat8(ds_tr(a), ds_tr(a + 4 * TPI));
                acc = mfma16(kf, bv[ks], acc);
                if (kt == w) nacc = mfma16(kf, af[ks], nacc); }
            u32x2 wv; wv.x = cvt_pk_bf16(acc[0], acc[1]); wv.y = cvt_pk_bf16(acc[2], acc[3]); *(u32x2*)(cp + 16 * kt) = wv;
            if (kt == w && c == 0) *(f32x4*)(NL + (size_t)slot * 128 + 16 * kt + 4 * g) = nacc; }
        slot = nslot;
    }
#undef MLA_PREFETCH
}

__device__ void ph_mlC(const P& p, LAS unsigned char* lds) {
    const bf16_t* R = (const bf16_t*)(p.ws + WS_R);
    const bf16_t* QB = R + (size_t)3 * TP * 512; const bf16_t* KB = R + (size_t)4 * TP * 512; const bf16_t* VB = R + (size_t)5 * TP * 512; const bf16_t* OB = R + (size_t)6 * TP * 512;
    const bf16_t* CL = (const bf16_t*)(p.ws + WS_CL); const float* VEC = (const float*)(p.ws + WS_VEC); const float* NL = (const float*)(p.ws + WS_NL);
    bf16_t* Y = (bf16_t*)(p.ws + WS_H);
    LAS unsigned char* Kt = lds; LAS unsigned char* Vt = lds + 128 * TPI; LAS unsigned char* Ct = lds + 2 * 128 * TPI;
    LAS float* vz = (LAS float*)(lds + 3 * 128 * TPI); LAS float* vb = vz + 128; LAS float* vcm = vb + 128; LAS float* vn = vcm + 128;
    const int tid = TIDX, lane = tid & 63, w = __builtin_amdgcn_readfirstlane(tid >> 6), c = lane & 15, g = lane >> 4, qq = (lane & 15) >> 2, pp = lane & 3;
    const int t = 16 * w + c;
    for (int u = blockIdx.x; u < 1024; u += gridDim.x) {
        const int oc = u & 127, h = (u >> 7) & 3, b = u >> 9;
        const int row0 = (b << 14) + oc * 128;
        __syncthreads();
        {
            const int ch = tid & 15, rb = tid >> 4; u32x4 kr[4], vr[4];
#pragma unroll
            for (int k = 0; k < 4; ++k) { const size_t o = (size_t)(row0 + rb + 32 * k) * 512 + h * 128 + ch * 8; kr[k] = *(const u32x4*)(KB + o); vr[k] = *(const u32x4*)(VB + o); }
#pragma unroll
            for (int k = 0; k < 4; ++k) { *(LAS u32x4*)(Kt + (rb + 32 * k) * TPI + ch * 16) = kr[k]; *(LAS u32x4*)(Vt + (rb + 32 * k) * TPI + ch * 16) = vr[k]; }
        }
        bf16x8 qf[4];
#pragma unroll
        for (int ks = 0; ks < 4; ++ks) qf[ks] = *(const bf16x8*)(QB + (size_t)(row0 + t) * 512 + h * 128 + 32 * ks + 8 * g);
        f32x4 hsum[8];
#pragma unroll
        for (int vt = 0; vt < 8; ++vt) hsum[vt] = (f32x4){0.f, 0.f, 0.f, 0.f};
#pragma unroll 1
        for (int d = 0; d < 2; ++d) {
            const int j = d ? 129 - oc : oc + 2, slot = ((b * 4 + h) * 2 + d) * 130 + j;
            if (d == 1) __syncthreads();
            ml_load_tile2(Ct, CL + (size_t)slot * 16384, 128, nullptr, tid);
            if (tid < 128) { const float* vp = VEC + (size_t)slot * 512; vz[tid] = vp[tid]; vb[tid] = vp[128 + tid]; vcm[tid] = vp[256 + tid]; vn[tid] = NL[(size_t)slot * 128 + tid]; }
            const float mprev = VEC[(size_t)slot * 512 + 386];
            __syncthreads();
            const float ut = -fmaxf(mprev, vcm[t]), winter = __expf(mprev + ut), flo = __expf(ut - vb[t]);
            float nq = 0.f;
#pragma unroll
            for (int ks = 0; ks < 4; ++ks) { const u32x4 qw = __builtin_bit_cast(u32x4, qf[ks]); const f32x4 n0 = *(const LAS f32x4*)(vn + 32 * ks + 8 * g), n1 = *(const LAS f32x4*)(vn + 32 * ks + 8 * g + 4);
                nq += bflo(qw[0]) * n0[0] + bfhi(qw[0]) * n0[1] + bflo(qw[1]) * n0[2] + bfhi(qw[1]) * n0[3] + bflo(qw[2]) * n1[0] + bfhi(qw[2]) * n1[1] + bflo(qw[3]) * n1[2] + bfhi(qw[3]) * n1[3]; }
            nq += __shfl_xor(nq, 16); nq += __shfl_xor(nq, 32);
            f32x4 hacc[8];
#pragma unroll
            for (int vt = 0; vt < 8; ++vt) { f32x4 acc = {0.f, 0.f, 0.f, 0.f};
#pragma unroll
                for (int ks = 0; ks < 4; ++ks) acc = mfma16(*(const LAS bf16x8*)(Ct + (16 * vt + c) * TPI + (32 * ks + 8 * g) * 2), qf[ks], acc);
                hacc[vt] = acc * winter; }
            float rs = 0.f;
            bf16x8 pf[4];
#pragma unroll
            for (int kp = 0; kp < 4; ++kp) {
                f32x4 sa[2];
#pragma unroll
                for (int hh = 0; hh < 2; ++hh) { const int st = 2 * kp + hh; const bool active = d ? (st >= w) : (st <= w);
                    f32x4 acc = {0.f, 0.f, 0.f, 0.f};
                    if (active) {
#pragma unroll
                        for (int ks = 0; ks < 4; ++ks) acc = mfma16(*(const LAS bf16x8*)(Kt + (16 * st + c) * TPI + (32 * ks + 8 * g) * 2), qf[ks], acc);
                        const f32x4 zz = *(const LAS f32x4*)(vz + 16 * st + 4 * g);
#pragma unroll
                        for (int jj = 0; jj < 4; ++jj) { const int s = 16 * st + 4 * g + jj; const bool ok = d ? (s >= t) : (s <= t);
                            const float wgt = ok ? __expf(ut + zz[jj]) : 0.f; acc[jj] *= wgt; rs += acc[jj]; }
                    }
                    sa[hh] = acc; }
                pf[kp] = pk8(sa[0], sa[1]);
            }
            rs += __shfl_xor(rs, 16); rs += __shfl_xor(rs, 32);
#pragma unroll
            for (int kp = 0; kp < 4; ++kp) { const bool active = d ? (2 * kp + 1 >= w) : (2 * kp <= w);
                if (active) { LAS unsigned char* vbp = Vt + (32 * kp + 4 * g + qq) * TPI + 8 * pp;
#pragma unroll
                    for (int vt = 0; vt < 8; ++vt) { const s16x4 lo = ds_tr(vbp + vt * 32), hi = ds_tr(vbp + 16 * TPI + vt * 32); hacc[vt] = mfma16(cat8(lo, hi), pf[kp], hacc[vt]); } } }
            const float den = winter * nq + rs, dd = 1.0f / fmaxf(fabsf(den), flo);
#pragma unroll
            for (int vt = 0; vt < 8; ++vt) hsum[vt] += hacc[vt] * dd;
        }
        float ss = 0.f;
#pragma unroll
        for (int vt = 0; vt < 8; ++vt) ss += hsum[vt][0] * hsum[vt][0] + hsum[vt][1] * hsum[vt][1] + hsum[vt][2] * hsum[vt][2] + hsum[vt][3] * hsum[vt][3];
        ss += __shfl_xor(ss, 16); ss += __shfl_xor(ss, 32);
        const float rstd = rsqrtf(ss * (1.0f / 128.0f) + 1e-6f);
        const int row = row0 + t;
        u32x2 owv[8]; f32x4 hgv[8];
#pragma unroll
        for (int vt = 0; vt < 8; ++vt) { const int v0 = 16 * vt + 4 * g; owv[vt] = *(const u32x2*)(OB + (size_t)row * 512 + h * 128 + v0); hgv[vt] = *(const f32x4*)(p.ml_head_g + h * 128 + v0); }
#pragma unroll
        for (int vt = 0; vt < 8; ++vt) { const int v0 = 16 * vt + 4 * g;
            const u32x2 ow = owv[vt]; const f32x4 hg = hgv[vt];
            const float y0 = hsum[vt][0] * rstd * hg[0] * sigmoid_f(bflo(ow.x)), y1 = hsum[vt][1] * rstd * hg[1] * sigmoid_f(bfhi(ow.x));
            const float y2 = hsum[vt][2] * rstd * hg[2] * sigmoid_f(bflo(ow.y)), y3 = hsum[vt][3] * rstd * hg[3] * sigmoid_f(bfhi(ow.y));
            u32x2 wv; wv.x = cvt_pk_bf16(y0, y1); wv.y = cvt_pk_bf16(y2, y3); *(u32x2*)(Y + (size_t)row * 1024 + 512 + h * 128 + v0) = wv; }
    }
}

__device__ void ph_sg(const P& p, LAS unsigned char* lds) {
    bf16_t* U = (bf16_t*)(p.ws + WS_R); const bf16_t* V = U + (size_t)T * 2048; const float* ST = (const float*)(p.ws + WS_ST);
    constexpr int VP = 560;
    LAS unsigned char* Vn = lds; LAS unsigned char* Wt = lds + 128 * VP;
    const int tid = TIDX, lane = tid & 63, w = __builtin_amdgcn_readfirstlane(tid >> 6), c = lane & 15, g = lane >> 4, qq = (lane & 15) >> 2, pp = lane & 3;
    const int c8 = tid & 31, rb = tid >> 5;
    int last_gg = -1;
    f32x4 g0, g1, b0, b1; bf16x8 bw[4]; float bs = 0.f;
    u32x4 vr[8]; f32x2 st[8];
#define SG_PREFETCH(uu) { const int gg_ = (uu) & 7, row0_ = ((uu) >> 3) * 128; \
        _Pragma("unroll") for (int k = 0; k < 8; ++k) { const int r = rb + 16 * k; vr[k] = *(const u32x4*)(V + (size_t)(row0_ + r) * 2048 + gg_ * 256 + c8 * 8); st[k] = *(const f32x2*)(ST + 2 * (row0_ + r)); } }
    int u = blockIdx.x;
    if (u < 2048) SG_PREFETCH(u)
    while (u < 2048) {
        const int gg = u & 7, ch = u >> 3, row0 = ch * 128;
        if (gg != last_gg) { const int cbase = gg * 256 + c8 * 8;
            g0 = *(const f32x4*)(p.sg_ln_g + cbase); g1 = *(const f32x4*)(p.sg_ln_g + cbase + 4); b0 = *(const f32x4*)(p.sg_ln_b + cbase); b1 = *(const f32x4*)(p.sg_ln_b + cbase + 4); }
        __syncthreads();
#pragma unroll
        for (int k = 0; k < 8; ++k) { const int r = rb + 16 * k; const u32x4 wv = vr[k]; const float mu = st[k][0] * (1.0f / 2048.0f), rs = rsqrtf(fmaxf(st[k][1] * (1.0f / 2048.0f) - mu * mu, 0.f) + 1e-6f);
            u32x4 o;
            o[0] = cvt_pk_bf16((bflo(wv[0]) - mu) * rs * g0[0] + b0[0], (bfhi(wv[0]) - mu) * rs * g0[1] + b0[1]);
            o[1] = cvt_pk_bf16((bflo(wv[1]) - mu) * rs * g0[2] + b0[2], (bfhi(wv[1]) - mu) * rs * g0[3] + b0[3]);
            o[2] = cvt_pk_bf16((bflo(wv[2]) - mu) * rs * g1[0] + b1[0], (bfhi(wv[2]) - mu) * rs * g1[1] + b1[1]);
            o[3] = cvt_pk_bf16((bflo(wv[3]) - mu) * rs * g1[2] + b1[2], (bfhi(wv[3]) - mu) * rs * g1[3] + b1[3]);
            *(LAS u32x4*)(Vn + r * VP + c8 * 16) = o; }
        if (gg != last_gg) {
            f32x4 wv[8];
#pragma unroll
            for (int k = 0; k < 8; ++k) { const int i = tid + k * NTHR, r = i >> 5, c4 = i & 31; wv[k] = *(const f32x4*)(p.sg_w_s + (size_t)gg * 16384 + r * 128 + c4 * 4); }
#pragma unroll
            for (int k = 0; k < 8; ++k) { const int i = tid + k * NTHR, r = i >> 5, c4 = i & 31;
                u32x2 o; o.x = cvt_pk_bf16(wv[k][0], wv[k][1]); o.y = cvt_pk_bf16(wv[k][2], wv[k][3]); *(LAS u32x2*)(Wt + r * TPI + c4 * 8) = o; } }
        __syncthreads();
        const int tt = 16 * w + c;
        if (gg != last_gg) {
#pragma unroll
            for (int ks = 0; ks < 4; ++ks) bw[ks] = *(const LAS bf16x8*)(Wt + (16 * w + c) * TPI + (32 * ks + 8 * g) * 2);
            bs = p.sg_b_s[gg * 128 + tt]; last_gg = gg; }
        bf16_t* up = U + (size_t)(row0 + tt) * 2048 + gg * 256 + 8 * g;
        u32x4 uw[8];
#pragma unroll
        for (int q = 0; q < 8; ++q) uw[q] = *(const u32x4*)(up + 32 * q);
        const int un = u + gridDim.x;
        if (un < 2048) SG_PREFETCH(un)
#pragma unroll
        for (int q = 0; q < 8; ++q) { u32x4 o;
#pragma unroll
            for (int hd = 0; hd < 2; ++hd) { f32x4 acc = {0.f, 0.f, 0.f, 0.f};
#pragma unroll
                for (int ks = 0; ks < 4; ++ks) { LAS unsigned char* a = Vn + (32 * ks + 8 * g + qq) * VP + (32 * q + 8 * pp + 4 * hd) * 2; acc = mfma16(cat8(ds_tr(a), ds_tr(a + 4 * VP)), bw[ks], acc); }
                o[2 * hd] = cvt_pk_bf16(bflo(uw[q][2 * hd]) * (acc[0] + bs), bfhi(uw[q][2 * hd]) * (acc[1] + bs));
                o[2 * hd + 1] = cvt_pk_bf16(bflo(uw[q][2 * hd + 1]) * (acc[2] + bs), bfhi(uw[q][2 * hd + 1]) * (acc[3] + bs)); }
            *(u32x4*)(up + 32 * q) = o; }
        u = un;
    }
#undef SG_PREFETCH
}

#define XB_TMO      128
#define XB_XCNT(j)  (256  + 64 * (j))
#define XB_XSUB(j)  (1280 + 64 * (j))
#define XB_XGEN(j)  (2304 + 64 * (j))
#define XB_TOP      3328
#define XB_TOPGEN   3392
#define XCD_BAR_WORDS 3456
#define XB_SPIN_CAP (1u << 18)

__device__ __forceinline__ unsigned xb_ld(unsigned* p)              { return __hip_atomic_load(p, __ATOMIC_RELAXED, __HIP_MEMORY_SCOPE_AGENT); }
__device__ __forceinline__ unsigned xb_add(unsigned* p, unsigned v) { return __hip_atomic_fetch_add(p, v, __ATOMIC_RELAXED, __HIP_MEMORY_SCOPE_AGENT); }
__device__ __forceinline__ unsigned xb_xcc_id() { return (unsigned)__builtin_amdgcn_s_getreg((3 << 11) | 20) & 0xFu; }
#define XB_SPIN(cond, bar) do { unsigned _sp = 0; while (cond) { __builtin_amdgcn_s_sleep(1); \
    if ((++_sp & 255u) == 0u) { if (xb_ld(&(bar)[XB_TMO])) break; if (_sp > XB_SPIN_CAP) { atomicAdd(&(bar)[XB_TMO], 1u); break; } } } } while (0)

struct XcdBarrier {
    unsigned* bar; unsigned x;
    volatile LAS unsigned* st;
};

__device__ __forceinline__ XcdBarrier xcd_barrier_post(unsigned* bar, volatile LAS unsigned* st) {
    XcdBarrier b; b.bar = bar; b.x = xb_xcc_id(); b.st = st;
    if (threadIdx.x == 0) (void)xb_add(&bar[XB_XCNT(b.x)], 1u);
    return b;
}
__device__ __forceinline__ void xcd_barrier_complete(unsigned* bar, unsigned x, unsigned& nloc, unsigned& nx) {
    const unsigned G = gridDim.x * gridDim.y * gridDim.z;
    unsigned sum, cnt, mine, sp = 0u;
    for (;;) {
        sum = 0u; cnt = 0u; mine = 0u;
#pragma unroll
        for (unsigned j = 0; j < 16; ++j) { const unsigned c = xb_ld(&bar[XB_XCNT(j)]); sum += c; cnt += (c > 0u) ? 1u : 0u; mine = (j == x) ? c : mine; }
        if (sum == G) break;
        __builtin_amdgcn_s_sleep(1);
        if ((++sp & 255u) == 0u) { if (xb_ld(&bar[XB_TMO])) break; if (sp > XB_SPIN_CAP) { atomicAdd(&bar[XB_TMO], 1u); break; } }
    }
    nloc = mine > 0u ? mine : 1u; nx = cnt > 0u ? cnt : 1u;
}

__device__ __forceinline__ void xcd_barrier(const XcdBarrier& b) {
    asm volatile("s_waitcnt vmcnt(0)" ::: "memory");
    __syncthreads();
    if (threadIdx.x == 0) {
        unsigned* bar = b.bar;
        __builtin_amdgcn_s_waitcnt(0);
        unsigned nloc = b.st[0], nx = b.st[1];
        if (nloc == 0u) { xcd_barrier_complete(bar, b.x, nloc, nx); b.st[0] = nloc; b.st[1] = nx; }
        const unsigned old = xb_add(&bar[XB_XSUB(b.x)], 1u);
        const unsigned gen = old / nloc;
        if (old + 1u == (gen + 1u) * nloc) {
            __builtin_amdgcn_fence(__ATOMIC_RELEASE, "agent");
            asm volatile("s_waitcnt vmcnt(0)" ::: "memory");
            const unsigned og = xb_add(&bar[XB_TOP], 1u);
            const unsigned tg = og / nx;
            if (og + 1u == (tg + 1u) * nx) xb_add(&bar[XB_TOPGEN], 1u);
            else XB_SPIN(xb_ld(&bar[XB_TOPGEN]) == tg, bar);
            __builtin_amdgcn_fence(__ATOMIC_ACQUIRE, "agent");
            xb_add(&bar[XB_XGEN(b.x)], 1u);
            asm volatile("s_waitcnt vmcnt(0)" ::: "memory");
        } else {
            XB_SPIN(xb_ld(&bar[XB_XGEN(b.x)]) == gen, bar);
            __builtin_amdgcn_fence(__ATOMIC_ACQUIRE, "agent");
            asm volatile("s_waitcnt vmcnt(0)" ::: "memory");
        }
    }
    __syncthreads();
}


constexpr int NPHASE = 25;
constexpr int CONV_L1_EARLY = 1144;
#ifndef PH_EN
#define PH_EN 0xFFFFFFFFu
#endif
#define EN(k) (((PH_EN) >> (k)) & 1u)
__device__ __forceinline__ void run_phase(const P& p, int ph_in, bool second, LAS unsigned char* lds) {
    const int G = gridDim.x, c = blockIdx.x;
    const bool ctx_units = (ph_in == 4) && !second && (c < 8);
    const int ph = ctx_units ? 3 : ph_in;
    unsigned char* ws = p.ws;
    const float* mod = (const float*)(ws + WS_MOD);
    bf16_t* Wb = (bf16_t*)(ws + WS_W); bf16_t* R = (bf16_t*)(ws + WS_R); bf16_t* H = (bf16_t*)(ws + WS_H); float* XC = (float*)(ws + WS_XC);
    pg8::StaticOrder S;
    if (!((PH_EN >> ph_in) & 1u)) return;
    switch (ph) {
    case 0: if (EN(0)) { ph_prep(p, lds); ph_convert(p, lds, 0, c, G, 0, 2720); ph_convert(p, lds, 1, c, G, 0, CONV_L1_EARLY); } break;
    case 1: case 4: case 10: case 13: case 16: case 21: if (EN(1)) {
        const int l = ph >= 13, sub = (ph == 1 || ph == 13) ? 0 : ((ph == 4 || ph == 16) ? 1 : 2);
        const float* xl = (ph == 1) ? p.x : p.out; const float* xc = (ph == 1) ? p.ctx : XC;
        if (ph == 1) ph_norm(p, xl, xc, 0, TP, 0, G, p.norm_g + (l * 3 + sub) * 1024, mod + (size_t)l * 3 * 9216, sub, H);
        else if (ph == 4 && !second) { ph_norm(p, xl, xc, 0, T, 8, G - 8, p.norm_g + (l * 3 + sub) * 1024, mod + (size_t)l * 3 * 9216, sub, H);
            ph_convert(p, lds, 1, c - 8, G - 8, CONV_L1_EARLY, 2880); }
        else if (ph == 4) ph_norm(p, xl, xc, T, TP, 0, G, p.norm_g + (l * 3 + sub) * 1024, mod + (size_t)l * 3 * 9216, sub, H);
        else ph_norm(p, xl, xc, 0, T, 0, G, p.norm_g + (l * 3 + sub) * 1024, mod + (size_t)l * 3 * 9216, sub, H); } break;
    case 2: case 11: case 14: case 22: if (EN(2)) {
        const int l = ph >= 13, s = (ph == 11 || ph == 22), M = (ph == 2) ? TP : T;
        pg8::Gemm g{H, Wb + W_FFN_IN + (size_t)(l * 2 + s) * 5632 * 1024, M, 5632, 1024, 0, 0}; S.init(M, 5632, G, c); EpiSwiglu E{R}; pg8::gemm_phase(lds, g, S, E); } break;
    case 3: case 12: case 15: case 23: case 9: case 20: if (EN(3)) {
        const int l = ph >= 13; pg8::Gemm g; float coef; int sub;
        if (ph == 9) { g = pg8::Gemm{H, Wb + W_MIXOUT, T, 1024, 1024, 0, 0}; coef = 1.0f; sub = 1; }
        else if (ph == 20) { g = pg8::Gemm{R, Wb + W_SGOUT, T, 1024, 2048, 0, 0}; coef = 1.0f; sub = 1; }
        else { const int s = (ph == 12 || ph == 23); g = pg8::Gemm{R, Wb + W_FFN_OUT + (size_t)(l * 2 + s) * 1024 * 2816, ctx_units ? TP : T, 1024, 2816, 1, 1}; coef = 0.5f; sub = s ? 2 : 0; }
        S.init(g.M, 1024, G, c);
        if (ctx_units) { S.fpm = T / 256 + (c >> 2); S.fpn = c & 3; }
        S.rev = REV_PANELS;
        EpiResid E{(ph == 3) ? p.x : p.out, (ph == 3) ? p.ctx : XC, p.out, XC, mod + (size_t)l * 3 * 9216 + (sub * 3 + 2) * 1024, coef}; pg8::gemm_phase(lds, g, S, E); } break;
    case 5: if (EN(5)) { pg8::Gemm g{H, Wb + W_MIXIN, TP, 3840, 1024, 0, 0}; S.init(TP, 3840, G, c);
        EpiProj E{R, (float*)(R + (size_t)7 * TP * 512), (const float2*)(ws + WS_ROPE), p.ml_gate_b}; pg8::gemm_phase(lds, g, S, E); } break;
    case 6:
#if NAIVE_NA
        if (EN(6)) ph_na_naive(p);
#else
        if (EN(6)) ph_na2(p, lds);
#endif
        __syncthreads();
#if NAIVE_MLA
        if (EN(26)) ph_mlA_naive(p, lds);
#else
        if (EN(26)) ph_mlA(p, lds);
#endif
        break;
    case 7: if (EN(7)) ph_mlB(p, lds); break;
    case 8:
#if NAIVE_MLC
        if (EN(8)) ph_mlC_naive(p, lds);
#else
        if (EN(8)) ph_mlC(p, lds);
#endif
        break;
    case 17: if (EN(17)) { pg8::Gemm g{H, Wb + W_SGIN, T, 4096, 1024, 0, 0}; S.init(T, 4096, G, c); EpiGeluUV E{R, (float*)(ws + WS_ST)}; pg8::gemm_phase(lds, g, S, E); } break;
    case 18: if (EN(18)) ph_sg_stats(p); break;
    case 19:
#if NAIVE_SG
        if (EN(19)) ph_sg_naive(p, lds);
#else
        if (EN(19)) ph_sg(p, lds);
#endif
        break;
    case 24: if (EN(24)) ph_final_norm(p); break;
    }
}

__global__ void __launch_bounds__(NTHR, 2) fwd_kernel(P p) {
    extern __shared__ __attribute__((aligned(16))) unsigned char lds_raw[];
    LAS unsigned char* lds = (LAS unsigned char*)lds_raw;
#if MULTI_LAUNCH
    run_phase(p, p.ph_lo, false, lds);
#else
    cg::grid_group grid = cg::this_grid();
    volatile LAS unsigned* bar_st = (volatile LAS unsigned*)(lds + (LDS_BYTES - 16));
    if (threadIdx.x < 4) bar_st[threadIdx.x] = 0u;
    __syncthreads();
    (void)xcd_barrier_post((unsigned*)(p.ws + WS_BAR), bar_st);
    for (int it = 2 * p.ph_lo; it < 2 * p.ph_hi; ++it) {
        const int ph = it >> 1;
        if (ph == 18) continue;
        if ((it & 1) && ph != 4 && !((DBL_MASK >> ph) & 1u)) continue;
        if (it > 2 * p.ph_lo) {
            if (it == 2 * p.ph_lo + 2) grid.sync();
            else { XcdBarrier xb; xb.bar = (unsigned*)(p.ws + WS_BAR); xb.x = xb_xcc_id(); xb.st = bar_st; xcd_barrier(xb); }
        }
        run_phase(p, ph, (it & 1) != 0, lds);
    }
#endif
}

extern "C" void kernel_launch(void* const* d_in, const int* in_sizes, int n_in, void* d_out, int out_size, void* d_ws, size_t ws_size, hipStream_t stream) {
    static int grid = 0;
    if (grid == 0) {
        if (ws_size < WS_END) { fprintf(stderr, "kernel_launch: workspace too small: %zu < %zu\n", ws_size, (size_t)WS_END); grid = -1; return; }
        int dev = 0, cus = 0, per_cu = 0;
        (void)hipGetDevice(&dev); (void)hipDeviceGetAttribute(&cus, hipDeviceAttributeMultiprocessorCount, dev);
        if (hipFuncSetAttribute((const void*)fwd_kernel, hipFuncAttributeMaxDynamicSharedMemorySize, LDS_BYTES) != hipSuccess) { fprintf(stderr, "kernel_launch: hipFuncSetAttribute failed\n"); grid = -1; return; }
        if (hipOccupancyMaxActiveBlocksPerMultiprocessor(&per_cu, (const void*)fwd_kernel, NTHR, LDS_BYTES) != hipSuccess || per_cu < 1) { fprintf(stderr, "kernel_launch: occupancy query gave %d\n", per_cu); per_cu = 1; }
        (void)hipGetLastError();
        grid = cus * 1;
    }
    if (grid < 0) return;
    (void)hipMemsetAsync((char*)d_ws + WS_MOD, 0, WS_ZERO_END, stream);
    P p{};
    const float** pp = (const float**)&p;
    for (int i = 0; i < 21; ++i) pp[i] = (const float*)d_in[i];
    p.out = (float*)d_out; p.ws = (unsigned char*)d_ws;
#if MULTI_LAUNCH
    for (int ph = 0; ph < NPHASE; ++ph) { p.ph_lo = ph; p.ph_hi = ph + 1; hipLaunchKernelGGL(fwd_kernel, dim3(grid), dim3(NTHR), LDS_BYTES, stream, p); }
#else
    p.ph_lo = 0; p.ph_hi = NPHASE;
    void* args[] = {&p};
    hipError_t e = hipLaunchCooperativeKernel((const void*)fwd_kernel, dim3(grid), dim3(NTHR), args, LDS_BYTES, stream);
    if (e != hipSuccess) fprintf(stderr, "cooperative launch failed: %s (grid %d)\n", hipGetErrorString(e), grid);
#endif
}
```
